# Optimizing an MI355X kernel written in HIP

```python
import math
import jax, jax.numpy as jnp
from jax import lax
import numpy as np

D_MODEL = 1024
BATCH = 2
SEQ = 8192
DEPTH = 1

CHUNK = 64
Q_BLOCK = 128
EPS = 1e-6

DIFF_HEADS = 4
DIFF_HEAD_DIM = 64
DIFF_V_DIM = 2 * DIFF_HEAD_DIM
DIFF_QK_WIDTH = DIFF_HEADS * 2 * DIFF_HEAD_DIM
DIFF_V_WIDTH = DIFF_HEADS * DIFF_V_DIM

GDN_HEADS = 4
GDN_K_DIM = 128
GDN_V_DIM = 128
GDN_K_WIDTH = GDN_HEADS * GDN_K_DIM
GDN_V_WIDTH = GDN_HEADS * GDN_V_DIM
CONV_K = 4
GDN_CONV_WIDTH = 2 * GDN_K_WIDTH + GDN_V_WIDTH

MOE_GROUPS = 4
MOE_EXPERTS_PER_GROUP = 8
MOE_EXPERTS = MOE_GROUPS * MOE_EXPERTS_PER_GROUP
MOE_TOP_K = 2
MOE_HIDDEN = 256

IN_SPLITS = (DIFF_QK_WIDTH, DIFF_QK_WIDTH, DIFF_V_WIDTH, GDN_K_WIDTH, GDN_K_WIDTH, GDN_V_WIDTH, GDN_HEADS, GDN_HEADS, GDN_V_WIDTH, D_MODEL, D_MODEL)
IN_WIDTH = 3 * 512 + 3 * 512 + 2 * GDN_HEADS + GDN_V_WIDTH + 2 * D_MODEL

kernel_name = 'hybrid_diffattn_gdn_hmoe_block'


def rms_norm(x, gain):
    xf = x.astype(jnp.float32)
    y = xf * lax.rsqrt(jnp.mean(xf * xf, axis=-1, keepdims=True) + EPS)
    return (y * gain.astype(jnp.float32)).astype(x.dtype)


def l2_normalize(t):
    return t * lax.rsqrt(jnp.sum(t * t, axis=-1, keepdims=True) + EPS)


def causal_depthwise_conv(x, w):
    s = x.shape[1]
    xp = jnp.pad(x, ((0, 0), (CONV_K - 1, 0), (0, 0)))
    out = xp[:, 0:s] * w[0]
    for j in range(1, CONV_K):
        out = out + xp[:, j:j + s] * w[j]
    return out


def diff_attention(q, k, v, lam, subln_gain, lambda_init):
    b, s = q.shape[0], q.shape[1]
    nb = s // Q_BLOCK
    scale = DIFF_HEAD_DIM ** -0.5
    kf = k.astype(jnp.float32)
    vf = v.astype(jnp.float32)
    qb = q.astype(jnp.float32).reshape(b, nb, Q_BLOCK, DIFF_HEADS, 2, DIFF_HEAD_DIM).transpose(1, 0, 2, 3, 4, 5)
    key_chunk = jnp.arange(s) // CHUNK

    def block(args):
        q_blk, bidx = args
        sc = jnp.einsum('bqhcd,bkhcd->bhcqk', q_blk, kf) * scale
        q_chunk = (bidx * Q_BLOCK + jnp.arange(Q_BLOCK)) // CHUNK
        mask = key_chunk[None, :] <= q_chunk[:, None]
        sc = jnp.where(mask, sc, -jnp.inf)
        p = jax.nn.softmax(sc, axis=-1)
        a = p[:, :, 0] - lam * p[:, :, 1]
        return jnp.einsum('bhqk,bkhv->bqhv', a, vf)

    o = lax.map(block, (qb, jnp.arange(nb)))
    o = o.transpose(1, 0, 2, 3, 4).reshape(b, s, DIFF_HEADS, DIFF_V_DIM)
    o = rms_norm(o, subln_gain) * (1.0 - lambda_init)
    return o.reshape(b, s, DIFF_V_WIDTH)


def gated_delta_net(q, k, v, beta, g, norm_gain, gate):
    b, s = q.shape[0], q.shape[1]
    nc = s // CHUNK
    q = l2_normalize(q) * (GDN_K_DIM ** -0.5)
    k = l2_normalize(k)

    def to_chunks(t):
        return t.reshape(b, nc, CHUNK, GDN_HEADS, -1).transpose(0, 3, 1, 2, 4)

    qc, kc, vc = to_chunks(q), to_chunks(k), to_chunks(v)
    bc = beta.reshape(b, nc, CHUNK, GDN_HEADS).transpose(0, 3, 1, 2)
    gc = g.reshape(b, nc, CHUNK, GDN_HEADS).transpose(0, 3, 1, 2)
    gcum = jnp.cumsum(gc, axis=-1)
    causal = jnp.tril(jnp.ones((CHUNK, CHUNK), dtype=bool))
    strict = jnp.tril(jnp.ones((CHUNK, CHUNK), dtype=bool), -1)
    diff = gcum[..., :, None] - gcum[..., None, :]
    decay_mat = jnp.exp(jnp.where(causal, diff, -jnp.inf))
    kb = kc * bc[..., None]
    vb = vc * bc[..., None]
    a_low = jnp.where(strict, jnp.einsum('bhncd,bhnjd->bhncj', kb, kc) * decay_mat, 0.0)
    eye = jnp.eye(CHUNK, dtype=jnp.float32)
    rhs = jnp.concatenate([vb, kb * jnp.exp(gcum)[..., None]], axis=-1)
    sol = lax.linalg.triangular_solve(eye + a_low, rhs, left_side=True, lower=True, unit_diagonal=True)
    u, w = sol[..., :GDN_V_DIM], sol[..., GDN_V_DIM:]
    intra = jnp.einsum('bhncd,bhnjd->bhncj', qc, kc) * decay_mat
    q_dec = qc * jnp.exp(gcum)[..., None]
    k_dec = kc * jnp.exp(gcum[..., -1:] - gcum)[..., None]
    g_last = jnp.exp(gcum[..., -1])
    xs = tuple(jnp.moveaxis(t, 2, 0) for t in (q_dec, k_dec, u, w, intra, g_last))

    def step(state, inp):
        q_d, k_d, u_c, w_c, a_c, gl = inp
        v_new = u_c - jnp.einsum('bhck,bhkv->bhcv', w_c, state)
        o_c = jnp.einsum('bhck,bhkv->bhcv', q_d, state) + jnp.einsum('bhcj,bhjv->bhcv', a_c, v_new)
        state = state * gl[..., None, None] + jnp.einsum('bhck,bhcv->bhkv', k_d, v_new)
        return state, o_c

    s0 = jnp.zeros((b, GDN_HEADS, GDN_K_DIM, GDN_V_DIM), jnp.float32)
    _, o = lax.scan(step, s0, xs)
    o = o.transpose(1, 0, 3, 2, 4).reshape(b, s, GDN_HEADS, GDN_V_DIM)
    o = rms_norm(o, norm_gain) * jax.nn.silu(gate.astype(jnp.float32)).reshape(b, s, GDN_HEADS, GDN_V_DIM)
    return o.reshape(b, s, GDN_V_WIDTH)


def hier_moe(h, w_group, b_group, w_expert, b_expert, w_gate, w_up, w_down):
    b, s, d = h.shape
    t = h.reshape(b * s, d)
    tf = t.astype(jnp.float32)
    grp_logits = tf @ w_group.astype(jnp.float32) + b_group.astype(jnp.float32)
    grp_prob = jax.nn.softmax(grp_logits, axis=-1)
    grp_idx = jnp.argmax(grp_logits, axis=-1)
    grp_w = jnp.max(grp_prob, axis=-1, keepdims=True)
    exp_logits = (tf @ w_expert.astype(jnp.float32) + b_expert.astype(jnp.float32)).reshape(-1, MOE_GROUPS, MOE_EXPERTS_PER_GROUP)
    in_grp = jnp.einsum('tg,tge->te', jax.nn.one_hot(grp_idx, MOE_GROUPS, dtype=jnp.float32), exp_logits)
    top_val, top_idx = lax.top_k(in_grp, MOE_TOP_K)
    top_w = jax.nn.softmax(top_val, axis=-1) * grp_w
    expert_id = grp_idx[:, None] * MOE_EXPERTS_PER_GROUP + top_idx
    combine = jnp.einsum('tk,tke->te', top_w, jax.nn.one_hot(expert_id, MOE_EXPERTS, dtype=jnp.float32))
    hg = jnp.einsum('td,edf->tef', t, w_gate)
    hu = jnp.einsum('td,edf->tef', t, w_up)
    act = jax.nn.silu(hg) * hu * combine[..., None].astype(t.dtype)
    y = jnp.einsum('tef,efd->td', act, w_down)
    return y.reshape(b, s, d)


def setup_inputs(seed: int = 0) -> dict:
    key = jax.random.key(seed)
    ks = jax.random.split(key, 24)
    nrm = jax.random.normal
    f32 = jnp.float32
    dt = jnp.exp(jax.random.uniform(ks[9], (DEPTH, GDN_HEADS), f32, math.log(1e-3), math.log(1e-1)))
    return {
        'x': nrm(ks[0], (BATCH, SEQ, D_MODEL), f32),
        'norm_mix_gain': 1.0 + 0.02 * nrm(ks[1], (DEPTH, D_MODEL), f32),
        'w_in': nrm(ks[2], (DEPTH, D_MODEL, IN_WIDTH), f32) * D_MODEL ** -0.5,
        'diff_lambda_q1': 0.1 * nrm(ks[3], (DEPTH, DIFF_HEAD_DIM), f32),
        'diff_lambda_k1': 0.1 * nrm(ks[4], (DEPTH, DIFF_HEAD_DIM), f32),
        'diff_lambda_q2': 0.1 * nrm(ks[5], (DEPTH, DIFF_HEAD_DIM), f32),
        'diff_lambda_k2': 0.1 * nrm(ks[6], (DEPTH, DIFF_HEAD_DIM), f32),
        'diff_subln_gain': 1.0 + 0.02 * nrm(ks[7], (DEPTH, DIFF_V_DIM), f32),
        'gdn_conv_w': nrm(ks[8], (DEPTH, CONV_K, GDN_CONV_WIDTH), f32) * CONV_K ** -0.5,
        'gdn_a_log': jnp.log(jax.random.uniform(ks[10], (DEPTH, GDN_HEADS), f32, 1.0, 16.0)),
        'gdn_dt_bias': dt + jnp.log(-jnp.expm1(-dt)),
        'gdn_norm_gain': 1.0 + 0.02 * nrm(ks[11], (DEPTH, GDN_V_DIM), f32),
        'w_branch_attn': nrm(ks[12], (DEPTH, DIFF_V_WIDTH, D_MODEL), f32) * DIFF_V_WIDTH ** -0.5,
        'w_branch_gdn': nrm(ks[13], (DEPTH, GDN_V_WIDTH, D_MODEL), f32) * GDN_V_WIDTH ** -0.5,
        'w_out': nrm(ks[14], (DEPTH, D_MODEL, D_MODEL), f32) * D_MODEL ** -0.5,
        'norm_ffn_gain': 1.0 + 0.02 * nrm(ks[15], (DEPTH, D_MODEL), f32),
        'moe_w_group': nrm(ks[16], (DEPTH, D_MODEL, MOE_GROUPS), f32) * D_MODEL ** -0.5,
        'moe_b_group': 0.01 * nrm(ks[17], (DEPTH, MOE_GROUPS), f32),
        'moe_w_expert': nrm(ks[18], (DEPTH, D_MODEL, MOE_EXPERTS), f32) * D_MODEL ** -0.5,
        'moe_b_expert': 0.01 * nrm(ks[19], (DEPTH, MOE_EXPERTS), f32),
        'moe_w_gate': nrm(ks[20], (DEPTH, MOE_EXPERTS, D_MODEL, MOE_HIDDEN), f32) * D_MODEL ** -0.5,
        'moe_w_up': nrm(ks[21], (DEPTH, MOE_EXPERTS, D_MODEL, MOE_HIDDEN), f32) * D_MODEL ** -0.5,
        'moe_w_down': nrm(ks[22], (DEPTH, MOE_EXPERTS, MOE_HIDDEN, D_MODEL), f32) * MOE_HIDDEN ** -0.5,
        'norm_final_gain': 1.0 + 0.02 * nrm(ks[23], (D_MODEL,), f32),
    }


def reference(x, norm_mix_gain, w_in, diff_lambda_q1, diff_lambda_k1, diff_lambda_q2, diff_lambda_k2, diff_subln_gain, gdn_conv_w, gdn_a_log, gdn_dt_bias, gdn_norm_gain, w_branch_attn, w_branch_gdn, w_out, norm_ffn_gain, moe_w_group, moe_b_group, moe_w_expert, moe_b_expert, moe_w_gate, moe_w_up, moe_w_down, norm_final_gain):
    b, s, _ = x.shape
    points = [int(p) for p in np.cumsum(IN_SPLITS)[:-1]]
    for layer in range(DEPTH):
        lambda_init = 0.8 - 0.6 * math.exp(-0.3 * layer)
        h = rms_norm(x, norm_mix_gain[layer])
        proj = h @ w_in[layer]
        (dq, dk, dv, gq, gk, gv, g_beta, g_dec, g_gate, m_gate_a, m_gate_b) = jnp.split(proj, points, axis=-1)
        lam = (jnp.exp(jnp.sum(diff_lambda_q1[layer].astype(jnp.float32) * diff_lambda_k1[layer].astype(jnp.float32)))
               - jnp.exp(jnp.sum(diff_lambda_q2[layer].astype(jnp.float32) * diff_lambda_k2[layer].astype(jnp.float32)))
               + lambda_init)
        y_a = diff_attention(dq.reshape(b, s, DIFF_HEADS, 2, DIFF_HEAD_DIM),
                             dk.reshape(b, s, DIFF_HEADS, 2, DIFF_HEAD_DIM),
                             dv.reshape(b, s, DIFF_HEADS, DIFF_V_DIM),
                             lam, diff_subln_gain[layer], lambda_init)
        qkv = jax.nn.silu(causal_depthwise_conv(jnp.concatenate([gq, gk, gv], axis=-1).astype(jnp.float32), gdn_conv_w[layer].astype(jnp.float32)))
        cq, ck, cv = jnp.split(qkv, [GDN_K_WIDTH, 2 * GDN_K_WIDTH], axis=-1)
        beta = jax.nn.sigmoid(g_beta.astype(jnp.float32))
        g_log = -jnp.exp(gdn_a_log[layer].astype(jnp.float32)) * jax.nn.softplus(g_dec.astype(jnp.float32) + gdn_dt_bias[layer].astype(jnp.float32))
        y_b = gated_delta_net(cq.reshape(b, s, GDN_HEADS, GDN_K_DIM), ck.reshape(b, s, GDN_HEADS, GDN_K_DIM),
                              cv.reshape(b, s, GDN_HEADS, GDN_V_DIM), beta, g_log, gdn_norm_gain[layer], g_gate)
        merged = (jax.nn.sigmoid(m_gate_a) * (y_a.astype(x.dtype) @ w_branch_attn[layer])
                  + jax.nn.sigmoid(m_gate_b) * (y_b.astype(x.dtype) @ w_branch_gdn[layer]))
        x = x + merged @ w_out[layer]
        h2 = rms_norm(x, norm_ffn_gain[layer])
        x = x + hier_moe(h2, moe_w_group[layer], moe_b_group[layer], moe_w_expert[layer], moe_b_expert[layer],
                         moe_w_gate[layer], moe_w_up[layer], moe_w_down[layer])
    return rms_norm(x, norm_final_gain)
```

```cpp
#include <hip/hip_runtime.h>
#include <cstdio>
#include <cstdint>
namespace pg8 {
#define PG8_LAS __attribute__((address_space(3)))
typedef unsigned short bf16_t;
typedef short bf16x8 __attribute__((ext_vector_type(8)));
typedef float f32x4 __attribute__((ext_vector_type(4)));
typedef unsigned u32x4 __attribute__((ext_vector_type(4)));
constexpr int BM = 256, BK = 64, HALF = 128, HTB = HALF * BK * 2  , STAGE_BYTES = 8 * HTB, NXCD = 8, WGM = 8;

__host__ __device__ __forceinline__ int lds_byte(int r, int c) { const int st = (r >> 4) * 2 + (c >> 5), rr = r & 15, cc = c & 31, ob = rr * 64 + cc * 2; return st * 1024 + (ob ^ (((ob >> 9) & 1) << 5)); }
__host__ __device__ __forceinline__ void stage_rc(int b, int& R, int& C) { const int st = b / 1024, sb = b % 1024, swz = sb ^ (((sb >> 9) & 1) << 5); R = (st >> 1) * 16 + swz / 64; C = (st & 1) * 32 + (swz % 64) / 2; }
__host__ __device__ __forceinline__ int perm32(int rho) { const int n = rho >> 4, i = rho & 15; return 8 * (i >> 2) + 4 * n + (i & 3); }

struct Unit { int pm, pn; };
struct Gemm { const bf16_t* A; const bf16_t* Bt; int M, N, K; };

struct StaticOrder {
    int nM, nN, nwg, G, c;
    __host__ __device__ void init(int M, int N, int G_, int c_) { nM = M / BM; nN = N / BM; nwg = nM * nN; G = G_; c = c_; }
    __host__ __device__ bool next(int i, Unit& u) const {
        const long L = (long)i * G + c; if (L >= nwg) return false;
        int wgid = (int)L; { const int q = nwg / NXCD, r = nwg % NXCD, xcd = wgid % NXCD, off = wgid / NXCD; wgid = (xcd < r ? xcd * (q + 1) : r * (q + 1) + (xcd - r) * q) + off; }
        const int nig = WGM * nN, gid = wgid / nig, fm = gid * WGM, gsz = (nM - fm) < WGM ? (nM - fm) : WGM;
        u.pm = fm + ((wgid % nig) % gsz); u.pn = (wgid % nig) / gsz; return true;
    }
    __device__ __forceinline__ void a_ready(const Unit&) const {}
    __device__ __forceinline__ void done(const Unit&) const {}
};

__device__ __forceinline__ unsigned cvt_pk_bf16(float lo, float hi) { unsigned r; asm volatile("v_cvt_pk_bf16_f32 %0, %1, %2" : "=v"(r) : "v"(lo), "v"(hi)); return r; }
typedef unsigned u32x2 __attribute__((ext_vector_type(2)));
__device__ __forceinline__ float bf_lo(unsigned w) { return __uint_as_float(w << 16); }
__device__ __forceinline__ float bf_hi(unsigned w) { return __uint_as_float(w & 0xffff0000u); }
__device__ __forceinline__ float sigmoid_f(float x) { return __builtin_amdgcn_rcpf(1.0f + __expf(-x)); }
__device__ __forceinline__ float silu_f(float x) { return x * sigmoid_f(x); }
__device__ __forceinline__ u32x4 pack8(const f32x4& v0, const f32x4& v1) { u32x4 w; w.x = cvt_pk_bf16(v0[0], v0[1]); w.y = cvt_pk_bf16(v0[2], v0[3]); w.z = cvt_pk_bf16(v1[0], v1[1]); w.w = cvt_pk_bf16(v1[2], v1[3]); return w; }

struct EpiProj {
    static constexpr bool PERM = true, AFTER_DRAIN = false;
    bf16_t *Q, *Kb, *V, *G, *GATE, *MA, *MB; float qscale;
    __device__ __forceinline__ void operator()(const f32x4 (&acc)[2][2][4][2], const Unit& u, int wr, int wc, int fr, int fq) const {
        const int pn = u.pn; bf16_t* base; int ldc, colt; float sc = 1.f; bool sg = false;
        if (pn < 2) { base = Q; ldc = 512; colt = pn * 256; sc = qscale; }
        else if (pn < 4) { base = Kb; ldc = 512; colt = (pn - 2) * 256; }
        else if (pn < 6) { base = V; ldc = 512; colt = (pn - 4) * 256; }
        else if (pn < 12) { base = G; ldc = 1536; colt = (pn - 6) * 256; }
        else if (pn < 14) { base = GATE; ldc = 512; colt = (pn - 12) * 256; }
        else if (pn < 18) { base = MA; ldc = 1024; colt = (pn - 14) * 256; sg = true; }
        else { base = MB; ldc = 1024; colt = (pn - 18) * 256; sg = true; }
        const int row0 = u.pm * BM + wr * 64 + fr, col0 = colt + wc * 32 + 8 * fq;
#pragma unroll
        for (int ai = 0; ai < 2; ++ai)
#pragma unroll
            for (int m = 0; m < 4; ++m) { bf16_t* rowp = base + (size_t)(row0 + ai * HALF + m * 16) * ldc + col0;
#pragma unroll
                for (int bj = 0; bj < 2; ++bj) { f32x4 v0 = acc[ai][bj][m][0], v1 = acc[ai][bj][m][1];
                    if (sg) {
#pragma unroll
                        for (int i = 0; i < 4; ++i) { v0[i] = sigmoid_f(v0[i]); v1[i] = sigmoid_f(v1[i]); }
                    } else { v0 = v0 * sc; v1 = v1 * sc; }
                    *(u32x4*)(rowp + bj * HALF) = pack8(v0, v1); } }
    }
};
template <int PASS> struct EpiMerge {
    static constexpr bool PERM = true, AFTER_DRAIN = false;
    const bf16_t* Gt; bf16_t* O;
    __device__ __forceinline__ void operator()(const f32x4 (&acc)[2][2][4][2], const Unit& u, int wr, int wc, int fr, int fq) const {
        const int row0 = u.pm * BM + wr * 64 + fr, col0 = u.pn * BM + wc * 32 + 8 * fq;
#pragma unroll
        for (int ai = 0; ai < 2; ++ai)
#pragma unroll
            for (int m = 0; m < 4; ++m) { const size_t off = (size_t)(row0 + ai * HALF + m * 16) * 1024 + col0;
#pragma unroll
                for (int bj = 0; bj < 2; ++bj) { const u32x4 g = *(const u32x4*)(Gt + off + bj * HALF);
                    f32x4 v0 = acc[ai][bj][m][0], v1 = acc[ai][bj][m][1];
                    v0[0] *= bf_lo(g.x); v0[1] *= bf_hi(g.x); v0[2] *= bf_lo(g.y); v0[3] *= bf_hi(g.y);
                    v1[0] *= bf_lo(g.z); v1[1] *= bf_hi(g.z); v1[2] *= bf_lo(g.w); v1[3] *= bf_hi(g.w);
                    if (PASS) { const u32x4 p = *(const u32x4*)(O + off + bj * HALF);
                        v0[0] += bf_lo(p.x); v0[1] += bf_hi(p.x); v0[2] += bf_lo(p.y); v0[3] += bf_hi(p.y);
                        v1[0] += bf_lo(p.z); v1[1] += bf_hi(p.z); v1[2] += bf_lo(p.w); v1[3] += bf_hi(p.w); }
                    *(u32x4*)(O + off + bj * HALF) = pack8(v0, v1); } }
    }
};
struct EpiRes {
    static constexpr bool PERM = false, AFTER_DRAIN = false;
    const float* base; float* out;
    __device__ __forceinline__ void operator()(const f32x4 (&acc)[2][2][4][2], const Unit& u, int wr, int wc, int fr, int fq) const {
        const int row0 = u.pm * BM + wr * 64 + fr, col0 = u.pn * BM + wc * 32 + 4 * fq;
#pragma unroll
        for (int ai = 0; ai < 2; ++ai)
#pragma unroll
            for (int m = 0; m < 4; ++m) { const size_t off = (size_t)(row0 + ai * HALF + m * 16) * 1024 + col0;
#pragma unroll
                for (int bj = 0; bj < 2; ++bj)
#pragma unroll
                    for (int n = 0; n < 2; ++n) { const size_t p = off + bj * HALF + n * 16; *(f32x4*)(out + p) = *(const f32x4*)(base + p) + acc[ai][bj][m][n]; } }
    }
};
struct EpiAct {
    static constexpr bool PERM = true, AFTER_DRAIN = false;
    bf16_t* ACT; const float* roww;
    __device__ __forceinline__ void operator()(const f32x4 (&acc)[2][2][4][2], const Unit& u, int wr, int wc, int fr, int fq) const {
        const int row0 = u.pm * BM + wr * 64 + fr, col0 = (u.pn & 1) * 128 + wc * 32 + 8 * fq;
#pragma unroll
        for (int ai = 0; ai < 2; ++ai)
#pragma unroll
            for (int m = 0; m < 4; ++m) { const int row = row0 + ai * HALF + m * 16; const float w = roww[row];
                f32x4 v0, v1;
#pragma unroll
                for (int i = 0; i < 4; ++i) { v0[i] = silu_f(acc[ai][0][m][0][i]) * acc[ai][1][m][0][i] * w; v1[i] = silu_f(acc[ai][0][m][1][i]) * acc[ai][1][m][1][i] * w; }
                *(u32x4*)(ACT + (size_t)row * 256 + col0) = pack8(v0, v1); }
    }
};
struct EpiStore {
    static constexpr bool PERM = true, AFTER_DRAIN = false;
    bf16_t* O; int ldc, pn_mask;
    __device__ __forceinline__ void operator()(const f32x4 (&acc)[2][2][4][2], const Unit& u, int wr, int wc, int fr, int fq) const {
        const int row0 = u.pm * BM + wr * 64 + fr, col0 = (u.pn & pn_mask) * BM + wc * 32 + 8 * fq;
#pragma unroll
        for (int ai = 0; ai < 2; ++ai)
#pragma unroll
            for (int m = 0; m < 4; ++m) { bf16_t* rowp = O + (size_t)(row0 + ai * HALF + m * 16) * ldc + col0;
#pragma unroll
                for (int bj = 0; bj < 2; ++bj) *(u32x4*)(rowp + bj * HALF) = pack8(acc[ai][bj][m][0], acc[ai][bj][m][1]); }
    }
};
struct MoeOrder {
    const PG8_LAS int* ts; int NPN, G, c;
    __device__ __forceinline__ bool next(int i, Unit& u) const {
        const int L = i * G + c, ntl = __builtin_amdgcn_readfirstlane(ts[32]);
        if (L >= ntl * NPN) return false;
        const int rt = L / NPN, pl = L - rt * NPN; int e = 0;
#pragma unroll
        for (int k = 1; k < 32; ++k) e += (ts[k] <= rt) ? 1 : 0;
        u.pm = __builtin_amdgcn_readfirstlane(rt); u.pn = __builtin_amdgcn_readfirstlane(e * NPN + pl); return true;
    }
    __device__ __forceinline__ void a_ready(const Unit&) const {}
    __device__ __forceinline__ void done(const Unit&) const {}
};

template <class Epi, class Sched, bool ALIGN_EPI = false, bool SP2 = false>
__device__ __forceinline__ void gemm_phase(PG8_LAS unsigned char* lds, const Gemm g, const Sched& S, const Epi& E) {
    const int tid = threadIdx.x, wid = __builtin_amdgcn_readfirstlane(tid >> 6), lane = tid & 63, wr = wid >> 2, wc = wid & 3, fr = lane & 15, fq = lane >> 4;
    const int K = g.K, nt = K / BK;
    unsigned voffA[2], voffB[2];
#pragma unroll
    for (int i = 0; i < 2; ++i) { int R, C; stage_rc(tid * 16 + i * 8192, R, C); const int Rb = Epi::PERM ? ((R & ~31) + perm32(R & 31)) : R;
        voffA[i] = (unsigned)(R * K + C) * 2u; voffB[i] = (unsigned)(Rb * K + C) * 2u; }
    const size_t kstep = (size_t)(BK * 2);
    const size_t hstep = (size_t)HALF * K * 2;
    const size_t tstep = 2 * hstep;
    const unsigned ldsw = (unsigned)wid * 1024u;
    const int aoff = lds_byte(wr * 64 + fr, fq * 8), boff = lds_byte(wc * 32 + fr, fq * 8);
#define PG8_SA(b, h) (((b) * 2 + (h)) * HTB)
#define PG8_SB(b, h) ((4 + (b) * 2 + (h)) * HTB)
#define PG8_STAGE(bufoff, gbase, voff) do { _Pragma("unroll") for (int _i = 0; _i < 2; ++_i) \
        __builtin_amdgcn_global_load_lds((const unsigned*)((const char*)(gbase) + (voff)[_i]), (PG8_LAS unsigned*)(lds + (bufoff) + ldsw + _i * 8192), 16, 0, 0); } while (0)
#define PG8_LDA(dst, b, h) do { _Pragma("unroll") for (int m = 0; m < 4; ++m) _Pragma("unroll") for (int k = 0; k < 2; ++k) dst[m][k] = *(const PG8_LAS bf16x8*)(lds + PG8_SA(b, h) + aoff + m * 2048 + k * 1024); } while (0)
#define PG8_LDB(dst, b, h) do { _Pragma("unroll") for (int n = 0; n < 2; ++n) _Pragma("unroll") for (int k = 0; k < 2; ++k) dst[n][k] = *(const PG8_LAS bf16x8*)(lds + PG8_SB(b, h) + boff + n * 2048 + k * 1024); } while (0)
#define PG8_MMA(ai, bj, At, Bt) do { __builtin_amdgcn_s_setprio(1); _Pragma("unroll") for (int m = 0; m < 4; ++m) _Pragma("unroll") for (int n = 0; n < 2; ++n) _Pragma("unroll") for (int k = 0; k < 2; ++k) \
        acc[ai][bj][m][n] = __builtin_amdgcn_mfma_f32_16x16x32_bf16(Bt[n][k], At[m][k], acc[ai][bj][m][n], 0, 0, 0); __builtin_amdgcn_s_setprio(0); } while (0)
#define PG8_WAIT_V(n) asm volatile("s_waitcnt vmcnt(" #n ")" ::: "memory")
#define PG8_WAIT_L(n) asm volatile("s_waitcnt lgkmcnt(" #n ")" ::: "memory")
#define PG8_BAR __builtin_amdgcn_s_barrier()
#define PG8_SCHED __builtin_amdgcn_sched_barrier(0)
    Unit cur, nxt; int ui = 0;
    if (!S.next(0, cur)) return;
    f32x4 acc[2][2][4][2];
#pragma unroll
    for (int a = 0; a < 2; ++a)
#pragma unroll
        for (int b = 0; b < 2; ++b)
#pragma unroll
            for (int m = 0; m < 4; ++m)
#pragma unroll
                for (int n = 0; n < 2; ++n) acc[a][b][m][n] = (f32x4){0.f, 0.f, 0.f, 0.f};
    bf16x8 At[4][2], B0[2][2], B1[2][2];
    const char* cA = (const char*)g.A + (size_t)cur.pm * tstep; const char* cB = (const char*)g.Bt + (size_t)cur.pn * tstep;
    S.a_ready(cur);
    if constexpr (SP2) {
        PG8_STAGE(PG8_SB(0, 0), cB, voffB); PG8_STAGE(PG8_SB(0, 1), cB + hstep, voffB); PG8_STAGE(PG8_SA(0, 0), cA, voffA); PG8_STAGE(PG8_SA(0, 1), cA + hstep, voffA);
        if (wr == 1) PG8_BAR;
        PG8_WAIT_V(2); PG8_BAR;
        PG8_STAGE(PG8_SB(1, 0), cB + kstep, voffB); PG8_STAGE(PG8_SA(1, 0), cA + kstep, voffA); PG8_STAGE(PG8_SB(1, 1), cB + hstep + kstep, voffB);
        PG8_WAIT_V(6); PG8_BAR;
    } else {
        PG8_STAGE(PG8_SB(0, 0), cB, voffB); PG8_STAGE(PG8_SA(0, 0), cA, voffA); PG8_STAGE(PG8_SB(0, 1), cB + hstep, voffB); PG8_STAGE(PG8_SA(0, 1), cA + hstep, voffA);
        if (wr == 1) PG8_BAR;
        PG8_WAIT_V(4); PG8_BAR;
        PG8_STAGE(PG8_SB(1, 0), cB + kstep, voffB); PG8_STAGE(PG8_SA(1, 0), cA + kstep, voffA); PG8_STAGE(PG8_SB(1, 1), cB + hstep + kstep, voffB);
        PG8_WAIT_V(6); PG8_BAR;
    }
    for (;;) {
        const bool has_next = S.next(ui + 1, nxt);
        const char* nA = has_next ? (const char*)g.A + (size_t)nxt.pm * tstep : cA; const char* nB = has_next ? (const char*)g.Bt + (size_t)nxt.pn * tstep : cB;
        for (int t = 0; t < nt; t += 2) {
            const bool last = (t == nt - 2);
            const char* a1 = cA + (size_t)(t + 1) * kstep;
            const char* a2 = last ? nA : cA + (size_t)(t + 2) * kstep; const char* b2 = last ? nB : cB + (size_t)(t + 2) * kstep;
            const char* a3 = a2 + kstep; const char* b3 = b2 + kstep;
            if (last && has_next) S.a_ready(nxt);
            if constexpr (SP2) {
            PG8_LDB(B0, 0, 0); PG8_LDB(B1, 0, 1); PG8_SCHED; PG8_LDA(At, 0, 0); PG8_STAGE(PG8_SA(1, 1), a1 + hstep, voffA);
            PG8_WAIT_V(8); PG8_WAIT_L(0); PG8_BAR; PG8_MMA(0, 0, At, B0); PG8_MMA(0, 1, At, B1); PG8_BAR; PG8_SCHED;
            PG8_LDA(At, 0, 1); PG8_STAGE(PG8_SB(0, 0), b2, voffB); PG8_STAGE(PG8_SB(0, 1), b2 + hstep, voffB); PG8_STAGE(PG8_SA(0, 0), a2, voffA);
            PG8_WAIT_V(8); PG8_WAIT_L(0); PG8_BAR; PG8_MMA(1, 0, At, B0); PG8_MMA(1, 1, At, B1); PG8_BAR; PG8_SCHED;
            PG8_LDB(B0, 1, 0); PG8_LDB(B1, 1, 1); PG8_SCHED; PG8_LDA(At, 1, 0); PG8_STAGE(PG8_SA(0, 1), a2 + hstep, voffA);
            PG8_WAIT_V(8); PG8_WAIT_L(0); PG8_BAR; PG8_MMA(0, 0, At, B0); PG8_MMA(0, 1, At, B1); PG8_BAR; PG8_SCHED;
            PG8_LDA(At, 1, 1); PG8_STAGE(PG8_SB(1, 0), b3, voffB); PG8_STAGE(PG8_SB(1, 1), b3 + hstep, voffB); PG8_STAGE(PG8_SA(1, 0), a3, voffA);
            PG8_WAIT_V(8); PG8_WAIT_L(0); PG8_BAR; PG8_MMA(1, 0, At, B0); PG8_MMA(1, 1, At, B1); PG8_BAR; PG8_SCHED;
            } else {
            PG8_LDB(B0, 0, 0); PG8_SCHED; PG8_LDA(At, 0, 0); PG8_STAGE(PG8_SA(1, 1), a1 + hstep, voffA);
            PG8_WAIT_L(8); PG8_BAR; PG8_WAIT_L(0); PG8_MMA(0, 0, At, B0); PG8_BAR; PG8_SCHED;
            PG8_LDB(B1, 0, 1); PG8_STAGE(PG8_SB(0, 0), b2, voffB);
            PG8_BAR; PG8_WAIT_L(0); PG8_MMA(0, 1, At, B1); PG8_BAR;
            PG8_LDA(At, 0, 1); PG8_STAGE(PG8_SA(0, 0), a2, voffA);
            PG8_BAR; PG8_WAIT_L(0); PG8_MMA(1, 0, At, B0); PG8_BAR; PG8_SCHED;
            PG8_STAGE(PG8_SB(0, 1), b2 + hstep, voffB);
            PG8_WAIT_V(6); PG8_BAR; PG8_MMA(1, 1, At, B1); PG8_BAR;
            PG8_LDB(B0, 1, 0); PG8_SCHED; PG8_LDA(At, 1, 0); PG8_STAGE(PG8_SA(0, 1), a2 + hstep, voffA);
            PG8_WAIT_L(8); PG8_BAR; PG8_WAIT_L(0); PG8_MMA(0, 0, At, B0); PG8_BAR; PG8_SCHED;
            PG8_LDB(B1, 1, 1); PG8_STAGE(PG8_SB(1, 0), b3, voffB);
            PG8_BAR; PG8_WAIT_L(0); PG8_MMA(0, 1, At, B1); PG8_BAR;
            PG8_LDA(At, 1, 1); PG8_STAGE(PG8_SA(1, 0), a3, voffA);
            PG8_BAR; PG8_WAIT_L(0); PG8_MMA(1, 0, At, B0); PG8_BAR; PG8_SCHED;
            PG8_STAGE(PG8_SB(1, 1), b3 + hstep, voffB);
            PG8_WAIT_V(6); PG8_BAR; PG8_MMA(1, 1, At, B1); PG8_BAR;
            }
        }
        if constexpr (ALIGN_EPI) { if (wr == 0) PG8_BAR; }
        if constexpr (!Epi::AFTER_DRAIN) { E(acc, cur, wr, wc, fr, fq); S.done(cur); }
        if (!has_next) break;
#pragma unroll
        for (int a = 0; a < 2; ++a)
#pragma unroll
            for (int b = 0; b < 2; ++b)
#pragma unroll
                for (int m = 0; m < 4; ++m)
#pragma unroll
                    for (int n = 0; n < 2; ++n) acc[a][b][m][n] = (f32x4){0.f, 0.f, 0.f, 0.f};
        cur = nxt; cA = nA; cB = nB; ++ui;
        if constexpr (ALIGN_EPI) { if (wr == 1) PG8_BAR; }
    }
    PG8_WAIT_V(0);
    if constexpr (!ALIGN_EPI) { if (wr == 0) PG8_BAR; }
    PG8_BAR;
    if constexpr (Epi::AFTER_DRAIN) { E.fused(acc, cur, wr, wc, fr, fq, lds, wid, lane); S.done(cur); }
#undef PG8_SA
#undef PG8_SB
#undef PG8_STAGE
#undef PG8_LDA
#undef PG8_LDB
#undef PG8_MMA
#undef PG8_WAIT_V
#undef PG8_WAIT_L
#undef PG8_BAR
#undef PG8_SCHED
}
}

#ifndef PG8_SP2
#define PG8_SP2 true
#endif
#ifndef PG8_ALIGN
#define PG8_ALIGN true
#endif
#include <hip/hip_bf16.h>
#include <cmath>
namespace attn_body {
using bf16=__hip_bfloat16;
using bf16x8=__attribute__((ext_vector_type(8)))short;
using s16x4=__attribute__((ext_vector_type(4)))short;
using f32x16=__attribute__((ext_vector_type(16)))float;
using u32x4=__attribute__((ext_vector_type(4)))unsigned;
constexpr int BATCH=2,NHEAD=16,SEQ=8192,D=64,DM=NHEAD*D,QP=512;
constexpr int NW=8,QBLK=32,QB=QBLK*NW,KVBLK=64,NQB=SEQ/QB;
constexpr int ATTN_PITCH=DM, ATTN_UNIT_ROWS=QB;
__device__ __forceinline__ int crow(int r,int hi){return (r&3)+8*(r>>2)+4*hi;}
#define SBAR() __builtin_amdgcn_sched_barrier(0)
__device__ __forceinline__ void cmask(f32x16&p0,f32x16&p1,int jb,int qrel,int hi){
  const float NEG=-INFINITY; (void)hi;
  if(jb>(qrel>>6)){
  #pragma unroll
  for(int r=0;r<16;++r){p0[r]=NEG;p1[r]=NEG;} }
}

constexpr int NSLOT=3, SLOTB=8192;
constexpr int LDS_K=0, LDS_V=NSLOT*SLOTB, LDS_WS=2*NSLOT*SLOTB, LDS_OST=LDS_WS+NW*64*4, LDS_BYTES=LDS_OST+NW*4096;
constexpr float C2=0.125f*1.4426950408889634f;
__device__ __forceinline__ void glds16(const void*gsrc,unsigned lds_dst){unsigned keep;
  asm volatile("s_mov_b32 %0, m0\n\ts_mov_b32 m0, %2\n\ts_nop 0\n\tglobal_load_lds_dwordx4 %1, off\n\ts_mov_b32 m0, %0":"=&s"(keep):"v"(gsrc),"s"(lds_dst):"memory");}
__device__ __forceinline__ float max3f(float a,float b,float c){float r;asm("v_max3_f32 %0, %1, %2, %3":"=v"(r):"v"(a),"v"(b),"v"(c));return r;}
__device__ __forceinline__ float max2f(float a,float b){float r;asm("v_max_f32_e32 %0, %1, %2":"=v"(r):"v"(a),"v"(b));return r;}
__device__ __forceinline__ float fadd_s(float a,float b){float r;asm("v_add_f32_e32 %0, %1, %2":"=v"(r):"v"(a),"v"(b));return r;}
__device__ __forceinline__ float fsub_s(float a,float b){float r;asm("v_sub_f32_e32 %0, %1, %2":"=v"(r):"v"(a),"v"(b));return r;}
typedef float f32x2_t __attribute__((ext_vector_type(2))); typedef __bf16 bf16x2_t __attribute__((ext_vector_type(2)));
__device__ __forceinline__ unsigned cvtpk_s(float lo,float hi){f32x2_t v={lo,hi};bf16x2_t b=__builtin_convertvector(v,bf16x2_t);return __builtin_bit_cast(unsigned,b);}
#define WAIT_BAR(N) asm volatile("s_waitcnt vmcnt(" #N ") lgkmcnt(0)\n\ts_barrier":::"memory")

__device__ __forceinline__ void qkt(f32x16&p0,f32x16&p1,const char*Kslot,const bf16x8*qr,const f32x16&negm,int r32,int hi){
  const char*kb=Kslot+hi*1024+r32*16;
  #pragma unroll
  for(int d0=0;d0<4;++d0){
    const bf16x8 b0=*reinterpret_cast<const bf16x8*>(kb+d0*2048);
    const bf16x8 b1=*reinterpret_cast<const bf16x8*>(kb+d0*2048+512);
    if(d0==0){p0=__builtin_amdgcn_mfma_f32_32x32x16_bf16(b0,qr[0],negm,0,0,0);p1=__builtin_amdgcn_mfma_f32_32x32x16_bf16(b1,qr[0],negm,0,0,0);}
    else{p0=__builtin_amdgcn_mfma_f32_32x32x16_bf16(b0,qr[d0],p0,0,0,0);p1=__builtin_amdgcn_mfma_f32_32x32x16_bf16(b1,qr[d0],p1,0,0,0);}}
}
typedef __attribute__((address_space(3))) const char* lds_cptr;
typedef short v4i16_t __attribute__((ext_vector_type(4)));
__device__ __forceinline__ void kload8(bf16x8*kf,lds_cptr kp){
  kf[0]=*(const __attribute__((address_space(3))) bf16x8*)(kp);      kf[1]=*(const __attribute__((address_space(3))) bf16x8*)(kp+512);
  kf[2]=*(const __attribute__((address_space(3))) bf16x8*)(kp+2048); kf[3]=*(const __attribute__((address_space(3))) bf16x8*)(kp+2560);
  kf[4]=*(const __attribute__((address_space(3))) bf16x8*)(kp+4096); kf[5]=*(const __attribute__((address_space(3))) bf16x8*)(kp+4608);
  kf[6]=*(const __attribute__((address_space(3))) bf16x8*)(kp+6144); kf[7]=*(const __attribute__((address_space(3))) bf16x8*)(kp+6656);
}
__device__ __forceinline__ void kload2(bf16x8*kf,lds_cptr kp,int j){ kf[2*j]=*(const __attribute__((address_space(3))) bf16x8*)(kp+j*2048); kf[2*j+1]=*(const __attribute__((address_space(3))) bf16x8*)(kp+j*2048+512); }
__device__ __forceinline__ s16x4 vtr(lds_cptr p){ return __builtin_bit_cast(s16x4,__builtin_amdgcn_ds_read_tr16_b64_v4i16((__attribute__((address_space(3))) v4i16_t*)p)); }
__device__ __forceinline__ float rowmax(const f32x16&p0,const f32x16&p1){
  float a=max3f(p0[0],p0[1],p1[0]),b=max3f(p0[2],p0[3],p1[1]);a=max3f(a,p1[2],p1[3]);
  #pragma unroll
  for(int r=4;r<16;r+=4){a=max3f(a,p0[r],p0[r+1]);b=max3f(b,p0[r+2],p0[r+3]);a=max3f(a,p1[r],p1[r+1]);b=max3f(b,p1[r+2],p1[r+3]);}
  const float m=max2f(a,b);
  auto rr=__builtin_amdgcn_permlane32_swap(__float_as_uint(m),__float_as_uint(m),false,false);
  return max2f(__uint_as_float(rr[0]),__uint_as_float(rr[1]));
}
__device__ __forceinline__ void pv(f32x16*o,int vb,bf16x8 pa0,bf16x8 pa1,bf16x8 pa2,bf16x8 pa3){
  #pragma unroll
  for(int d0=0;d0<2;++d0){s16x4 lo[4],hi[4];
    #pragma unroll
    for(int ks=0;ks<4;++ks){
      asm volatile("ds_read_b64_tr_b16 %0,%1 offset:%c2":"=&v"(lo[ks]):"v"(vb),"i"(d0*4096+ks*1024):"memory");
      asm volatile("ds_read_b64_tr_b16 %0,%1 offset:%c2":"=&v"(hi[ks]):"v"(vb),"i"(d0*4096+ks*1024+512):"memory");}
    asm volatile("s_waitcnt lgkmcnt(0)":::"memory");SBAR();
    #define PK(k) (bf16x8){lo[k][0],lo[k][1],lo[k][2],lo[k][3],hi[k][0],hi[k][1],hi[k][2],hi[k][3]}
    o[d0]=__builtin_amdgcn_mfma_f32_32x32x16_bf16(pa0,PK(0),o[d0],0,0,0);
    o[d0]=__builtin_amdgcn_mfma_f32_32x32x16_bf16(pa1,PK(1),o[d0],0,0,0);
    o[d0]=__builtin_amdgcn_mfma_f32_32x32x16_bf16(pa2,PK(2),o[d0],0,0,0);
    o[d0]=__builtin_amdgcn_mfma_f32_32x32x16_bf16(pa3,PK(3),o[d0],0,0,0);
    #undef PK
  }
}

#ifndef ATTN_STORE16
#define ATTN_STORE16(p,v) (*(u32x4*)(p)=(v))
#endif
template<int THRL> __device__ __forceinline__ void attn_unit(int b,int qcol,int vcol,int ocol,int qb,const bf16*Q,const bf16*__restrict__ K,const bf16*__restrict__ V,bf16*O,char*shm){
  const int tid=threadIdx.x,lane=tid&63,r32=lane&31,hi=lane>>5; const int wid=__builtin_amdgcn_readfirstlane(tid>>6);
  const long rowbase=(long)b*SEQ; const int q0=qb*QB;
  const bf16*Qw=Q+(rowbase+q0+wid*QBLK)*QP+qcol;
  const bf16*Kh=K+rowbase*QP+qcol,*Vh=V+rowbase*QP+vcol;
  const unsigned lds0=(unsigned)(uintptr_t)shm;
  float*wsf=(float*)(shm+LDS_WS)+wid*64;
  const bf16*ksrc=Kh+(long)lane*QP+wid*8;
  const bf16*vsrc=Vh+(long)(16*(wid&3)+(lane>>2))*QP+(wid>>2)*32+(lane&3)*8;
  const unsigned kdst=lds0+LDS_K+wid*1024, vdst=lds0+LDS_V+wid*1024;
  #define DMA_K(t,slot) glds16(ksrc+(long)(t)*KVBLK*QP,(unsigned)__builtin_amdgcn_readfirstlane(kdst+(slot)))
  #define DMA_V(t,slot) glds16(vsrc+(long)(t)*KVBLK*QP,(unsigned)__builtin_amdgcn_readfirstlane(vdst+(slot)))
  const int vb0=(int)(lds0+LDS_V)+((lane>>4)&1)*32+(lane&3)*8+(4*hi+((lane&15)>>2))*64;
  const char*Kbase=shm+LDS_K; bf16x8 kf[8];
  const lds_cptr shm3=(lds_cptr)shm; const lds_cptr kp0=shm3+LDS_K+hi*1024+r32*16; const lds_cptr vp0=shm3+LDS_V+((lane>>4)&1)*32+(lane&3)*8+(4*hi+((lane&15)>>2))*64;
  const int NT=(q0+QB)/KVBLK;
  DMA_K(0,0);DMA_V(0,0);DMA_K(1,SLOTB);
  bf16x8 qr[4];
  #pragma unroll
  for(int d0=0;d0<4;++d0)qr[d0]=*reinterpret_cast<const bf16x8*>(&Qw[(long)r32*QP+d0*16+hi*8]);
  float mhat=0.f,l_reg=0.f;f32x16 o[2];o[0]=f32x16{};o[1]=f32x16{};f32x16 negm=f32x16{};asm volatile("":"+v"(negm));
  const int qrel=wid*QBLK+r32;
  #define CMASK(P0,P1,t) do{int jb_=(t)-(NT-4); if(jb_>=0)cmask(P0,P1,jb_,qrel,hi);}while(0)
  bool resc=false;
  #define START(P0,P1) do{ const float rm=rowmax(P0,P1); resc=false; \
    { const float dl=rm; mhat=fadd_s(mhat,dl); \
      _Pragma("unroll") for(int r=0;r<16;++r){P0[r]=fsub_s(P0[r],dl);P1[r]=fsub_s(P1[r],dl);} \
      _Pragma("unroll") for(int r=0;r<16;++r)negm[r]=-mhat; asm volatile("":"+v"(negm)); } \
    _Pragma("unroll") for(int r=0;r<16;++r)P0[r]=__builtin_amdgcn_exp2f(P0[r]); }while(0)
  #define RESC() do{ if(resc){ asm volatile("s_waitcnt lgkmcnt(0)":::"memory"); \
      _Pragma("unroll") for(int d_=0;d_<2;++d_) _Pragma("unroll") for(int r=0;r<16;++r)o[d_][r]*=wsf[crow(r,hi)]; } }while(0)
  f32x16 pA0,pA1,pB0,pB1;
  int sl_prev=0,sl_cur=0,sl_next=SLOTB;
  #define ROT() do{sl_prev=sl_cur;sl_cur=sl_next;sl_next=(sl_next==(NSLOT-1)*SLOTB)?0:sl_next+SLOTB;}while(0)
  DMA_K(2,2*SLOTB);
  WAIT_BAR(3);
  qkt(pA0,pA1,Kbase,qr,negm,r32,hi);asm volatile("s_nop 15\n\ts_nop 7":"+v"(pA0),"+v"(pA1));CMASK(pA0,pA1,0);
  START(pA0,pA1);
  _Pragma("unroll") for(int r=0;r<16;++r)pA1[r]=__builtin_amdgcn_exp2f(pA1[r]);
  WAIT_BAR(0);
  DMA_K(3,0);DMA_V(1,SLOTB);
  ROT();
  kload8(kf,kp0+sl_cur);
  WAIT_BAR(2);
  s16x4 vlo[8],vhi[8]; u32x4 pw0,pw1,pw2,pw3;
  #define PKW(P,B) cvtpk_s(P[B],P[B+1])
  #define PAF(k) __builtin_bit_cast(bf16x8,pw##k)
  #define VFR(i) (bf16x8){vlo[i][0],vlo[i][1],vlo[i][2],vlo[i][3],vhi[i][0],vhi[i][1],vhi[i][2],vhi[i][3]}
  #define PIN(x) asm volatile("":"+v"(x))
  #define MX3(a,b,c) __builtin_fmaxf(__builtin_fmaxf((a),(b)),(c))
  #define GAPA(MF,A0,A1,A2,A3,W0,W1,PW) do{ MF; sacc+=A0; sacc+=A1; sacc+=A2; sacc+=A3; PIN(sacc); W0; W1; PIN(PW); SBAR(); }while(0)
  #define EX(v) __builtin_amdgcn_exp2f(v)
  #define GAPB(MF,X,B) do{ MF; X[B]=EX(X[B]); X[B+1]=EX(X[B+1]); X[B+2]=EX(X[B+2]); X[B+3]=EX(X[B+3]); PIN(X); SBAR(); }while(0)
  #define VRD(i) do{ vlo[i]=vtr(vp_+(((i)>>2)*4096+((i)&3)*1024)); vhi[i]=vtr(vp_+(((i)>>2)*4096+((i)&3)*1024+512)); }while(0)
  #define KRD(G,j) do{ if(G){ kload2(kf,kp0+sl_next,j); SBAR(); } }while(0)
  #define STEP(C0,C1,P0,P1,t,GK,GV,GL) do{ SBAR(); \
    const lds_cptr vp_=vp0+sl_prev; \
    VRD(0); SBAR(); float sacc=(P0[0]+P0[1]); \
    GAPA(C0=__builtin_amdgcn_mfma_f32_32x32x16_bf16(kf[0],qr[0],negm,0,0,0), P0[2],P0[3],P0[4],P0[5],     pw0[0]=PKW(P0,0), pw0[1]=PKW(P0,2), pw0); \
    VRD(4); SBAR(); GAPA(C1=__builtin_amdgcn_mfma_f32_32x32x16_bf16(kf[1],qr[0],negm,0,0,0), P0[6],P0[7],P0[8],P0[9],     pw0[2]=PKW(P0,4), pw0[3]=PKW(P0,6), pw0); \
    VRD(1); SBAR(); GAPA(C0=__builtin_amdgcn_mfma_f32_32x32x16_bf16(kf[2],qr[1],C0,0,0,0),   P0[10],P0[11],P0[12],P0[13], pw1[0]=PKW(P0,8), pw1[1]=PKW(P0,10), pw1); \
    VRD(5); SBAR(); GAPA(C1=__builtin_amdgcn_mfma_f32_32x32x16_bf16(kf[3],qr[1],C1,0,0,0),   P0[14],P0[15],P1[0],P1[1],   pw1[2]=PKW(P0,12),pw1[3]=PKW(P0,14), pw1); \
    VRD(2); SBAR(); GAPA(C0=__builtin_amdgcn_mfma_f32_32x32x16_bf16(kf[4],qr[2],C0,0,0,0),   P1[2],P1[3],P1[4],P1[5],     pw2[0]=PKW(P1,0), pw2[1]=PKW(P1,2), pw2); \
    VRD(6); SBAR(); GAPA(C1=__builtin_amdgcn_mfma_f32_32x32x16_bf16(kf[5],qr[2],C1,0,0,0),   P1[6],P1[7],P1[8],P1[9],     pw2[2]=PKW(P1,4), pw2[3]=PKW(P1,6), pw2); \
    VRD(3); SBAR(); GAPA(C0=__builtin_amdgcn_mfma_f32_32x32x16_bf16(kf[6],qr[3],C0,0,0,0),   P1[10],P1[11],P1[12],P1[13], pw3[0]=PKW(P1,8), pw3[1]=PKW(P1,10), pw3); \
    VRD(7); SBAR(); GAPA(C1=__builtin_amdgcn_mfma_f32_32x32x16_bf16(kf[7],qr[3],C1,0,0,0),   P1[14],P1[15],0.f,0.f,       pw3[2]=PKW(P1,12),pw3[3]=PKW(P1,14), pw3); \
    l_reg+=sacc; \
    if(GK){DMA_K((t)+3,sl_cur);} if(GV){DMA_V((t)+1,sl_next);} \
    CMASK(C0,C1,t); \
    { float a=MX3(C0[0],C0[1],C1[0]),b=MX3(C0[2],C0[3],C1[1]); a=MX3(a,C1[2],C1[3]); \
      _Pragma("unroll") for(int r=4;r<16;r+=4){a=MX3(a,C0[r],C0[r+1]);b=MX3(b,C0[r+2],C0[r+3]);a=MX3(a,C1[r],C1[r+1]);b=MX3(b,C1[r+2],C1[r+3]);} \
      float rm=__builtin_fmaxf(a,b); { auto rr=__builtin_amdgcn_permlane32_swap(__float_as_uint(rm),__float_as_uint(rm),false,false); rm=__builtin_fmaxf(__uint_as_float(rr[0]),__uint_as_float(rr[1])); } \
      resc=false; \
      if(__builtin_expect(__any(rm>(float)THRL),0)){ const float dl=__builtin_fmaxf(rm,0.f); mhat+=dl; \
        _Pragma("unroll") for(int r=0;r<16;++r){C0[r]-=dl;C1[r]-=dl;} \
        _Pragma("unroll") for(int r=0;r<16;++r)negm[r]=-mhat; asm volatile("":"+v"(negm)); \
        const float f=__builtin_amdgcn_exp2f(-dl); l_reg*=f; if(hi==0)wsf[r32]=f; resc=true; } } \
    SBAR(); \
    GAPB(o[0]=__builtin_amdgcn_mfma_f32_32x32x16_bf16(PAF(0),VFR(0),o[0],0,0,0), C0,0); \
    GAPB(o[1]=__builtin_amdgcn_mfma_f32_32x32x16_bf16(PAF(0),VFR(4),o[1],0,0,0), C0,4); \
    KRD(GL,0); GAPB(o[0]=__builtin_amdgcn_mfma_f32_32x32x16_bf16(PAF(1),VFR(1),o[0],0,0,0), C0,8); \
    KRD(GL,1); GAPB(o[1]=__builtin_amdgcn_mfma_f32_32x32x16_bf16(PAF(1),VFR(5),o[1],0,0,0), C0,12); \
    KRD(GL,2); GAPB(o[0]=__builtin_amdgcn_mfma_f32_32x32x16_bf16(PAF(2),VFR(2),o[0],0,0,0), C1,0); \
    KRD(GL,3); GAPB(o[1]=__builtin_amdgcn_mfma_f32_32x32x16_bf16(PAF(2),VFR(6),o[1],0,0,0), C1,4); \
    GAPB(o[0]=__builtin_amdgcn_mfma_f32_32x32x16_bf16(PAF(3),VFR(3),o[0],0,0,0), C1,8); \
    GAPB(o[1]=__builtin_amdgcn_mfma_f32_32x32x16_bf16(PAF(3),VFR(7),o[1],0,0,0), C1,12); \
    }while(0)
  int t=1;
  #undef CMASK
  #define CMASK(P0,P1,t) do{}while(0)
  for(;t+5<NT;t+=2){
    STEP(pB0,pB1,pA0,pA1,t,true,true,true);     WAIT_BAR(2); RESC(); ROT();
    STEP(pA0,pA1,pB0,pB1,t+1,true,true,true);   WAIT_BAR(2); RESC(); ROT();
  }
  #undef CMASK
  #define CMASK(P0,P1,t) do{int jb_=(t)-(NT-4); if(jb_>=0)cmask(P0,P1,jb_,qrel,hi);}while(0)
  #define ENDW(tt) do{ if((tt)+3<NT){WAIT_BAR(2);} else if((tt)+2<NT){WAIT_BAR(1);} else {WAIT_BAR(0);} }while(0)
  for(;t+1<NT;t+=2){
    STEP(pB0,pB1,pA0,pA1,t,(t+3<NT),(t+1<NT),(t+1<NT));       ENDW(t);   RESC(); ROT();
    STEP(pA0,pA1,pB0,pB1,t+1,(t+4<NT),(t+2<NT),(t+2<NT));     ENDW(t+1); RESC(); ROT();
  }
  STEP(pB0,pB1,pA0,pA1,NT-1,false,false,false); RESC();
  { float sacc=pB0[0]+pB0[1]; _Pragma("unroll") for(int r=2;r<16;++r)sacc+=pB0[r]; _Pragma("unroll") for(int r=0;r<16;++r)sacc+=pB1[r]; l_reg+=sacc;
    pw0=(u32x4){PKW(pB0,0),PKW(pB0,2),PKW(pB0,4),PKW(pB0,6)};pw1=(u32x4){PKW(pB0,8),PKW(pB0,10),PKW(pB0,12),PKW(pB0,14)};pw2=(u32x4){PKW(pB1,0),PKW(pB1,2),PKW(pB1,4),PKW(pB1,6)};pw3=(u32x4){PKW(pB1,8),PKW(pB1,10),PKW(pB1,12),PKW(pB1,14)};
    SBAR(); pv(o,vb0+sl_cur,PAF(0),PAF(1),PAF(2),PAF(3)); }
  #undef PKW
  #undef PAF
  #undef VFR
  #undef PIN
  #undef MX3
  #undef GAPA
  #undef GAPB
  #undef EX
  #undef VRD
  #undef KRD
  #undef STEP
  #undef ENDW
  {auto rr=__builtin_amdgcn_permlane32_swap(__float_as_uint(l_reg),__float_as_uint(l_reg),false,false);l_reg=__uint_as_float(rr[0])+__uint_as_float(rr[1]);}
  if(hi==0)wsf[32+r32]=l_reg;asm volatile("s_waitcnt lgkmcnt(0)":::"memory");
  float rli[16];
  #pragma unroll
  for(int r=0;r<16;++r)rli[r]=__builtin_amdgcn_rcpf(wsf[32+crow(r,hi)]);
  bf16*Ow=O+(rowbase+q0+wid*QBLK)*DM+ocol;
  { bf16*stg=(bf16*)(shm+LDS_OST)+wid*2048;
    #pragma unroll
    for(int r=0;r<16;++r){const int orow=crow(r,hi);
      #pragma unroll
      for(int d0=0;d0<2;++d0)stg[orow*64+d0*32+r32]=__float2bfloat16(o[d0][r]*rli[r]);}
    asm volatile("s_waitcnt lgkmcnt(0)":::"memory");
    #pragma unroll
    for(int i=0;i<4;++i){const int row=i*8+(lane>>3),ch=lane&7; const u32x4 v=*(const u32x4*)(stg+row*64+ch*8); ATTN_STORE16(Ow+(long)row*DM+ch*8,v);} }
  asm volatile("s_waitcnt lgkmcnt(0)\n\ts_barrier":::"memory");
  #undef DMA_K
  #undef DMA_V
  #undef CMASK
  #undef START
  #undef RESC
  #undef ROT
}
constexpr int ATTN_LDS_BYTES=LDS_BYTES;
struct AttnTensors { const bf16* Q; const bf16* K; const bf16* V; bf16* O; };
struct AttnUnit { int bh; int qb; };
struct StaticOrder {
  int vcu;
  __device__ __forceinline__ explicit StaticOrder(int grid,int block):vcu((block%8)*(grid/8)+block/8){}
  __device__ __forceinline__ bool next(int i,AttnUnit&u)const{ if(i>=4)return false; const int s=vcu&7; u.bh=vcu>>3; u.qb=(i==0)?s:(i==1)?15-s:(i==2)?16+s:31-s; return true; }
  __device__ __forceinline__ void a_ready(const AttnUnit&)const{}
  __device__ __forceinline__ void done(const AttnUnit&)const{}
};
template<class Sched,int THRL=8> __device__ __forceinline__ void attn_phase(char*lds,const AttnTensors&T,const Sched&S){
  AttnUnit u;
  for(int i=0;S.next(i,u);++i){ S.a_ready(u); { const int hp=u.bh%NHEAD; attn_unit<THRL>(u.bh/NHEAD,(hp>>1)*64,(hp>>2)*128+(hp&1)*64,hp*64,u.qb,T.Q,T.K,T.V,T.O,lds); } S.done(u); }
}
#undef SBAR
#undef WAIT_BAR
}

constexpr int NWAVES = 8;
constexpr int BATCH = 2, T = 8192, D = 1024, M = BATCH * T;
constexpr int NPROJ = 5632;
constexpr int IN_W = 5640;
constexpr float EPS = 1e-6f;
constexpr int NE = 32, FH = 256;
constexpr int XG_ROWS = 160 * 256;
constexpr int N_PHASES = 12;

constexpr size_t MiB = 1u << 20;
constexpr size_t WS_CTL = 0, CTL_ZERO_BYTES = 1 * MiB;
constexpr size_t WS_WIN = 1 * MiB;
constexpr size_t WS_WA = 12 * MiB, WS_WB = 13 * MiB, WS_WOUT = 14 * MiB;
constexpr size_t WS_BD = 16 * MiB;
constexpr size_t WS_POS = 16 * MiB + 512 * 1024;
constexpr size_t WS_ROWW = 17 * MiB;
constexpr size_t WS_ROUTE = 17 * MiB + 256 * 1024;
constexpr size_t WS_WR = 17 * MiB + 512 * 1024;
constexpr size_t WS_GU = 18 * MiB;
constexpr size_t WS_DN = 50 * MiB;
constexpr size_t WS_H = 66 * MiB;
constexpr size_t WS_Q = 98 * MiB, WS_K = 114 * MiB, WS_V = 130 * MiB;
constexpr size_t WS_G = 146 * MiB;
constexpr size_t WS_GATE = 194 * MiB;
constexpr size_t WS_XG = 146 * MiB;
constexpr size_t WS_YG = 66 * MiB;
constexpr size_t WS_ACT = 226 * MiB;
constexpr size_t WS_END = 256 * MiB;
static_assert(WS_XG + (size_t)XG_ROWS * 1024 * 2 <= WS_ACT && WS_ACT + (size_t)XG_ROWS * 256 * 2 <= WS_END && WS_YG + (size_t)XG_ROWS * 1024 * 2 <= WS_XG, "ws map");
static_assert(WS_WR + 36 * 1024 * 4 <= WS_GU && WS_ROWW + XG_ROWS * 4 <= WS_ROUTE && WS_ROUTE + (size_t)M * 16 <= WS_WR, "ws map small");
constexpr int CW_TMO = 0, CW_CODE = 1;
constexpr int CW_BAR = 4096;
constexpr int CW_CNT = 16384, CW_CUR = 16384 + 32 * 64;
constexpr int RING_OFF = 0, RING_BYTES = 131072;
constexpr int LDSCTL_OFF = RING_BYTES, MISC_OFF = LDSCTL_OFF + 320;
constexpr int TS_OFF = MISC_OFF + 128;
constexpr int GDN_AB_OFF = LDSCTL_OFF + 1024;
constexpr int LDS_BYTES = 147456;

#define GAS __attribute__((address_space(1)))
#define LAS __attribute__((address_space(3)))
typedef unsigned short bf16;
typedef unsigned v4u __attribute__((ext_vector_type(4)));
typedef unsigned v2u __attribute__((ext_vector_type(2)));
typedef float f32x4 __attribute__((ext_vector_type(4)));
typedef GAS unsigned gu32;
#define RLX_AGENT __ATOMIC_RELAXED, __HIP_MEMORY_SCOPE_AGENT
#define LDS_WAIT() asm volatile("s_waitcnt lgkmcnt(0)" ::: "memory")
#define VM_WAIT() asm volatile("s_waitcnt vmcnt(0)" ::: "memory")
__device__ __forceinline__ unsigned f2bf(float f) { unsigned u = __builtin_bit_cast(unsigned, f); return (u + 0x7fffu + ((u >> 16) & 1u)) >> 16; }
__device__ __forceinline__ unsigned pk2(float lo, float hi) { return f2bf(lo) | (f2bf(hi) << 16); }
__device__ __forceinline__ float bflo(unsigned w) { return __uint_as_float(w << 16); }
__device__ __forceinline__ float bfhi(unsigned w) { return __uint_as_float(w & 0xffff0000u); }
__device__ __forceinline__ float sigm(float x) { return 1.0f / (1.0f + __expf(-x)); }

#define XB_TMO      128
#define XB_XCNT(j)  (256  + 64 * (j))
#define XB_XSUB(j)  (1280 + 64 * (j))
#define XB_XGEN(j)  (2304 + 64 * (j))
#define XB_TOP      3328
#define XB_TOPGEN   3392
#define XCD_BAR_WORDS 3456
#define XB_SPIN_CAP (1u << 22)
__device__ __forceinline__ unsigned xb_ld(unsigned* p)              { return __hip_atomic_load(p, __ATOMIC_RELAXED, __HIP_MEMORY_SCOPE_AGENT); }
__device__ __forceinline__ unsigned xb_add(unsigned* p, unsigned v) { return __hip_atomic_fetch_add(p, v, __ATOMIC_RELAXED, __HIP_MEMORY_SCOPE_AGENT); }
__device__ __forceinline__ unsigned xb_xcc_id() { return (unsigned)__builtin_amdgcn_s_getreg((3 << 11) | 20) & 0xFu; }
#define XB_SPIN(cond, bar) do { unsigned _sp = 0; while (cond) { __builtin_amdgcn_s_sleep(1); \
    if ((++_sp & 255u) == 0u) { if (xb_ld(&(bar)[XB_TMO])) break; if (_sp > XB_SPIN_CAP) { atomicAdd(&(bar)[XB_TMO], 1u); break; } } } } while (0)
struct XcdBarrier { unsigned* bar; unsigned x; volatile LAS unsigned* st; };
__device__ __forceinline__ XcdBarrier xcd_barrier_post(unsigned* bar, volatile LAS unsigned* st) {
    XcdBarrier b; b.bar = bar; b.x = xb_xcc_id(); b.st = st;
    if (threadIdx.x == 0) (void)xb_add(&bar[XB_XCNT(b.x)], 1u);
    return b;
}
__device__ __forceinline__ void xcd_barrier_complete(unsigned* bar, unsigned x, unsigned& nloc, unsigned& nx) {
    const unsigned G = gridDim.x * gridDim.y * gridDim.z;
    unsigned sum, cnt, mine, sp = 0u;
    for (;;) {
        sum = 0u; cnt = 0u; mine = 0u;
#pragma unroll
        for (unsigned j = 0; j < 16; ++j) { const unsigned c = xb_ld(&bar[XB_XCNT(j)]); sum += c; cnt += (c > 0u) ? 1u : 0u; mine = (j == x) ? c : mine; }
        if (sum == G) break;
        __builtin_amdgcn_s_sleep(1);
        if ((++sp & 255u) == 0u) { if (xb_ld(&bar[XB_TMO])) break; if (sp > XB_SPIN_CAP) { atomicAdd(&bar[XB_TMO], 1u); break; } }
    }
    nloc = mine > 0u ? mine : 1u; nx = cnt > 0u ? cnt : 1u;
}
__device__ __forceinline__ void xcd_barrier(const XcdBarrier& b) {
    asm volatile("s_waitcnt vmcnt(0)" ::: "memory");
    __syncthreads();
    if (threadIdx.x == 0) {
        unsigned* bar = b.bar;
        __builtin_amdgcn_s_waitcnt(0);
        unsigned nloc = b.st[0], nx = b.st[1];
        if (nloc == 0u) { xcd_barrier_complete(bar, b.x, nloc, nx); b.st[0] = nloc; b.st[1] = nx; }
        const unsigned old = xb_add(&bar[XB_XSUB(b.x)], 1u);
        const unsigned gen = old / nloc;
        if (old + 1u == (gen + 1u) * nloc) {
            __builtin_amdgcn_fence(__ATOMIC_RELEASE, "agent");
            asm volatile("s_waitcnt vmcnt(0)" ::: "memory");
            const unsigned og = xb_add(&bar[XB_TOP], 1u);
            const unsigned tg = og / nx;
            if (og + 1u == (tg + 1u) * nx) xb_add(&bar[XB_TOPGEN], 1u);
            else XB_SPIN(xb_ld(&bar[XB_TOPGEN]) == tg, bar);
            __builtin_amdgcn_fence(__ATOMIC_ACQUIRE, "agent");
            xb_add(&bar[XB_XGEN(b.x)], 1u);
            asm volatile("s_waitcnt vmcnt(0)" ::: "memory");
        } else {
            XB_SPIN(xb_ld(&bar[XB_XGEN(b.x)]) == gen, bar);
            __builtin_amdgcn_fence(__ATOMIC_ACQUIRE, "agent");
            asm volatile("s_waitcnt vmcnt(0)" ::: "memory");
        }
    }
    __syncthreads();
}

#define CAS __attribute__((address_space(4)))
struct Args { const float* in[24]; float* out; unsigned char* ws; int ph_lo, ph_hi; };
#define FIN(k) (F.ka->in[k])
struct Frame {
    LAS unsigned char* lds;
    volatile LAS unsigned* MISC;
    gu32* ctl;
    int tid, lane, wave;
    int vcu, G;
    unsigned char* ws;
    float* out;
    const CAS Args* ka;
};
__device__ __forceinline__ float wave_sum(float v) {
#pragma unroll
    for (int o = 1; o < 64; o <<= 1) v += __shfl_xor(v, o);
    return v;
}
__device__ __forceinline__ void p0_transpose_item(const float* W, int ldw, int col0, int K, int nblk, bf16* WT, int dst_row0, LAS float* scr, int item, int lane) {
    const int kb = item / nblk, nb = item % nblk, k0 = 64 * kb, n0 = 32 * nb;
#pragma unroll 8
    for (int i = 0; i < 32; ++i) { const int kk = 2 * i + (lane >> 5); scr[kk * 33 + (lane & 31)] = W[(size_t)(k0 + kk) * ldw + col0 + n0 + (lane & 31)]; }
    LDS_WAIT(); asm volatile("" ::: "memory");
    const int c = lane & 7;
#pragma unroll
    for (int j = 0; j < 4; ++j) { const int n = (lane >> 3) + 8 * j; const LAS float* s = scr + (8 * c) * 33 + n;
        v4u o; o.x = pk2(s[0 * 33], s[1 * 33]); o.y = pk2(s[2 * 33], s[3 * 33]); o.z = pk2(s[4 * 33], s[5 * 33]); o.w = pk2(s[6 * 33], s[7 * 33]);
        *(GAS v4u*)(WT + (size_t)(dst_row0 + n0 + n) * K + k0 + 8 * c) = o; }
    LDS_WAIT(); asm volatile("" ::: "memory");
}

__device__ __forceinline__ void p0_prologue(Frame& F) {
    LAS float* scr = (LAS float*)(F.lds + RING_OFF + F.wave * 16384);
    const int gw = F.vcu * NWAVES + F.wave, NGW = F.G * NWAVES;
    bf16* WIN = (bf16*)(F.ws + WS_WIN); bf16* WA = (bf16*)(F.ws + WS_WA); bf16* WB = (bf16*)(F.ws + WS_WB); bf16* WO = (bf16*)(F.ws + WS_WOUT);
    bf16* GU = (bf16*)(F.ws + WS_GU); bf16* DN = (bf16*)(F.ws + WS_DN);
    constexpr int I_IN0 = 16 * 96, I_IN1 = 16 * 16, I_IN2 = 16 * 32, I_IN3 = 16 * 32;
    constexpr int I_A = 8 * 32, I_B = 8 * 32, I_O = 16 * 32;
    constexpr int I_G1 = 16 * 4;
    constexpr int I_GU = NE * 4 * I_G1, I_DN = NE * 4 * 32;
    constexpr int NITEMS = I_IN0 + I_IN1 + I_IN2 + I_IN3 + I_A + I_B + I_O + I_GU + I_DN;
    for (int it = gw; it < NITEMS; it += NGW) {
        int r = it;
        if (r < I_IN0) { p0_transpose_item(FIN(2), IN_W, 0, D, 96, WIN, 0, scr, r, F.lane); continue; } r -= I_IN0;
        if (r < I_IN1) { p0_transpose_item(FIN(2), IN_W, 3080, D, 16, WIN, 3072, scr, r, F.lane); continue; } r -= I_IN1;
        if (r < I_IN2) { p0_transpose_item(FIN(2), IN_W, 3592, D, 32, WIN, 3584, scr, r, F.lane); continue; } r -= I_IN2;
        if (r < I_IN3) { p0_transpose_item(FIN(2), IN_W, 4616, D, 32, WIN, 4608, scr, r, F.lane); continue; } r -= I_IN3;
        if (r < I_A) { p0_transpose_item(FIN(12), 1024, 0, 512, 32, WA, 0, scr, r, F.lane); continue; } r -= I_A;
        if (r < I_B) { p0_transpose_item(FIN(13), 1024, 0, 512, 32, WB, 0, scr, r, F.lane); continue; } r -= I_B;
        if (r < I_O) { p0_transpose_item(FIN(14), 1024, 0, 1024, 32, WO, 0, scr, r, F.lane); continue; } r -= I_O;
        if (r < I_GU) { const int blk = r / I_G1, i2 = r % I_G1, e = blk >> 2, pn = (blk >> 1) & 1, isup = blk & 1;
            p0_transpose_item((isup ? FIN(21) : FIN(20)) + (size_t)e * 1024 * 256, 256, 128 * pn, 1024, 4, GU, e * 512 + 256 * pn + 128 * isup, scr, i2, F.lane); continue; } r -= I_GU;
        { const int e = r / 128, i2 = r % 128; p0_transpose_item(FIN(22) + (size_t)e * 256 * 1024, 1024, 0, 256, 32, DN, e * 1024, scr, i2, F.lane); }
    }
    { float* WR = (float*)(F.ws + WS_WR); const int gt = F.vcu * (NWAVES * 64) + F.tid, NT = F.G * NWAVES * 64;
      for (int i = gt; i < 36 * 1024; i += NT) { const int c = i >> 10, k = i & 1023; WR[i] = (c < 4) ? FIN(16)[k * 4 + c] : FIN(18)[k * 32 + (c - 4)]; } }
    __syncthreads();
    LAS float* W8 = (LAS float*)(F.lds + RING_OFF);
    for (int i = F.tid; i < 1024 * 8; i += NWAVES * 64) W8[i] = FIN(2)[(size_t)(i >> 3) * IN_W + 3072 + (i & 7)];
    __syncthreads();
    bf16* H = (bf16*)(F.ws + WS_H); float* BD = (float*)(F.ws + WS_BD);
    for (int m = gw; m < M; m += NGW) {
        const GAS f32x4* xr = (const GAS f32x4*)(FIN(0) + (size_t)m * D) + F.lane;
        f32x4 v[4]; float s2 = 0.f;
#pragma unroll
        for (int j = 0; j < 4; ++j) { v[j] = xr[64 * j]; s2 += (v[j].x * v[j].x + v[j].y * v[j].y) + (v[j].z * v[j].z + v[j].w * v[j].w); }
        const float rstd = 1.f / sqrtf(wave_sum(s2) * (1.f / D) + EPS);
        float bd[8];
#pragma unroll
        for (int q = 0; q < 8; ++q) bd[q] = 0.f;
        GAS unsigned long long* o8 = (GAS unsigned long long*)(H + (size_t)m * D) + F.lane;
#pragma unroll
        for (int j = 0; j < 4; ++j) { const f32x4 g = *((const GAS f32x4*)FIN(1) + F.lane + 64 * j); v[j] = v[j] * rstd * g;
            o8[64 * j] = (unsigned long long)pk2(v[j].x, v[j].y) | ((unsigned long long)pk2(v[j].z, v[j].w) << 32);
#pragma unroll
            for (int i = 0; i < 4; ++i) { const int k = 256 * j + 4 * F.lane + i; const f32x4 wa = *(const LAS f32x4*)(W8 + k * 8), wb = *(const LAS f32x4*)(W8 + k * 8 + 4); const float xv = v[j][i];
                bd[0] += xv * wa.x; bd[1] += xv * wa.y; bd[2] += xv * wa.z; bd[3] += xv * wa.w; bd[4] += xv * wb.x; bd[5] += xv * wb.y; bd[6] += xv * wb.z; bd[7] += xv * wb.w; } }
#pragma unroll
        for (int q = 0; q < 8; ++q) bd[q] = wave_sum(bd[q]);
        if (F.lane == 0) { *(GAS f32x4*)(BD + (size_t)m * 8) = (f32x4){bd[0], bd[1], bd[2], bd[3]}; *(GAS f32x4*)(BD + (size_t)m * 8 + 4) = (f32x4){bd[4], bd[5], bd[6], bd[7]}; }
    }
}

__device__ __forceinline__ void gdn_recurrence_phase(Frame& F) {
    if (blockIdx.x >= 8) return;
    const int b = blockIdx.x >> 2, h = blockIdx.x & 3, tid = F.tid;
    LAS float* Qs = (LAS float*)(F.lds + RING_OFF); LAS float* Ks = Qs + 64 * 128; LAS float* Vs = Ks + 64 * 128; LAS float* Os = Vs + 64 * 128;
    LAS float* GA = (LAS float*)(F.lds + GDN_AB_OFF); LAS float* GB = GA + 64;
    const bf16* G = (const bf16*)(F.ws + WS_G); const bf16* GATE = (const bf16*)(F.ws + WS_GATE); const float* BD = (const float*)(F.ws + WS_BD); bf16* YB = (bf16*)(F.ws + WS_K);
    const int c = tid >> 3, seg = tid & 7;
    const float na = -__expf(FIN(9)[h]), dtb = FIN(10)[h];
    float S[64];
#pragma unroll
    for (int k = 0; k < 64; ++k) S[k] = 0.f;
    const int vcol = 32 * (tid >> 6) + (tid & 31), kh = ((tid >> 5) & 1) * 64;
    for (int n = 0; n <= 128; ++n) {
        const int t0 = b * T + n * 64;
        if (n > 0) {
            const int tp = t0 - 64 + c; float o[16]; float ss = 0.f;
#pragma unroll
            for (int i = 0; i < 16; ++i) { o[i] = Os[c * 128 + seg * 16 + i]; ss += o[i] * o[i]; }
            ss += __shfl_xor(ss, 1); ss += __shfl_xor(ss, 2); ss += __shfl_xor(ss, 4);
            const float r = 1.f / sqrtf(ss * (1.f / 128.f) + EPS);
            const v4u g0 = *(const v4u*)(GATE + (size_t)tp * 512 + h * 128 + seg * 16), g1 = *(const v4u*)(GATE + (size_t)tp * 512 + h * 128 + seg * 16 + 8);
            const unsigned gw[8] = {g0.x, g0.y, g0.z, g0.w, g1.x, g1.y, g1.z, g1.w}; unsigned ow[8];
#pragma unroll
            for (int i = 0; i < 8; ++i) { const float ga = bflo(gw[i]), gb = bfhi(gw[i]);
                const float y0 = o[2 * i] * r * FIN(11)[seg * 16 + 2 * i] * (ga * sigm(ga)), y1 = o[2 * i + 1] * r * FIN(11)[seg * 16 + 2 * i + 1] * (gb * sigm(gb)); ow[i] = pk2(y0, y1); }
            *(v4u*)(YB + (size_t)tp * 512 + h * 128 + seg * 16) = (v4u){ow[0], ow[1], ow[2], ow[3]}; *(v4u*)(YB + (size_t)tp * 512 + h * 128 + seg * 16 + 8) = (v4u){ow[4], ow[5], ow[6], ow[7]};
        }
        if (n == 128) break;
#pragma unroll
        for (int j = 0; j < 3; ++j) {
            const int ch = j * 512 + h * 128 + seg * 16; float a[16];
#pragma unroll
            for (int i = 0; i < 16; ++i) a[i] = 0.f;
#pragma unroll
            for (int jj = 0; jj < 4; ++jj) { const int tl = n * 64 + c - 3 + jj;
                if (tl >= 0) { const bf16* rp = G + (size_t)(b * T + tl) * 1536 + ch; const v4u r0 = *(const v4u*)rp, r1 = *(const v4u*)(rp + 8); const unsigned rw[8] = {r0.x, r0.y, r0.z, r0.w, r1.x, r1.y, r1.z, r1.w};
                    const float* wp = FIN(8) + jj * 1536 + ch;
#pragma unroll
                    for (int i = 0; i < 8; ++i) { a[2 * i] += wp[2 * i] * bflo(rw[i]); a[2 * i + 1] += wp[2 * i + 1] * bfhi(rw[i]); } } }
            float ss = 0.f;
#pragma unroll
            for (int i = 0; i < 16; ++i) { a[i] = a[i] * sigm(a[i]); ss += a[i] * a[i]; }
            ss += __shfl_xor(ss, 1); ss += __shfl_xor(ss, 2); ss += __shfl_xor(ss, 4);
            const float sc = (j == 0) ? 0.08838834764831845f / sqrtf(ss + EPS) : (j == 1) ? 1.f / sqrtf(ss + EPS) : 1.f;
            LAS float* dst = (j == 0 ? Qs : j == 1 ? Ks : Vs) + c * 128 + seg * 16;
#pragma unroll
            for (int i = 0; i < 16; ++i) dst[i] = a[i] * sc;
        }
        if (tid < 64) { const float* bd = BD + (size_t)(t0 + tid) * 8; const float xd = bd[4 + h] + dtb; const float sp = xd > 20.f ? xd : log1pf(__expf(xd)); GA[tid] = __expf(na * sp); GB[tid] = sigm(bd[h]); }
        __syncthreads();
        if (tid < 256) {
            for (int cc = 0; cc < 64; ++cc) {
                const float a = GA[cc], be = GB[cc]; const LAS float* kr = Ks + cc * 128 + kh; const LAS float* qr = Qs + cc * 128 + kh;
                float kS = 0.f;
#pragma unroll
                for (int k = 0; k < 64; ++k) kS += kr[k] * S[k];
                kS += __shfl_xor(kS, 32);
                const float d = be * (Vs[cc * 128 + vcol] - a * kS);
                float o = 0.f;
#pragma unroll
                for (int k = 0; k < 64; ++k) { S[k] = a * S[k] + kr[k] * d; o += qr[k] * S[k]; }
                o += __shfl_xor(o, 32);
                if (kh == 0) Os[cc * 128 + vcol] = o;
            }
        }
        __syncthreads();
    }
}

__device__ __forceinline__ void ya_phase(Frame& F) {
    const int gw = F.vcu * NWAVES + F.wave, NGW = F.G * NWAVES, l = F.lane;
    const float lam = __expf(wave_sum(FIN(3)[l] * FIN(4)[l])) - __expf(wave_sum(FIN(5)[l] * FIN(6)[l])) + 0.2f;
    const bf16* OP = (const bf16*)(F.ws + WS_H); bf16* YA = (bf16*)(F.ws + WS_Q);
    const int vh = l >> 5, d = 2 * (l & 31);
    const float g0 = FIN(7)[2 * l] * 0.8f, g1 = FIN(7)[2 * l + 1] * 0.8f;
    for (int m = gw; m < M; m += NGW) {
        const bf16* row = OP + (size_t)m * 1024; unsigned ow[4];
#pragma unroll
        for (int hh = 0; hh < 4; ++hh) {
            const unsigned p0 = *(const unsigned*)(row + ((hh * 2 + 0) * 2 + vh) * 64 + d), p1 = *(const unsigned*)(row + ((hh * 2 + 1) * 2 + vh) * 64 + d);
            const float a0 = bflo(p0) - lam * bflo(p1), a1 = bfhi(p0) - lam * bfhi(p1);
            const float ss = wave_sum(a0 * a0 + a1 * a1);
            const float r = 1.f / sqrtf(ss * (1.f / 128.f) + EPS);
            ow[hh] = pk2(a0 * r * g0, a1 * r * g1);
        }
#pragma unroll
        for (int hh = 0; hh < 4; ++hh) *(unsigned*)(YA + (size_t)m * 512 + hh * 128 + 2 * l) = ow[hh];
    }
}

__device__ __forceinline__ void router_phase(Frame& F) {
    const int gw = F.vcu * NWAVES + F.wave, NGW = F.G * NWAVES, l = F.lane;
    const float* WR = (const float*)(F.ws + WS_WR); bf16* H2 = (bf16*)(F.ws + WS_H); float* ROUTE = (float*)(F.ws + WS_ROUTE);
    f32x4 gn[4];
#pragma unroll
    for (int j = 0; j < 4; ++j) gn[j] = *((const GAS f32x4*)FIN(15) + l + 64 * j);
    for (int m = gw; m < M; m += NGW) {
        const GAS f32x4* xr = (const GAS f32x4*)(F.out + (size_t)m * D) + l;
        f32x4 v[4]; float s2 = 0.f;
#pragma unroll
        for (int j = 0; j < 4; ++j) { v[j] = xr[64 * j]; s2 += (v[j].x * v[j].x + v[j].y * v[j].y) + (v[j].z * v[j].z + v[j].w * v[j].w); }
        const float rstd = 1.f / sqrtf(wave_sum(s2) * (1.f / D) + EPS);
        GAS unsigned long long* o8 = (GAS unsigned long long*)(H2 + (size_t)m * D) + l;
#pragma unroll
        for (int j = 0; j < 4; ++j) { v[j] = v[j] * rstd * gn[j]; o8[64 * j] = (unsigned long long)pk2(v[j].x, v[j].y) | ((unsigned long long)pk2(v[j].z, v[j].w) << 32); }
        float lg[36];
#pragma unroll
        for (int c = 0; c < 36; ++c) { float a = 0.f;
#pragma unroll
            for (int j = 0; j < 4; ++j) { const f32x4 w = *((const GAS f32x4*)(WR + c * 1024) + l + 64 * j); a += (v[j].x * w.x + v[j].y * w.y) + (v[j].z * w.z + v[j].w * w.w); }
            lg[c] = wave_sum(a); }
        float gl[4];
#pragma unroll
        for (int c = 0; c < 4; ++c) gl[c] = lg[c] + FIN(17)[c];
        int gi = 0; float gm = gl[0];
#pragma unroll
        for (int c = 1; c < 4; ++c) if (gl[c] > gm) { gm = gl[c]; gi = c; }
        float den = 0.f;
#pragma unroll
        for (int c = 0; c < 4; ++c) den += __expf(gl[c] - gm);
        const float gwt = 1.f / den;
        float el[8];
#pragma unroll
        for (int j = 0; j < 8; ++j) { float a = lg[4 + j] + FIN(19)[j];
#pragma unroll
            for (int g = 1; g < 4; ++g) a = (gi == g) ? lg[4 + 8 * g + j] + FIN(19)[8 * g + j] : a;
            el[j] = a; }
        int i0 = 0; float v0 = el[0];
#pragma unroll
        for (int j = 1; j < 8; ++j) if (el[j] > v0) { v0 = el[j]; i0 = j; }
        int i1 = -1; float v1 = -INFINITY;
#pragma unroll
        for (int j = 0; j < 8; ++j) if (j != i0 && el[j] > v1) { v1 = el[j]; i1 = j; }
        const float e1 = __expf(v1 - v0), w0 = gwt / (1.f + e1), w1 = gwt * e1 / (1.f + e1);
        const int ex0 = gi * 8 + i0, ex1 = gi * 8 + i1;
        if (l == 0) { *(GAS f32x4*)(ROUTE + (size_t)m * 4) = (f32x4){__int_as_float(ex0), __int_as_float(ex1), w0, w1};
            atomicAdd((unsigned*)(F.ctl + CW_CNT + 64 * ex0), 1u); atomicAdd((unsigned*)(F.ctl + CW_CNT + 64 * ex1), 1u); }
    }
}
__device__ __forceinline__ void moe_build_ts(Frame& F) {
    LAS int* ts = (LAS int*)(F.lds + TS_OFF);
    if (F.tid == 0) { int acc = 0;
        for (int e = 0; e < 32; ++e) { ts[e] = acc; const unsigned n = __hip_atomic_load(F.ctl + CW_CNT + 64 * e, RLX_AGENT); acc += (int)((n + 255u) >> 8); }
        ts[32] = acc; }
    __syncthreads();
}
__device__ __forceinline__ void gather_phase(Frame& F) {
    moe_build_ts(F);
    const LAS int* ts = (const LAS int*)(F.lds + TS_OFF);
    const int gw = F.vcu * NWAVES + F.wave, NGW = F.G * NWAVES, l = F.lane;
    const bf16* H2 = (const bf16*)(F.ws + WS_H); const float* ROUTE = (const float*)(F.ws + WS_ROUTE); bf16* XG = (bf16*)(F.ws + WS_XG); float* ROWW = (float*)(F.ws + WS_ROWW); int* POS = (int*)(F.ws + WS_POS);
    for (int m = gw; m < M; m += NGW) {
        const f32x4 rt = *(const GAS f32x4*)(ROUTE + (size_t)m * 4);
        const int e0 = __float_as_int(rt.x), e1 = __float_as_int(rt.y);
        int p0 = 0, p1 = 0;
        if (l == 0) { p0 = ts[e0] * 256 + (int)atomicAdd((unsigned*)(F.ctl + CW_CUR + 64 * e0), 1u); p1 = ts[e1] * 256 + (int)atomicAdd((unsigned*)(F.ctl + CW_CUR + 64 * e1), 1u);
            ROWW[p0] = rt.z; ROWW[p1] = rt.w; POS[2 * m] = p0; POS[2 * m + 1] = p1; }
        p0 = __builtin_amdgcn_readfirstlane(p0); p1 = __builtin_amdgcn_readfirstlane(p1);
        const v4u a = *((const GAS v4u*)(H2 + (size_t)m * D) + l), bq = *((const GAS v4u*)(H2 + (size_t)m * D) + 64 + l);
        *((GAS v4u*)(XG + (size_t)p0 * D) + l) = a; *((GAS v4u*)(XG + (size_t)p0 * D) + 64 + l) = bq;
        *((GAS v4u*)(XG + (size_t)p1 * D) + l) = a; *((GAS v4u*)(XG + (size_t)p1 * D) + 64 + l) = bq;
    }
}
__device__ __forceinline__ void final_phase(Frame& F) {
    const int gw = F.vcu * NWAVES + F.wave, NGW = F.G * NWAVES, l = F.lane;
    const bf16* YG = (const bf16*)(F.ws + WS_YG); const int* POS = (const int*)(F.ws + WS_POS);
    f32x4 gn[4];
#pragma unroll
    for (int j = 0; j < 4; ++j) gn[j] = *((const GAS f32x4*)FIN(23) + l + 64 * j);
    for (int m = gw; m < M; m += NGW) {
        const int p0 = POS[2 * m], p1 = POS[2 * m + 1];
        GAS f32x4* xr = (GAS f32x4*)(F.out + (size_t)m * D) + l;
        const GAS v2u* y0 = (const GAS v2u*)(YG + (size_t)p0 * D) + l; const GAS v2u* y1 = (const GAS v2u*)(YG + (size_t)p1 * D) + l;
        f32x4 v[4]; float s2 = 0.f;
#pragma unroll
        for (int j = 0; j < 4; ++j) { const v2u a = y0[64 * j], bq = y1[64 * j]; v[j] = xr[64 * j];
            v[j].x += bflo(a.x) + bflo(bq.x); v[j].y += bfhi(a.x) + bfhi(bq.x); v[j].z += bflo(a.y) + bflo(bq.y); v[j].w += bfhi(a.y) + bfhi(bq.y);
            s2 += (v[j].x * v[j].x + v[j].y * v[j].y) + (v[j].z * v[j].z + v[j].w * v[j].w); }
        const float rstd = 1.f / sqrtf(wave_sum(s2) * (1.f / D) + EPS);
#pragma unroll
        for (int j = 0; j < 4; ++j) xr[64 * j] = v[j] * rstd * gn[j];
    }
}

__global__ void __launch_bounds__(NWAVES * 64, 2) mk_fwd(Args args) {
    extern __shared__ __attribute__((aligned(16))) unsigned char lds[];
    Frame F;
    F.lds = (LAS unsigned char*)lds;
    F.MISC = (volatile LAS unsigned*)(F.lds + MISC_OFF);
    F.tid = threadIdx.x; F.lane = F.tid & 63; F.wave = __builtin_amdgcn_readfirstlane(F.tid >> 6);
    F.G = gridDim.x; { const int bx = blockIdx.x; F.vcu = (F.G % 8 == 0) ? (bx % 8) * (F.G / 8) + bx / 8 : bx; }
    F.ws = args.ws; F.out = args.out; F.ctl = (gu32*)(args.ws + WS_CTL);
    F.ka = (const CAS Args*)__builtin_amdgcn_kernarg_segment_ptr();
    for (int u = F.tid; u < (LDS_BYTES - LDSCTL_OFF) / 4; u += NWAVES * 64) ((LAS unsigned*)(F.lds + LDSCTL_OFF))[u] = 0u;
    __syncthreads();
    XcdBarrier bar = xcd_barrier_post((unsigned*)(F.ctl + CW_BAR), F.MISC + 8);
    const int lo = args.ph_lo, hi = args.ph_hi;
#ifndef PHMASK
#define PHMASK 0xfff
#endif
#define IN(k) (((PHMASK >> (k)) & 1) && lo <= (k) && (k) < hi)
#define SEAM(k) do { if (IN(k) && IN((k) + 1)) xcd_barrier(bar); } while (0)
    bf16* const WIN = (bf16*)(F.ws + WS_WIN); bf16* const Hb = (bf16*)(F.ws + WS_H);
    bf16* const Qb = (bf16*)(F.ws + WS_Q); bf16* const Kb = (bf16*)(F.ws + WS_K); bf16* const Vb = (bf16*)(F.ws + WS_V);
    bf16* const MA = (bf16*)F.out; bf16* const MB = MA + (size_t)M * 1024;

    if (IN(0)) { p0_prologue(F); } SEAM(0);
    if (IN(1)) {
        pg8::Gemm g{Hb, WIN, M, NPROJ, D}; pg8::StaticOrder S; S.init(M, NPROJ, F.G, (int)blockIdx.x);
        pg8::EpiProj E{Qb, Kb, Vb, (bf16*)(F.ws + WS_G), (bf16*)(F.ws + WS_GATE), MA, MB, attn_body::C2};
        pg8::gemm_phase<pg8::EpiProj, pg8::StaticOrder, PG8_ALIGN, PG8_SP2>(F.lds + RING_OFF, g, S, E);
    } SEAM(1);
    if (IN(2)) {
        const attn_body::AttnTensors AT{(const attn_body::bf16*)Qb, (const attn_body::bf16*)Kb, (const attn_body::bf16*)Vb, (attn_body::bf16*)Hb};
        const attn_body::StaticOrder S((int)F.G, (int)blockIdx.x);
        attn_body::attn_phase<attn_body::StaticOrder>((char*)lds + RING_OFF, AT, S);
    } SEAM(2);
    if (IN(3)) { gdn_recurrence_phase(F); } SEAM(3);
    if (IN(4)) { ya_phase(F); } SEAM(4);
    if (IN(5)) {
        { pg8::Gemm g{Qb, (bf16*)(F.ws + WS_WA), M, D, 512}; pg8::StaticOrder S; S.init(M, D, F.G, (int)blockIdx.x);
          pg8::EpiMerge<0> E{MA, Hb}; pg8::gemm_phase<pg8::EpiMerge<0>, pg8::StaticOrder, PG8_ALIGN, PG8_SP2>(F.lds + RING_OFF, g, S, E); }
        __syncthreads();
        { pg8::Gemm g{Kb, (bf16*)(F.ws + WS_WB), M, D, 512}; pg8::StaticOrder S; S.init(M, D, F.G, (int)blockIdx.x);
          pg8::EpiMerge<1> E{MB, Hb}; pg8::gemm_phase<pg8::EpiMerge<1>, pg8::StaticOrder, PG8_ALIGN, PG8_SP2>(F.lds + RING_OFF, g, S, E); }
    } SEAM(5);
    if (IN(6)) {
        pg8::Gemm g{Hb, (bf16*)(F.ws + WS_WOUT), M, D, D}; pg8::StaticOrder S; S.init(M, D, F.G, (int)blockIdx.x);
        pg8::EpiRes E{FIN(0), F.out}; pg8::gemm_phase<pg8::EpiRes, pg8::StaticOrder, PG8_ALIGN, PG8_SP2>(F.lds + RING_OFF, g, S, E);
    } SEAM(6);
    if (IN(7)) { router_phase(F); } SEAM(7);
    if (IN(8)) { gather_phase(F); } SEAM(8);
    if (IN(9)) {
        moe_build_ts(F);
        pg8::Gemm g{(bf16*)(F.ws + WS_XG), (bf16*)(F.ws + WS_GU), XG_ROWS, NE * 512, D};
        pg8::MoeOrder S{(const LAS int*)(F.lds + TS_OFF), 2, F.G, (int)blockIdx.x};
        pg8::EpiAct E{(bf16*)(F.ws + WS_ACT), (const float*)(F.ws + WS_ROWW)};
        pg8::gemm_phase<pg8::EpiAct, pg8::MoeOrder, PG8_ALIGN, PG8_SP2>(F.lds + RING_OFF, g, S, E);
    } SEAM(9);
    if (IN(10)) {
        moe_build_ts(F);
        int Kd = FH; asm volatile("" : "+s"(Kd));
        pg8::Gemm g{(bf16*)(F.ws + WS_ACT), (bf16*)(F.ws + WS_DN), XG_ROWS, NE * 1024, Kd};
        pg8::MoeOrder S{(const LAS int*)(F.lds + TS_OFF), 4, F.G, (int)blockIdx.x};
        pg8::EpiStore E{(bf16*)(F.ws + WS_YG), 1024, 3};
        pg8::gemm_phase<pg8::EpiStore, pg8::MoeOrder, PG8_ALIGN, PG8_SP2>(F.lds + RING_OFF, g, S, E);
    } SEAM(10);
    if (IN(11)) { final_phase(F); }
#undef IN
#undef SEAM
}

#ifndef MK_N_LAUNCHES
#define MK_N_LAUNCHES 1
#endif
extern "C" void kernel_launch(void* const* d_in, const int* in_sizes, int n_in, void* d_out, int out_size, void* d_ws, size_t ws_size, hipStream_t stream) {
    static int grid = 0;
    if (grid == 0) {
        if (n_in != 24 || in_sizes[0] != M * D || out_size != M * D || ws_size < WS_END) { fprintf(stderr, "kernel_launch: unexpected shapes (n_in %d, in0 %d, out %d, ws %zu)\n", n_in, n_in > 0 ? in_sizes[0] : -1, out_size, ws_size); grid = -1; return; }
        int dev = 0, cus = 0, per_cu = 0;
        if (hipGetDevice(&dev) != hipSuccess || hipDeviceGetAttribute(&cus, hipDeviceAttributeMultiprocessorCount, dev) != hipSuccess) { grid = -1; return; }
        if (hipFuncSetAttribute((const void*)mk_fwd, hipFuncAttributeMaxDynamicSharedMemorySize, LDS_BYTES) != hipSuccess) { fprintf(stderr, "kernel_launch: hipFuncSetAttribute failed\n"); grid = -1; return; }
        if (hipOccupancyMaxActiveBlocksPerMultiprocessor(&per_cu, (const void*)mk_fwd, NWAVES * 64, LDS_BYTES) != hipSuccess || per_cu < 1) { fprintf(stderr, "kernel_launch: occupancy query says %d blocks per CU\n", per_cu); per_cu = 1; }
        (void)hipGetLastError();
        grid = cus;
        if (grid != 256) fprintf(stderr, "kernel_launch: %d CUs (built for 256)\n", grid);
    }
    if (grid < 0) return;
    if (hipMemsetAsync((char*)d_ws + WS_CTL, 0, CTL_ZERO_BYTES, stream) != hipSuccess) return;
    Args a{};
    for (int i = 0; i < 24; ++i) a.in[i] = (const float*)d_in[i];
    a.out = (float*)d_out; a.ws = (unsigned char*)d_ws;
#if MK_N_LAUNCHES == 1
    a.ph_lo = 0; a.ph_hi = N_PHASES;
    hipLaunchKernelGGL(mk_fwd, dim3(grid), dim3(NWAVES * 64), LDS_BYTES, stream, a);
#else
    for (int p = 0; p < N_PHASES; ++p) { a.ph_lo = p; a.ph_hi = p + 1; hipLaunchKernelGGL(mk_fwd, dim3(grid), dim3(NWAVES * 64), LDS_BYTES, stream, a); }
#endif
}
```

```cpp
#include <hip/hip_runtime.h>
#include <cstdio>
#include <cstdint>
namespace pg8 {
#define PG8_LAS __attribute__((address_space(3)))
typedef unsigned short bf16_t;
typedef short bf16x8 __attribute__((ext_vector_type(8)));
typedef float f32x4 __attribute__((ext_vector_type(4)));
typedef unsigned u32x4 __attribute__((ext_vector_type(4)));
constexpr int BM = 256, BK = 64, HALF = 128, HTB = HALF * BK * 2  , STAGE_BYTES = 8 * HTB, NXCD = 8, WGM = 8;

__host__ __device__ __forceinline__ int lds_byte(int r, int c) { const int st = (r >> 4) * 2 + (c >> 5), rr = r & 15, cc = c & 31, ob = rr * 64 + cc * 2; return st * 1024 + (ob ^ (((ob >> 9) & 1) << 5)); }
__host__ __device__ __forceinline__ void stage_rc(int b, int& R, int& C) { const int st = b / 1024, sb = b % 1024, swz = sb ^ (((sb >> 9) & 1) << 5); R = (st >> 1) * 16 + swz / 64; C = (st & 1) * 32 + (swz % 64) / 2; }
__host__ __device__ __forceinline__ int perm32(int rho) { const int n = rho >> 4, i = rho & 15; return 8 * (i >> 2) + 4 * n + (i & 3); }

struct Unit { int pm, pn; };
struct Gemm { const bf16_t* A; const bf16_t* Bt; int M, N, K; };

struct StaticOrder {
    int nM, nN, nwg, G, c;
    __host__ __device__ void init(int M, int N, int G_, int c_) { nM = M / BM; nN = N / BM; nwg = nM * nN; G = G_; c = c_; }
    __host__ __device__ bool next(int i, Unit& u) const {
        const long L = (long)i * G + c; if (L >= nwg) return false;
        int wgid = (int)L; { const int q = nwg / NXCD, r = nwg % NXCD, xcd = wgid % NXCD, off = wgid / NXCD; wgid = (xcd < r ? xcd * (q + 1) : r * (q + 1) + (xcd - r) * q) + off; }
        const int nig = WGM * nN, gid = wgid / nig, fm = gid * WGM, gsz = (nM - fm) < WGM ? (nM - fm) : WGM;
        u.pm = fm + ((wgid % nig) % gsz); u.pn = (wgid % nig) / gsz; return true;
    }
    __device__ __forceinline__ void a_ready(const Unit&) const {}
    __device__ __forceinline__ void done(const Unit&) const {}
};

__device__ __forceinline__ unsigned cvt_pk_bf16(float lo, float hi) { unsigned r; asm volatile("v_cvt_pk_bf16_f32 %0, %1, %2" : "=v"(r) : "v"(lo), "v"(hi)); return r; }
typedef unsigned u32x2 __attribute__((ext_vector_type(2)));
__device__ __forceinline__ float bf_lo(unsigned w) { return __uint_as_float(w << 16); }
__device__ __forceinline__ float bf_hi(unsigned w) { return __uint_as_float(w & 0xffff0000u); }
__device__ __forceinline__ float sigmoid_f(float x) { return __builtin_amdgcn_rcpf(1.0f + __expf(-x)); }
__device__ __forceinline__ float silu_f(float x) { return x * sigmoid_f(x); }
__device__ __forceinline__ u32x4 pack8(const f32x4& v0, const f32x4& v1) { u32x4 w; w.x = cvt_pk_bf16(v0[0], v0[1]); w.y = cvt_pk_bf16(v0[2], v0[3]); w.z = cvt_pk_bf16(v1[0], v1[1]); w.w = cvt_pk_bf16(v1[2], v1[3]); return w; }

struct EpiProj {
    static constexpr bool PERM = true, AFTER_DRAIN = false;
    bf16_t *Q, *Kb, *V, *G, *GATE, *MA, *MB; float qscale;
    __device__ __forceinline__ void operator()(const f32x4 (&acc)[2][2][4][2], const Unit& u, int wr, int wc, int fr, int fq) const {
        const int pn = u.pn; bf16_t* base; int ldc, colt; float sc = 1.f; bool sg = false;
        if (pn < 2) { base = Q; ldc = 512; colt = pn * 256; sc = qscale; }
        else if (pn < 4) { base = Kb; ldc = 512; colt = (pn - 2) * 256; }
        else if (pn < 6) { base = V; ldc = 512; colt = (pn - 4) * 256; }
        else if (pn < 12) { base = G; ldc = 1536; colt = (pn - 6) * 256; }
        else if (pn < 14) { base = GATE; ldc = 512; colt = (pn - 12) * 256; }
        else if (pn < 18) { base = MA; ldc = 1024; colt = (pn - 14) * 256; sg = true; }
        else { base = MB; ldc = 1024; colt = (pn - 18) * 256; sg = true; }
        const int row0 = u.pm * BM + wr * 64 + fr, col0 = colt + wc * 32 + 8 * fq;
#pragma unroll
        for (int ai = 0; ai < 2; ++ai)
#pragma unroll
            for (int m = 0; m < 4; ++m) { bf16_t* rowp = base + (size_t)(row0 + ai * HALF + m * 16) * ldc + col0;
#pragma unroll
                for (int bj = 0; bj < 2; ++bj) { f32x4 v0 = acc[ai][bj][m][0], v1 = acc[ai][bj][m][1];
                    if (sg) {
#pragma unroll
                        for (int i = 0; i < 4; ++i) { v0[i] = sigmoid_f(v0[i]); v1[i] = sigmoid_f(v1[i]); }
                    } else { v0 = v0 * sc; v1 = v1 * sc; }
                    *(u32x4*)(rowp + bj * HALF) = pack8(v0, v1); } }
    }
};
template <int PASS> struct EpiMerge {
    static constexpr bool PERM = true, AFTER_DRAIN = false;
    const bf16_t* Gt; bf16_t* O;
    __device__ __forceinline__ void operator()(const f32x4 (&acc)[2][2][4][2], const Unit& u, int wr, int wc, int fr, int fq) const {
        const int row0 = u.pm * BM + wr * 64 + fr, col0 = u.pn * BM + wc * 32 + 8 * fq;
#pragma unroll
        for (int ai = 0; ai < 2; ++ai)
#pragma unroll
            for (int m = 0; m < 4; ++m) { const size_t off = (size_t)(row0 + ai * HALF + m * 16) * 1024 + col0;
#pragma unroll
                for (int bj = 0; bj < 2; ++bj) { const u32x4 g = *(const u32x4*)(Gt + off + bj * HALF);
                    f32x4 v0 = acc[ai][bj][m][0], v1 = acc[ai][bj][m][1];
                    v0[0] *= bf_lo(g.x); v0[1] *= bf_hi(g.x); v0[2] *= bf_lo(g.y); v0[3] *= bf_hi(g.y);
                    v1[0] *= bf_lo(g.z); v1[1] *= bf_hi(g.z); v1[2] *= bf_lo(g.w); v1[3] *= bf_hi(g.w);
                    if (PASS) { const u32x4 p = *(const u32x4*)(O + off + bj * HALF);
                        v0[0] += bf_lo(p.x); v0[1] += bf_hi(p.x); v0[2] += bf_lo(p.y); v0[3] += bf_hi(p.y);
                        v1[0] += bf_lo(p.z); v1[1] += bf_hi(p.z); v1[2] += bf_lo(p.w); v1[3] += bf_hi(p.w); }
                    *(u32x4*)(O + off + bj * HALF) = pack8(v0, v1); } }
    }
};
struct EpiRes {
    static constexpr bool PERM = false, AFTER_DRAIN = false;
    const float* base; float* out;
    __device__ __forceinline__ void operator()(const f32x4 (&acc)[2][2][4][2], const Unit& u, int wr, int wc, int fr, int fq) const {
        const int row0 = u.pm * BM + wr * 64 + fr, col0 = u.pn * BM + wc * 32 + 4 * fq;
#pragma unroll
        for (int ai = 0; ai < 2; ++ai)
#pragma unroll
            for (int m = 0; m < 4; ++m) { const size_t off = (size_t)(row0 + ai * HALF + m * 16) * 1024 + col0;
#pragma unroll
                for (int bj = 0; bj < 2; ++bj)
#pragma unroll
                    for (int n = 0; n < 2; ++n) { const size_t p = off + bj * HALF + n * 16; *(f32x4*)(out + p) = *(const f32x4*)(base + p) + acc[ai][bj][m][n]; } }
    }
};
struct EpiAct {
    static constexpr bool PERM = true, AFTER_DRAIN = false;
    bf16_t* ACT; const float* roww;
    __device__ __forceinline__ void operator()(const f32x4 (&acc)[2][2][4][2], const Unit& u, int wr, int wc, int fr, int fq) const {
        const int row0 = u.pm * BM + wr * 64 + fr, col0 = (u.pn & 1) * 128 + wc * 32 + 8 * fq;
#pragma unroll
        for (int ai = 0; ai < 2; ++ai)
#pragma unroll
            for (int m = 0; m < 4; ++m) { const int row = row0 + ai * HALF + m * 16; const float w = roww[row];
                f32x4 v0, v1;
#pragma unroll
                for (int i = 0; i < 4; ++i) { v0[i] = silu_f(acc[ai][0][m][0][i]) * acc[ai][1][m][0][i] * w; v1[i] = silu_f(acc[ai][0][m][1][i]) * acc[ai][1][m][1][i] * w; }
                *(u32x4*)(ACT + (size_t)row * 256 + col0) = pack8(v0, v1); }
    }
};
struct EpiStore {
    static constexpr bool PERM = true, AFTER_DRAIN = false;
    bf16_t* O; int ldc, pn_mask;
    __device__ __forceinline__ void operator()(const f32x4 (&acc)[2][2][4][2], const Unit& u, int wr, int wc, int fr, int fq) const {
        const int row0 = u.pm * BM + wr * 64 + fr, col0 = (u.pn & pn_mask) * BM + wc * 32 + 8 * fq;
#pragma unroll
        for (int ai = 0; ai < 2; ++ai)
#pragma unroll
            for (int m = 0; m < 4; ++m) { bf16_t* rowp = O + (size_t)(row0 + ai * HALF + m * 16) * ldc + col0;
#pragma unroll
                for (int bj = 0; bj < 2; ++bj) *(u32x4*)(rowp + bj * HALF) = pack8(acc[ai][bj][m][0], acc[ai][bj][m][1]); }
    }
};
struct MoeOrder {
    const PG8_LAS int* ts; int NPN, G, c;
    __device__ __forceinline__ bool next(int i, Unit& u) const {
        const int L = i * G + c, ntl = __builtin_amdgcn_readfirstlane(ts[32]);
        if (L >= ntl * NPN) return false;
        const int rt = L / NPN, pl = L - rt * NPN; int e = 0;
#pragma unroll
        for (int k = 1; k < 32; ++k) e += (ts[k] <= rt) ? 1 : 0;
        u.pm = __builtin_amdgcn_readfirstlane(rt); u.pn = __builtin_amdgcn_readfirstlane(e * NPN + pl); return true;
    }
    __device__ __forceinline__ void a_ready(const Unit&) const {}
    __device__ __forceinline__ void done(const Unit&) const {}
};

template <class Epi, class Sched, bool ALIGN_EPI = false, bool SP2 = false>
__device__ __forceinline__ void gemm_phase(PG8_LAS unsigned char* lds, const Gemm g, const Sched& S, const Epi& E) {
    const int tid = threadIdx.x, wid = __builtin_amdgcn_readfirstlane(tid >> 6), lane = tid & 63, wr = wid >> 2, wc = wid & 3, fr = lane & 15, fq = lane >> 4;
    const int K = g.K, nt = K / BK;
    unsigned voffA[2], voffB[2];
#pragma unroll
    for (int i = 0; i < 2; ++i) { int R, C; stage_rc(tid * 16 + i * 8192, R, C); const int Rb = Epi::PERM ? ((R & ~31) + perm32(R & 31)) : R;
        voffA[i] = (unsigned)(R * K + C) * 2u; voffB[i] = (unsigned)(Rb * K + C) * 2u; }
    const size_t kstep = (size_t)(BK * 2);
    const size_t hstep = (size_t)HALF * K * 2;
    const size_t tstep = 2 * hstep;
    const unsigned ldsw = (unsigned)wid * 1024u;
    const int aoff = lds_byte(wr * 64 + fr, fq * 8), boff = lds_byte(wc * 32 + fr, fq * 8);
#define PG8_SA(b, h) (((b) * 2 + (h)) * HTB)
#define PG8_SB(b, h) ((4 + (b) * 2 + (h)) * HTB)
#define PG8_STAGE(bufoff, gbase, voff) do { _Pragma("unroll") for (int _i = 0; _i < 2; ++_i) \
        __builtin_amdgcn_global_load_lds((const unsigned*)((const char*)(gbase) + (voff)[_i]), (PG8_LAS unsigned*)(lds + (bufoff) + ldsw + _i * 8192), 16, 0, 0); } while (0)
#define PG8_LDA(dst, b, h) do { _Pragma("unroll") for (int m = 0; m < 4; ++m) _Pragma("unroll") for (int k = 0; k < 2; ++k) dst[m][k] = *(const PG8_LAS bf16x8*)(lds + PG8_SA(b, h) + aoff + m * 2048 + k * 1024); } while (0)
#define PG8_LDB(dst, b, h) do { _Pragma("unroll") for (int n = 0; n < 2; ++n) _Pragma("unroll") for (int k = 0; k < 2; ++k) dst[n][k] = *(const PG8_LAS bf16x8*)(lds + PG8_SB(b, h) + boff + n * 2048 + k * 1024); } while (0)
#define PG8_MMA(ai, bj, At, Bt) do { __builtin_amdgcn_s_setprio(1); _Pragma("unroll") for (int m = 0; m < 4; ++m) _Pragma("unroll") for (int n = 0; n < 2; ++n) _Pragma("unroll") for (int k = 0; k < 2; ++k) \
        acc[ai][bj][m][n] = __builtin_amdgcn_mfma_f32_16x16x32_bf16(Bt[n][k], At[m][k], acc[ai][bj][m][n], 0, 0, 0); __builtin_amdgcn_s_setprio(0); } while (0)
#define PG8_WAIT_V(n) asm volatile("s_waitcnt vmcnt(" #n ")" ::: "memory")
#define PG8_WAIT_L(n) asm volatile("s_waitcnt lgkmcnt(" #n ")" ::: "memory")
#define PG8_BAR __builtin_amdgcn_s_barrier()
#define PG8_SCHED __builtin_amdgcn_sched_barrier(0)
    Unit cur, nxt; int ui = 0;
    if (!S.next(0, cur)) return;
    f32x4 acc[2][2][4][2];
#pragma unroll
    for (int a = 0; a < 2; ++a)
#pragma unroll
        for (int b = 0; b < 2; ++b)
#pragma unroll
            for (int m = 0; m < 4; ++m)
#pragma unroll
                for (int n = 0; n < 2; ++n) acc[a][b][m][n] = (f32x4){0.f, 0.f, 0.f, 0.f};
    bf16x8 At[4][2], B0[2][2], B1[2][2];
    const char* cA = (const char*)g.A + (size_t)cur.pm * tstep; const char* cB = (const char*)g.Bt + (size_t)cur.pn * tstep;
    S.a_ready(cur);
    if constexpr (SP2) {
        PG8_STAGE(PG8_SB(0, 0), cB, voffB); PG8_STAGE(PG8_SB(0, 1), cB + hstep, voffB); PG8_STAGE(PG8_SA(0, 0), cA, voffA); PG8_STAGE(PG8_SA(0, 1), cA + hstep, voffA);
        if (wr == 1) PG8_BAR;
        PG8_WAIT_V(2); PG8_BAR;
        PG8_STAGE(PG8_SB(1, 0), cB + kstep, voffB); PG8_STAGE(PG8_SA(1, 0), cA + kstep, voffA); PG8_STAGE(PG8_SB(1, 1), cB + hstep + kstep, voffB);
        PG8_WAIT_V(6); PG8_BAR;
    } else {
        PG8_STAGE(PG8_SB(0, 0), cB, voffB); PG8_STAGE(PG8_SA(0, 0), cA, voffA); PG8_STAGE(PG8_SB(0, 1), cB + hstep, voffB); PG8_STAGE(PG8_SA(0, 1), cA + hstep, voffA);
        if (wr == 1) PG8_BAR;
        PG8_WAIT_V(4); PG8_BAR;
        PG8_STAGE(PG8_SB(1, 0), cB + kstep, voffB); PG8_STAGE(PG8_SA(1, 0), cA + kstep, voffA); PG8_STAGE(PG8_SB(1, 1), cB + hstep + kstep, voffB);
        PG8_WAIT_V(6); PG8_BAR;
    }
    for (;;) {
        const bool has_next = S.next(ui + 1, nxt);
        const char* nA = has_next ? (const char*)g.A + (size_t)nxt.pm * tstep : cA; const char* nB = has_next ? (const char*)g.Bt + (size_t)nxt.pn * tstep : cB;
        for (int t = 0; t < nt; t += 2) {
            const bool last = (t == nt - 2);
            const char* a1 = cA + (size_t)(t + 1) * kstep;
            const char* a2 = last ? nA : cA + (size_t)(t + 2) * kstep; const char* b2 = last ? nB : cB + (size_t)(t + 2) * kstep;
            const char* a3 = a2 + kstep; const char* b3 = b2 + kstep;
            if (last && has_next) S.a_ready(nxt);
            if constexpr (SP2) {
            PG8_LDB(B0, 0, 0); PG8_LDB(B1, 0, 1); PG8_SCHED; PG8_LDA(At, 0, 0); PG8_STAGE(PG8_SA(1, 1), a1 + hstep, voffA);
            PG8_WAIT_V(8); PG8_WAIT_L(0); PG8_BAR; PG8_MMA(0, 0, At, B0); PG8_MMA(0, 1, At, B1); PG8_BAR; PG8_SCHED;
            PG8_LDA(At, 0, 1); PG8_STAGE(PG8_SB(0, 0), b2, voffB); PG8_STAGE(PG8_SB(0, 1), b2 + hstep, voffB); PG8_STAGE(PG8_SA(0, 0), a2, voffA);
            PG8_WAIT_V(8); PG8_WAIT_L(0); PG8_BAR; PG8_MMA(1, 0, At, B0); PG8_MMA(1, 1, At, B1); PG8_BAR; PG8_SCHED;
            PG8_LDB(B0, 1, 0); PG8_LDB(B1, 1, 1); PG8_SCHED; PG8_LDA(At, 1, 0); PG8_STAGE(PG8_SA(0, 1), a2 + hstep, voffA);
            PG8_WAIT_V(8); PG8_WAIT_L(0); PG8_BAR; PG8_MMA(0, 0, At, B0); PG8_MMA(0, 1, At, B1); PG8_BAR; PG8_SCHED;
            PG8_LDA(At, 1, 1); PG8_STAGE(PG8_SB(1, 0), b3, voffB); PG8_STAGE(PG8_SB(1, 1), b3 + hstep, voffB); PG8_STAGE(PG8_SA(1, 0), a3, voffA);
            PG8_WAIT_V(8); PG8_WAIT_L(0); PG8_BAR; PG8_MMA(1, 0, At, B0); PG8_MMA(1, 1, At, B1); PG8_BAR; PG8_SCHED;
            } else {
            PG8_LDB(B0, 0, 0); PG8_SCHED; PG8_LDA(At, 0, 0); PG8_STAGE(PG8_SA(1, 1), a1 + hstep, voffA);
            PG8_WAIT_L(8); PG8_BAR; PG8_WAIT_L(0); PG8_MMA(0, 0, At, B0); PG8_BAR; PG8_SCHED;
            PG8_LDB(B1, 0, 1); PG8_STAGE(PG8_SB(0, 0), b2, voffB);
            PG8_BAR; PG8_WAIT_L(0); PG8_MMA(0, 1, At, B1); PG8_BAR;
            PG8_LDA(At, 0, 1); PG8_STAGE(PG8_SA(0, 0), a2, voffA);
            PG8_BAR; PG8_WAIT_L(0); PG8_MMA(1, 0, At, B0); PG8_BAR; PG8_SCHED;
            PG8_STAGE(PG8_SB(0, 1), b2 + hstep, voffB);
            PG8_WAIT_V(6); PG8_BAR; PG8_MMA(1, 1, At, B1); PG8_BAR;
            PG8_LDB(B0, 1, 0); PG8_SCHED; PG8_LDA(At, 1, 0); PG8_STAGE(PG8_SA(0, 1), a2 + hstep, voffA);
            PG8_WAIT_L(8); PG8_BAR; PG8_WAIT_L(0); PG8_MMA(0, 0, At, B0); PG8_BAR; PG8_SCHED;
            PG8_LDB(B1, 1, 1); PG8_STAGE(PG8_SB(1, 0), b3, voffB);
            PG8_BAR; PG8_WAIT_L(0); PG8_MMA(0, 1, At, B1); PG8_BAR;
            PG8_LDA(At, 1, 1); PG8_STAGE(PG8_SA(1, 0), a3, voffA);
            PG8_BAR; PG8_WAIT_L(0); PG8_MMA(1, 0, At, B0); PG8_BAR; PG8_SCHED;
            PG8_STAGE(PG8_SB(1, 1), b3 + hstep, voffB);
            PG8_WAIT_V(6); PG8_BAR; PG8_MMA(1, 1, At, B1); PG8_BAR;
            }
        }
        if constexpr (ALIGN_EPI) { if (wr == 0) PG8_BAR; }
        if constexpr (!Epi::AFTER_DRAIN) { E(acc, cur, wr, wc, fr, fq); S.done(cur); }
        if (!has_next) break;
#pragma unroll
        for (int a = 0; a < 2; ++a)
#pragma unroll
            for (int b = 0; b < 2; ++b)
#pragma unroll
                for (int m = 0; m < 4; ++m)
#pragma unroll
                    for (int n = 0; n < 2; ++n) acc[a][b][m][n] = (f32x4){0.f, 0.f, 0.f, 0.f};
        cur = nxt; cA = nA; cB = nB; ++ui;
        if constexpr (ALIGN_EPI) { if (wr == 1) PG8_BAR; }
    }
    PG8_WAIT_V(0);
    if constexpr (!ALIGN_EPI) { if (wr == 0) PG8_BAR; }
    PG8_BAR;
    if constexpr (Epi::AFTER_DRAIN) { E.fused(acc, cur, wr, wc, fr, fq, lds, wid, lane); S.done(cur); }
#undef PG8_SA
#undef PG8_SB
#undef PG8_STAGE
#undef PG8_LDA
#undef PG8_LDB
#undef PG8_MMA
#undef PG8_WAIT_V
#undef PG8_WAIT_L
#undef PG8_BAR
#undef PG8_SCHED
}
}

#ifndef PG8_SP2
#define PG8_SP2 true
#endif
#ifndef PG8_ALIGN
#define PG8_ALIGN true
#endif
#include <hip/hip_bf16.h>
#include <cmath>
namespace attn_body {
using bf16=__hip_bfloat16;
using bf16x8=__attribute__((ext_vector_type(8)))short;
using s16x4=__attribute__((ext_vector_type(4)))short;
using f32x16=__attribute__((ext_vector_type(16)))float;
using u32x4=__attribute__((ext_vector_type(4)))unsigned;
constexpr int BATCH=2,NHEAD=16,SEQ=8192,D=64,DM=NHEAD*D,QP=512;
constexpr int NW=8,QBLK=32,QB=QBLK*NW,KVBLK=64,NQB=SEQ/QB;
constexpr int ATTN_PITCH=DM, ATTN_UNIT_ROWS=QB;
__device__ __forceinline__ int crow(int r,int hi){return (r&3)+8*(r>>2)+4*hi;}
#define SBAR() __builtin_amdgcn_sched_barrier(0)
__device__ __forceinline__ void cmask(f32x16&p0,f32x16&p1,int jb,int qrel,int hi){
  const float NEG=-INFINITY; (void)hi;
  if(jb>(qrel>>6)){
  #pragma unroll
  for(int r=0;r<16;++r){p0[r]=NEG;p1[r]=NEG;} }
}

constexpr int NSLOT=3, SLOTB=8192;
constexpr int LDS_K=0, LDS_V=NSLOT*SLOTB, LDS_WS=2*NSLOT*SLOTB, LDS_OST=LDS_WS+NW*64*4, LDS_BYTES=LDS_OST+NW*4096;
constexpr float C2=0.125f*1.4426950408889634f;
__device__ __forceinline__ void glds16(const void*gsrc,unsigned lds_dst){unsigned keep;
  asm volatile("s_mov_b32 %0, m0\n\ts_mov_b32 m0, %2\n\ts_nop 0\n\tglobal_load_lds_dwordx4 %1, off\n\ts_mov_b32 m0, %0":"=&s"(keep):"v"(gsrc),"s"(lds_dst):"memory");}
__device__ __forceinline__ float max3f(float a,float b,float c){float r;asm("v_max3_f32 %0, %1, %2, %3":"=v"(r):"v"(a),"v"(b),"v"(c));return r;}
__device__ __forceinline__ float max2f(float a,float b){float r;asm("v_max_f32_e32 %0, %1, %2":"=v"(r):"v"(a),"v"(b));return r;}
__device__ __forceinline__ float fadd_s(float a,float b){float r;asm("v_add_f32_e32 %0, %1, %2":"=v"(r):"v"(a),"v"(b));return r;}
__device__ __forceinline__ float fsub_s(float a,float b){float r;asm("v_sub_f32_e32 %0, %1, %2":"=v"(r):"v"(a),"v"(b));return r;}
typedef float f32x2_t __attribute__((ext_vector_type(2))); typedef __bf16 bf16x2_t __attribute__((ext_vector_type(2)));
__device__ __forceinline__ unsigned cvtpk_s(float lo,float hi){f32x2_t v={lo,hi};bf16x2_t b=__builtin_convertvector(v,bf16x2_t);return __builtin_bit_cast(unsigned,b);}
#define WAIT_BAR(N) asm volatile("s_waitcnt vmcnt(" #N ") lgkmcnt(0)\n\ts_barrier":::"memory")

__device__ __forceinline__ void qkt(f32x16&p0,f32x16&p1,const char*Kslot,const bf16x8*qr,const f32x16&negm,int r32,int hi){
  const char*kb=Kslot+hi*1024+r32*16;
  #pragma unroll
  for(int d0=0;d0<4;++d0){
    const bf16x8 b0=*reinterpret_cast<const bf16x8*>(kb+d0*2048);
    const bf16x8 b1=*reinterpret_cast<const bf16x8*>(kb+d0*2048+512);
    if(d0==0){p0=__builtin_amdgcn_mfma_f32_32x32x16_bf16(b0,qr[0],negm,0,0,0);p1=__builtin_amdgcn_mfma_f32_32x32x16_bf16(b1,qr[0],negm,0,0,0);}
    else{p0=__builtin_amdgcn_mfma_f32_32x32x16_bf16(b0,qr[d0],p0,0,0,0);p1=__builtin_amdgcn_mfma_f32_32x32x16_bf16(b1,qr[d0],p1,0,0,0);}}
}
typedef __attribute__((address_space(3))) const char* lds_cptr;
typedef short v4i16_t __attribute__((ext_vector_type(4)));
__device__ __forceinline__ void kload8(bf16x8*kf,lds_cptr kp){
  kf[0]=*(const __attribute__((address_space(3))) bf16x8*)(kp);      kf[1]=*(const __attribute__((address_space(3))) bf16x8*)(kp+512);
  kf[2]=*(const __attribute__((address_space(3))) bf16x8*)(kp+2048); kf[3]=*(const __attribute__((address_space(3))) bf16x8*)(kp+2560);
  kf[4]=*(const __attribute__((address_space(3))) bf16x8*)(kp+4096); kf[5]=*(const __attribute__((address_space(3))) bf16x8*)(kp+4608);
  kf[6]=*(const __attribute__((address_space(3))) bf16x8*)(kp+6144); kf[7]=*(const __attribute__((address_space(3))) bf16x8*)(kp+6656);
}
__device__ __forceinline__ void kload2(bf16x8*kf,lds_cptr kp,int j){ kf[2*j]=*(const __attribute__((address_space(3))) bf16x8*)(kp+j*2048); kf[2*j+1]=*(const __attribute__((address_space(3))) bf16x8*)(kp+j*2048+512); }
__device__ __forceinline__ s16x4 vtr(lds_cptr p){ return __builtin_bit_cast(s16x4,__builtin_amdgcn_ds_read_tr16_b64_v4i16((__attribute__((address_space(3))) v4i16_t*)p)); }
__device__ __forceinline__ float rowmax(const f32x16&p0,const f32x16&p1){
  float a=max3f(p0[0],p0[1],p1[0]),b=max3f(p0[2],p0[3],p1[1]);a=max3f(a,p1[2],p1[3]);
  #pragma unroll
  for(int r=4;r<16;r+=4){a=max3f(a,p0[r],p0[r+1]);b=max3f(b,p0[r+2],p0[r+3]);a=max3f(a,p1[r],p1[r+1]);b=max3f(b,p1[r+2],p1[r+3]);}
  const float m=max2f(a,b);
  auto rr=__builtin_amdgcn_permlane32_swap(__float_as_uint(m),__float_as_uint(m),false,false);
  return max2f(__uint_as_float(rr[0]),__uint_as_float(rr[1]));
}
__device__ __forceinline__ void pv(f32x16*o,int vb,bf16x8 pa0,bf16x8 pa1,bf16x8 pa2,bf16x8 pa3){
  #pragma unroll
  for(int d0=0;d0<2;++d0){s16x4 lo[4],hi[4];
    #pragma unroll
    for(int ks=0;ks<4;++ks){
      asm volatile("ds_read_b64_tr_b16 %0,%1 offset:%c2":"=&v"(lo[ks]):"v"(vb),"i"(d0*4096+ks*1024):"memory");
      asm volatile("ds_read_b64_tr_b16 %0,%1 offset:%c2":"=&v"(hi[ks]):"v"(vb),"i"(d0*4096+ks*1024+512):"memory");}
    asm volatile("s_waitcnt lgkmcnt(0)":::"memory");SBAR();
    #define PK(k) (bf16x8){lo[k][0],lo[k][1],lo[k][2],lo[k][3],hi[k][0],hi[k][1],hi[k][2],hi[k][3]}
    o[d0]=__builtin_amdgcn_mfma_f32_32x32x16_bf16(pa0,PK(0),o[d0],0,0,0);
    o[d0]=__builtin_amdgcn_mfma_f32_32x32x16_bf16(pa1,PK(1),o[d0],0,0,0);
    o[d0]=__builtin_amdgcn_mfma_f32_32x32x16_bf16(pa2,PK(2),o[d0],0,0,0);
    o[d0]=__builtin_amdgcn_mfma_f32_32x32x16_bf16(pa3,PK(3),o[d0],0,0,0);
    #undef PK
  }
}

#ifndef ATTN_STORE16
#define ATTN_STORE16(p,v) (*(u32x4*)(p)=(v))
#endif
template<int THRL> __device__ __forceinline__ void attn_unit(int b,int qcol,int vcol,int ocol,int qb,const bf16*Q,const bf16*__restrict__ K,const bf16*__restrict__ V,bf16*O,char*shm){
  const int tid=threadIdx.x,lane=tid&63,r32=lane&31,hi=lane>>5; const int wid=__builtin_amdgcn_readfirstlane(tid>>6);
  const long rowbase=(long)b*SEQ; const int q0=qb*QB;
  const bf16*Qw=Q+(rowbase+q0+wid*QBLK)*QP+qcol;
  const bf16*Kh=K+rowbase*QP+qcol,*Vh=V+rowbase*QP+vcol;
  const unsigned lds0=(unsigned)(uintptr_t)shm;
  float*wsf=(float*)(shm+LDS_WS)+wid*64;
  const bf16*ksrc=Kh+(long)lane*QP+wid*8;
  const bf16*vsrc=Vh+(long)(16*(wid&3)+(lane>>2))*QP+(wid>>2)*32+(lane&3)*8;
  const unsigned kdst=lds0+LDS_K+wid*1024, vdst=lds0+LDS_V+wid*1024;
  #define DMA_K(t,slot) glds16(ksrc+(long)(t)*KVBLK*QP,(unsigned)__builtin_amdgcn_readfirstlane(kdst+(slot)))
  #define DMA_V(t,slot) glds16(vsrc+(long)(t)*KVBLK*QP,(unsigned)__builtin_amdgcn_readfirstlane(vdst+(slot)))
  const int vb0=(int)(lds0+LDS_V)+((lane>>4)&1)*32+(lane&3)*8+(4*hi+((lane&15)>>2))*64;
  const char*Kbase=shm+LDS_K; bf16x8 kf[8];
  const lds_cptr shm3=(lds_cptr)shm; const lds_cptr kp0=shm3+LDS_K+hi*1024+r32*16; const lds_cptr vp0=shm3+LDS_V+((lane>>4)&1)*32+(lane&3)*8+(4*hi+((lane&15)>>2))*64;
  const int NT=(q0+QB)/KVBLK;
  DMA_K(0,0);DMA_V(0,0);DMA_K(1,SLOTB);
  bf16x8 qr[4];
  #pragma unroll
  for(int d0=0;d0<4;++d0)qr[d0]=*reinterpret_cast<const bf16x8*>(&Qw[(long)r32*QP+d0*16+hi*8]);
  float mhat=0.f,l_reg=0.f;f32x16 o[2];o[0]=f32x16{};o[1]=f32x16{};f32x16 negm=f32x16{};asm volatile("":"+v"(negm));
  const int qrel=wid*QBLK+r32;
  #define CMASK(P0,P1,t) do{int jb_=(t)-(NT-4); if(jb_>=0)cmask(P0,P1,jb_,qrel,hi);}while(0)
  bool resc=false;
  #define START(P0,P1) do{ const float rm=rowmax(P0,P1); resc=false; \
    { const float dl=rm; mhat=fadd_s(mhat,dl); \
      _Pragma("unroll") for(int r=0;r<16;++r){P0[r]=fsub_s(P0[r],dl);P1[r]=fsub_s(P1[r],dl);} \
      _Pragma("unroll") for(int r=0;r<16;++r)negm[r]=-mhat; asm volatile("":"+v"(negm)); } \
    _Pragma("unroll") for(int r=0;r<16;++r)P0[r]=__builtin_amdgcn_exp2f(P0[r]); }while(0)
  #define RESC() do{ if(resc){ asm volatile("s_waitcnt lgkmcnt(0)":::"memory"); \
      _Pragma("unroll") for(int d_=0;d_<2;++d_) _Pragma("unroll") for(int r=0;r<16;++r)o[d_][r]*=wsf[crow(r,hi)]; } }while(0)
  f32x16 pA0,pA1,pB0,pB1;
  int sl_prev=0,sl_cur=0,sl_next=SLOTB;
  #define ROT() do{sl_prev=sl_cur;sl_cur=sl_next;sl_next=(sl_next==(NSLOT-1)*SLOTB)?0:sl_next+SLOTB;}while(0)
  DMA_K(2,2*SLOTB);
  WAIT_BAR(3);
  qkt(pA0,pA1,Kbase,qr,negm,r32,hi);asm volatile("s_nop 15\n\ts_nop 7":"+v"(pA0),"+v"(pA1));CMASK(pA0,pA1,0);
  START(pA0,pA1);
  _Pragma("unroll") for(int r=0;r<16;++r)pA1[r]=__builtin_amdgcn_exp2f(pA1[r]);
  WAIT_BAR(0);
  DMA_K(3,0);DMA_V(1,SLOTB);
  ROT();
  kload8(kf,kp0+sl_cur);
  WAIT_BAR(2);
  s16x4 vlo[8],vhi[8]; u32x4 pw0,pw1,pw2,pw3;
  #define PKW(P,B) cvtpk_s(P[B],P[B+1])
  #define PAF(k) __builtin_bit_cast(bf16x8,pw##k)
  #define VFR(i) (bf16x8){vlo[i][0],vlo[i][1],vlo[i][2],vlo[i][3],vhi[i][0],vhi[i][1],vhi[i][2],vhi[i][3]}
  #define PIN(x) asm volatile("":"+v"(x))
  #define MX3(a,b,c) __builtin_fmaxf(__builtin_fmaxf((a),(b)),(c))
  #define GAPA(MF,A0,A1,A2,A3,W0,W1,PW) do{ MF; sacc+=A0; sacc+=A1; sacc+=A2; sacc+=A3; PIN(sacc); W0; W1; PIN(PW); SBAR(); }while(0)
  #define EX(v) __builtin_amdgcn_exp2f(v)
  #define GAPB(MF,X,B) do{ MF; X[B]=EX(X[B]); X[B+1]=EX(X[B+1]); X[B+2]=EX(X[B+2]); X[B+3]=EX(X[B+3]); PIN(X); SBAR(); }while(0)
  #define VRD(i) do{ vlo[i]=vtr(vp_+(((i)>>2)*4096+((i)&3)*1024)); vhi[i]=vtr(vp_+(((i)>>2)*4096+((i)&3)*1024+512)); }while(0)
  #define KRD(G,j) do{ if(G){ kload2(kf,kp0+sl_next,j); SBAR(); } }while(0)
  #define STEP(C0,C1,P0,P1,t,GK,GV,GL) do{ SBAR(); \
    const lds_cptr vp_=vp0+sl_prev; \
    VRD(0); SBAR(); float sacc=(P0[0]+P0[1]); \
    GAPA(C0=__builtin_amdgcn_mfma_f32_32x32x16_bf16(kf[0],qr[0],negm,0,0,0), P0[2],P0[3],P0[4],P0[5],     pw0[0]=PKW(P0,0), pw0[1]=PKW(P0,2), pw0); \
    VRD(4); SBAR(); GAPA(C1=__builtin_amdgcn_mfma_f32_32x32x16_bf16(kf[1],qr[0],negm,0,0,0), P0[6],P0[7],P0[8],P0[9],     pw0[2]=PKW(P0,4), pw0[3]=PKW(P0,6), pw0); \
    VRD(1); SBAR(); GAPA(C0=__builtin_amdgcn_mfma_f32_32x32x16_bf16(kf[2],qr[1],C0,0,0,0),   P0[10],P0[11],P0[12],P0[13], pw1[0]=PKW(P0,8), pw1[1]=PKW(P0,10), pw1); \
    VRD(5); SBAR(); GAPA(C1=__builtin_amdgcn_mfma_f32_32x32x16_bf16(kf[3],qr[1],C1,0,0,0),   P0[14],P0[15],P1[0],P1[1],   pw1[2]=PKW(P0,12),pw1[3]=PKW(P0,14), pw1); \
    VRD(2); SBAR(); GAPA(C0=__builtin_amdgcn_mfma_f32_32x32x16_bf16(kf[4],qr[2],C0,0,0,0),   P1[2],P1[3],P1[4],P1[5],     pw2[0]=PKW(P1,0), pw2[1]=PKW(P1,2), pw2); \
    VRD(6); SBAR(); GAPA(C1=__builtin_amdgcn_mfma_f32_32x32x16_bf16(kf[5],qr[2],C1,0,0,0),   P1[6],P1[7],P1[8],P1[9],     pw2[2]=PKW(P1,4), pw2[3]=PKW(P1,6), pw2); \
    VRD(3); SBAR(); GAPA(C0=__builtin_amdgcn_mfma_f32_32x32x16_bf16(kf[6],qr[3],C0,0,0,0),   P1[10],P1[11],P1[12],P1[13], pw3[0]=PKW(P1,8), pw3[1]=PKW(P1,10), pw3); \
    VRD(7); SBAR(); GAPA(C1=__builtin_amdgcn_mfma_f32_32x32x16_bf16(kf[7],qr[3],C1,0,0,0),   P1[14],P1[15],0.f,0.f,       pw3[2]=PKW(P1,12),pw3[3]=PKW(P1,14), pw3); \
    l_reg+=sacc; \
    if(GK){DMA_K((t)+3,sl_cur);} if(GV){DMA_V((t)+1,sl_next);} \
    CMASK(C0,C1,t); \
    { float a=MX3(C0[0],C0[1],C1[0]),b=MX3(C0[2],C0[3],C1[1]); a=MX3(a,C1[2],C1[3]); \
      _Pragma("unroll") for(int r=4;r<16;r+=4){a=MX3(a,C0[r],C0[r+1]);b=MX3(b,C0[r+2],C0[r+3]);a=MX3(a,C1[r],C1[r+1]);b=MX3(b,C1[r+2],C1[r+3]);} \
      float rm=__builtin_fmaxf(a,b); { auto rr=__builtin_amdgcn_permlane32_swap(__float_as_uint(rm),__float_as_uint(rm),false,false); rm=__builtin_fmaxf(__uint_as_float(rr[0]),__uint_as_float(rr[1])); } \
      resc=false; \
      if(__builtin_expect(__any(rm>(float)THRL),0)){ const float dl=__builtin_fmaxf(rm,0.f); mhat+=dl; \
        _Pragma("unroll") for(int r=0;r<16;++r){C0[r]-=dl;C1[r]-=dl;} \
        _Pragma("unroll") for(int r=0;r<16;++r)negm[r]=-mhat; asm volatile("":"+v"(negm)); \
        const float f=__builtin_amdgcn_exp2f(-dl); l_reg*=f; if(hi==0)wsf[r32]=f; resc=true; } } \
    SBAR(); \
    GAPB(o[0]=__builtin_amdgcn_mfma_f32_32x32x16_bf16(PAF(0),VFR(0),o[0],0,0,0), C0,0); \
    GAPB(o[1]=__builtin_amdgcn_mfma_f32_32x32x16_bf16(PAF(0),VFR(4),o[1],0,0,0), C0,4); \
    KRD(GL,0); GAPB(o[0]=__builtin_amdgcn_mfma_f32_32x32x16_bf16(PAF(1),VFR(1),o[0],0,0,0), C0,8); \
    KRD(GL,1); GAPB(o[1]=__builtin_amdgcn_mfma_f32_32x32x16_bf16(PAF(1),VFR(5),o[1],0,0,0), C0,12); \
    KRD(GL,2); GAPB(o[0]=__builtin_amdgcn_mfma_f32_32x32x16_bf16(PAF(2),VFR(2),o[0],0,0,0), C1,0); \
    KRD(GL,3); GAPB(o[1]=__builtin_amdgcn_mfma_f32_32x32x16_bf16(PAF(2),VFR(6),o[1],0,0,0), C1,4); \
    GAPB(o[0]=__builtin_amdgcn_mfma_f32_32x32x16_bf16(PAF(3),VFR(3),o[0],0,0,0), C1,8); \
    GAPB(o[1]=__builtin_amdgcn_mfma_f32_32x32x16_bf16(PAF(3),VFR(7),o[1],0,0,0), C1,12); \
    }while(0)
  int t=1;
  #undef CMASK
  #define CMASK(P0,P1,t) do{}while(0)
  for(;t+5<NT;t+=2){
    STEP(pB0,pB1,pA0,pA1,t,true,true,true);     WAIT_BAR(2); RESC(); ROT();
    STEP(pA0,pA1,pB0,pB1,t+1,true,true,true);   WAIT_BAR(2); RESC(); ROT();
  }
  #undef CMASK
  #define CMASK(P0,P1,t) do{int jb_=(t)-(NT-4); if(jb_>=0)cmask(P0,P1,jb_,qrel,hi);}while(0)
  #define ENDW(tt) do{ if((tt)+3<NT){WAIT_BAR(2);} else if((tt)+2<NT){WAIT_BAR(1);} else {WAIT_BAR(0);} }while(0)
  for(;t+1<NT;t+=2){
    STEP(pB0,pB1,pA0,pA1,t,(t+3<NT),(t+1<NT),(t+1<NT));       ENDW(t);   RESC(); ROT();
    STEP(pA0,pA1,pB0,pB1,t+1,(t+4<NT),(t+2<NT),(t+2<NT));     ENDW(t+1); RESC(); ROT();
  }
  STEP(pB0,pB1,pA0,pA1,NT-1,false,false,false); RESC();
  { float sacc=pB0[0]+pB0[1]; _Pragma("unroll") for(int r=2;r<16;++r)sacc+=pB0[r]; _Pragma("unroll") for(int r=0;r<16;++r)sacc+=pB1[r]; l_reg+=sacc;
    pw0=(u32x4){PKW(pB0,0),PKW(pB0,2),PKW(pB0,4),PKW(pB0,6)};pw1=(u32x4){PKW(pB0,8),PKW(pB0,10),PKW(pB0,12),PKW(pB0,14)};pw2=(u32x4){PKW(pB1,0),PKW(pB1,2),PKW(pB1,4),PKW(pB1,6)};pw3=(u32x4){PKW(pB1,8),PKW(pB1,10),PKW(pB1,12),PKW(pB1,14)};
    SBAR(); pv(o,vb0+sl_cur,PAF(0),PAF(1),PAF(2),PAF(3)); }
  #undef PKW
  #undef PAF
  #undef VFR
  #undef PIN
  #undef MX3
  #undef GAPA
  #undef GAPB
  #undef EX
  #undef VRD
  #undef KRD
  #undef STEP
  #undef ENDW
  {auto rr=__builtin_amdgcn_permlane32_swap(__float_as_uint(l_reg),__float_as_uint(l_reg),false,false);l_reg=__uint_as_float(rr[0])+__uint_as_float(rr[1]);}
  if(hi==0)wsf[32+r32]=l_reg;asm volatile("s_waitcnt lgkmcnt(0)":::"memory");
  float rli[16];
  #pragma unroll
  for(int r=0;r<16;++r)rli[r]=__builtin_amdgcn_rcpf(wsf[32+crow(r,hi)]);
  bf16*Ow=O+(rowbase+q0+wid*QBLK)*DM+ocol;
  { bf16*stg=(bf16*)(shm+LDS_OST)+wid*2048;
    #pragma unroll
    for(int r=0;r<16;++r){const int orow=crow(r,hi);
      #pragma unroll
      for(int d0=0;d0<2;++d0)stg[orow*64+d0*32+r32]=__float2bfloat16(o[d0][r]*rli[r]);}
    asm volatile("s_waitcnt lgkmcnt(0)":::"memory");
    #pragma unroll
    for(int i=0;i<4;++i){const int row=i*8+(lane>>3),ch=lane&7; const u32x4 v=*(const u32x4*)(stg+row*64+ch*8); ATTN_STORE16(Ow+(long)row*DM+ch*8,v);} }
  asm volatile("s_waitcnt lgkmcnt(0)\n\ts_barrier":::"memory");
  #undef DMA_K
  #undef DMA_V
  #undef CMASK
  #undef START
  #undef RESC
  #undef ROT
}
constexpr int ATTN_LDS_BYTES=LDS_BYTES;
struct AttnTensors { const bf16* Q; const bf16* K; const bf16* V; bf16* O; };
struct AttnUnit { int bh; int qb; };
struct StaticOrder {
  int vcu;
  __device__ __forceinline__ explicit StaticOrder(int grid,int block):vcu((block%8)*(grid/8)+block/8){}
  __device__ __forceinline__ bool next(int i,AttnUnit&u)const{ if(i>=4)return false; const int s=vcu&7; u.bh=vcu>>3; u.qb=(i==0)?s:(i==1)?15-s:(i==2)?16+s:31-s; return true; }
  __device__ __forceinline__ void a_ready(const AttnUnit&)const{}
  __device__ __forceinline__ void done(const AttnUnit&)const{}
};
template<class Sched,int THRL=8> __device__ __forceinline__ void attn_phase(char*lds,const AttnTensors&T,const Sched&S){
  AttnUnit u;
  for(int i=0;S.next(i,u);++i){ S.a_ready(u); { const int hp=u.bh%NHEAD; attn_unit<THRL>(u.bh/NHEAD,(hp>>1)*64,(hp>>2)*128+(hp&1)*64,hp*64,u.qb,T.Q,T.K,T.V,T.O,lds); } S.done(u); }
}
#undef SBAR
#undef WAIT_BAR
}

constexpr int NWAVES = 8;
constexpr int BATCH = 2, T = 8192, D = 1024, M = BATCH * T;
constexpr int NPROJ = 5632;
constexpr int IN_W = 5640;
constexpr float EPS = 1e-6f;
constexpr int NE = 32, FH = 256;
constexpr int XG_ROWS = 160 * 256;
constexpr int N_PHASES = 13;

constexpr size_t MiB = 1u << 20;
constexpr size_t WS_CTL = 0, CTL_ZERO_BYTES = 1 * MiB;
constexpr size_t WS_WIN = 1 * MiB;
constexpr size_t WS_WA = 12 * MiB, WS_WB = 13 * MiB, WS_WOUT = 14 * MiB;
constexpr size_t WS_BD = 16 * MiB;
constexpr size_t WS_POS = 16 * MiB + 512 * 1024;
constexpr size_t WS_ROWW = 17 * MiB;
constexpr size_t WS_ROUTE = 17 * MiB + 256 * 1024;
constexpr size_t WS_WR = 17 * MiB + 512 * 1024;
constexpr size_t WS_GU = 18 * MiB;
constexpr size_t WS_WN = 18 * MiB, WS_KDT = 34 * MiB, WS_U = 50 * MiB;
constexpr size_t WS_QD = 210 * MiB, WS_IN = 226 * MiB, WS_GL = 234 * MiB;
constexpr size_t WS_SB = 146 * MiB, WS_VB = 178 * MiB;
constexpr size_t WS_DN = 50 * MiB;
constexpr size_t WS_H = 66 * MiB;
constexpr size_t WS_Q = 98 * MiB, WS_K = 114 * MiB, WS_V = 130 * MiB;
constexpr size_t WS_G = 146 * MiB;
constexpr size_t WS_GATE = 194 * MiB;
constexpr size_t WS_XG = 146 * MiB;
constexpr size_t WS_YG = 66 * MiB;
constexpr size_t WS_ACT = 226 * MiB;
constexpr size_t WS_END = 256 * MiB;
static_assert(WS_XG + (size_t)XG_ROWS * 1024 * 2 <= WS_ACT && WS_ACT + (size_t)XG_ROWS * 256 * 2 <= WS_END && WS_YG + (size_t)XG_ROWS * 1024 * 2 <= WS_XG, "ws map");
static_assert(WS_WR + 36 * 1024 * 4 <= WS_GU && WS_ROWW + XG_ROWS * 4 <= WS_ROUTE && WS_ROUTE + (size_t)M * 16 <= WS_WR, "ws map small");
constexpr int CW_TMO = 0, CW_CODE = 1;
constexpr int CW_BAR = 4096;
constexpr int CW_CNT = 16384, CW_CUR = 16384 + 32 * 64;
constexpr int RING_OFF = 0, RING_BYTES = 131072;
constexpr int LDSCTL_OFF = RING_BYTES, MISC_OFF = LDSCTL_OFF + 320;
constexpr int TS_OFF = MISC_OFF + 128;
constexpr int GDN_AB_OFF = LDSCTL_OFF + 1024;
constexpr int LDS_BYTES = 147456;

#define GAS __attribute__((address_space(1)))
#define LAS __attribute__((address_space(3)))
typedef unsigned short bf16;
typedef unsigned v4u __attribute__((ext_vector_type(4)));
typedef unsigned v2u __attribute__((ext_vector_type(2)));
typedef float f32x4 __attribute__((ext_vector_type(4)));
typedef GAS unsigned gu32;
#define RLX_AGENT __ATOMIC_RELAXED, __HIP_MEMORY_SCOPE_AGENT
#define LDS_WAIT() asm volatile("s_waitcnt lgkmcnt(0)" ::: "memory")
#define VM_WAIT() asm volatile("s_waitcnt vmcnt(0)" ::: "memory")
__device__ __forceinline__ unsigned f2bf(float f) { unsigned u = __builtin_bit_cast(unsigned, f); return (u + 0x7fffu + ((u >> 16) & 1u)) >> 16; }
__device__ __forceinline__ unsigned pk2(float lo, float hi) { return f2bf(lo) | (f2bf(hi) << 16); }
__device__ __forceinline__ float bflo(unsigned w) { return __uint_as_float(w << 16); }
__device__ __forceinline__ float bfhi(unsigned w) { return __uint_as_float(w & 0xffff0000u); }
__device__ __forceinline__ float sigm(float x) { return 1.0f / (1.0f + __expf(-x)); }

#define XB_TMO      128
#define XB_XCNT(j)  (256  + 64 * (j))
#define XB_XSUB(j)  (1280 + 64 * (j))
#define XB_XGEN(j)  (2304 + 64 * (j))
#define XB_TOP      3328
#define XB_TOPGEN   3392
#define XCD_BAR_WORDS 3456
#define XB_SPIN_CAP (1u << 22)
__device__ __forceinline__ unsigned xb_ld(unsigned* p)              { return __hip_atomic_load(p, __ATOMIC_RELAXED, __HIP_MEMORY_SCOPE_AGENT); }
__device__ __forceinline__ unsigned xb_add(unsigned* p, unsigned v) { return __hip_atomic_fetch_add(p, v, __ATOMIC_RELAXED, __HIP_MEMORY_SCOPE_AGENT); }
__device__ __forceinline__ unsigned xb_xcc_id() { return (unsigned)__builtin_amdgcn_s_getreg((3 << 11) | 20) & 0xFu; }
#define XB_SPIN(cond, bar) do { unsigned _sp = 0; while (cond) { __builtin_amdgcn_s_sleep(1); \
    if ((++_sp & 255u) == 0u) { if (xb_ld(&(bar)[XB_TMO])) break; if (_sp > XB_SPIN_CAP) { atomicAdd(&(bar)[XB_TMO], 1u); break; } } } } while (0)
struct XcdBarrier { unsigned* bar; unsigned x; volatile LAS unsigned* st; };
__device__ __forceinline__ XcdBarrier xcd_barrier_post(unsigned* bar, volatile LAS unsigned* st) {
    XcdBarrier b; b.bar = bar; b.x = xb_xcc_id(); b.st = st;
    if (threadIdx.x == 0) (void)xb_add(&bar[XB_XCNT(b.x)], 1u);
    return b;
}
__device__ __forceinline__ void xcd_barrier_complete(unsigned* bar, unsigned x, unsigned& nloc, unsigned& nx) {
    const unsigned G = gridDim.x * gridDim.y * gridDim.z;
    unsigned sum, cnt, mine, sp = 0u;
    for (;;) {
        sum = 0u; cnt = 0u; mine = 0u;
#pragma unroll
        for (unsigned j = 0; j < 16; ++j) { const unsigned c = xb_ld(&bar[XB_XCNT(j)]); sum += c; cnt += (c > 0u) ? 1u : 0u; mine = (j == x) ? c : mine; }
        if (sum == G) break;
        __builtin_amdgcn_s_sleep(1);
        if ((++sp & 255u) == 0u) { if (xb_ld(&bar[XB_TMO])) break; if (sp > XB_SPIN_CAP) { atomicAdd(&bar[XB_TMO], 1u); break; } }
    }
    nloc = mine > 0u ? mine : 1u; nx = cnt > 0u ? cnt : 1u;
}
__device__ __forceinline__ void xcd_barrier(const XcdBarrier& b) {
    asm volatile("s_waitcnt vmcnt(0)" ::: "memory");
    __syncthreads();
    if (threadIdx.x == 0) {
        unsigned* bar = b.bar;
        __builtin_amdgcn_s_waitcnt(0);
        unsigned nloc = b.st[0], nx = b.st[1];
        if (nloc == 0u) { xcd_barrier_complete(bar, b.x, nloc, nx); b.st[0] = nloc; b.st[1] = nx; }
        const unsigned old = xb_add(&bar[XB_XSUB(b.x)], 1u);
        const unsigned gen = old / nloc;
        if (old + 1u == (gen + 1u) * nloc) {
            __builtin_amdgcn_fence(__ATOMIC_RELEASE, "agent");
            asm volatile("s_waitcnt vmcnt(0)" ::: "memory");
            const unsigned og = xb_add(&bar[XB_TOP], 1u);
            const unsigned tg = og / nx;
            if (og + 1u == (tg + 1u) * nx) xb_add(&bar[XB_TOPGEN], 1u);
            else XB_SPIN(xb_ld(&bar[XB_TOPGEN]) == tg, bar);
            __builtin_amdgcn_fence(__ATOMIC_ACQUIRE, "agent");
            xb_add(&bar[XB_XGEN(b.x)], 1u);
            asm volatile("s_waitcnt vmcnt(0)" ::: "memory");
        } else {
            XB_SPIN(xb_ld(&bar[XB_XGEN(b.x)]) == gen, bar);
            __builtin_amdgcn_fence(__ATOMIC_ACQUIRE, "agent");
            asm volatile("s_waitcnt vmcnt(0)" ::: "memory");
        }
    }
    __syncthreads();
}

#define CAS __attribute__((address_space(4)))
struct Args { const float* in[24]; float* out; unsigned char* ws; int ph_lo, ph_hi; };
#define FIN(k) (F.ka->in[k])
struct Frame {
    LAS unsigned char* lds;
    volatile LAS unsigned* MISC;
    gu32* ctl;
    int tid, lane, wave;
    int vcu, G;
    unsigned char* ws;
    float* out;
    const CAS Args* ka;
};
__device__ __forceinline__ float wave_sum(float v) {
#pragma unroll
    for (int o = 1; o < 64; o <<= 1) v += __shfl_xor(v, o);
    return v;
}
__device__ __forceinline__ void p0_transpose_item(const float* W, int ldw, int col0, int K, int nblk, bf16* WT, int dst_row0, LAS float* scr, int item, int lane) {
    const int kb = item / nblk, nb = item % nblk, k0 = 64 * kb, n0 = 32 * nb;
#pragma unroll 8
    for (int i = 0; i < 32; ++i) { const int kk = 2 * i + (lane >> 5); scr[kk * 33 + (lane & 31)] = W[(size_t)(k0 + kk) * ldw + col0 + n0 + (lane & 31)]; }
    LDS_WAIT(); asm volatile("" ::: "memory");
    const int c = lane & 7;
#pragma unroll
    for (int j = 0; j < 4; ++j) { const int n = (lane >> 3) + 8 * j; const LAS float* s = scr + (8 * c) * 33 + n;
        v4u o; o.x = pk2(s[0 * 33], s[1 * 33]); o.y = pk2(s[2 * 33], s[3 * 33]); o.z = pk2(s[4 * 33], s[5 * 33]); o.w = pk2(s[6 * 33], s[7 * 33]);
        *(GAS v4u*)(WT + (size_t)(dst_row0 + n0 + n) * K + k0 + 8 * c) = o; }
    LDS_WAIT(); asm volatile("" ::: "memory");
}

__device__ __forceinline__ void moe_weights_phase(Frame& F) {
    LAS float* scr = (LAS float*)(F.lds + RING_OFF + F.wave * 16384);
    const int gw = F.vcu * NWAVES + F.wave, NGW = F.G * NWAVES;
    bf16* GU = (bf16*)(F.ws + WS_GU); bf16* DN = (bf16*)(F.ws + WS_DN);
    constexpr int I_G1 = 16 * 4;
    constexpr int I_GU = NE * 4 * I_G1, I_DN = NE * 4 * 32;
    for (int it = gw; it < I_GU + I_DN; it += NGW) {
        int r = it;
        if (r < I_GU) { const int blk = r / I_G1, i2 = r % I_G1, e = blk >> 2, pn = (blk >> 1) & 1, isup = blk & 1;
            p0_transpose_item((isup ? FIN(21) : FIN(20)) + (size_t)e * 1024 * 256, 256, 128 * pn, 1024, 4, GU, e * 512 + 256 * pn + 128 * isup, scr, i2, F.lane); continue; } r -= I_GU;
        { const int e = r / 128, i2 = r % 128; p0_transpose_item(FIN(22) + (size_t)e * 256 * 1024, 1024, 0, 256, 32, DN, e * 1024, scr, i2, F.lane); }
    }
}

__device__ __forceinline__ void p0_prologue(Frame& F) {
    LAS float* scr = (LAS float*)(F.lds + RING_OFF + F.wave * 16384);
    const int gw = F.vcu * NWAVES + F.wave, NGW = F.G * NWAVES;
    bf16* WIN = (bf16*)(F.ws + WS_WIN); bf16* WA = (bf16*)(F.ws + WS_WA); bf16* WB = (bf16*)(F.ws + WS_WB); bf16* WO = (bf16*)(F.ws + WS_WOUT);
    constexpr int I_IN0 = 16 * 96, I_IN1 = 16 * 16, I_IN2 = 16 * 32, I_IN3 = 16 * 32;
    constexpr int I_A = 8 * 32, I_B = 8 * 32, I_O = 16 * 32;
    constexpr int NITEMS = I_IN0 + I_IN1 + I_IN2 + I_IN3 + I_A + I_B + I_O;
    for (int it = gw; it < NITEMS; it += NGW) {
        int r = it;
        if (r < I_IN0) { p0_transpose_item(FIN(2), IN_W, 0, D, 96, WIN, 0, scr, r, F.lane); continue; } r -= I_IN0;
        if (r < I_IN1) { p0_transpose_item(FIN(2), IN_W, 3080, D, 16, WIN, 3072, scr, r, F.lane); continue; } r -= I_IN1;
        if (r < I_IN2) { p0_transpose_item(FIN(2), IN_W, 3592, D, 32, WIN, 3584, scr, r, F.lane); continue; } r -= I_IN2;
        if (r < I_IN3) { p0_transpose_item(FIN(2), IN_W, 4616, D, 32, WIN, 4608, scr, r, F.lane); continue; } r -= I_IN3;
        if (r < I_A) { p0_transpose_item(FIN(12), 1024, 0, 512, 32, WA, 0, scr, r, F.lane); continue; } r -= I_A;
        if (r < I_B) { p0_transpose_item(FIN(13), 1024, 0, 512, 32, WB, 0, scr, r, F.lane); continue; } r -= I_B;
        p0_transpose_item(FIN(14), 1024, 0, 1024, 32, WO, 0, scr, r, F.lane);
    }
    { float* WR = (float*)(F.ws + WS_WR); const int gt = F.vcu * (NWAVES * 64) + F.tid, NT = F.G * NWAVES * 64;
      for (int i = gt; i < 36 * 1024; i += NT) { const int c = i >> 10, k = i & 1023; WR[i] = (c < 4) ? FIN(16)[k * 4 + c] : FIN(18)[k * 32 + (c - 4)]; } }
    __syncthreads();
    LAS float* W8 = (LAS float*)(F.lds + RING_OFF);
    for (int i = F.tid; i < 1024 * 8; i += NWAVES * 64) W8[i] = FIN(2)[(size_t)(i >> 3) * IN_W + 3072 + (i & 7)];
    __syncthreads();
    bf16* H = (bf16*)(F.ws + WS_H); float* BD = (float*)(F.ws + WS_BD);
    for (int m = gw; m < M; m += NGW) {
        const GAS f32x4* xr = (const GAS f32x4*)(FIN(0) + (size_t)m * D) + F.lane;
        f32x4 v[4]; float s2 = 0.f;
#pragma unroll
        for (int j = 0; j < 4; ++j) { v[j] = xr[64 * j]; s2 += (v[j].x * v[j].x + v[j].y * v[j].y) + (v[j].z * v[j].z + v[j].w * v[j].w); }
        const float rstd = 1.f / sqrtf(wave_sum(s2) * (1.f / D) + EPS);
        float bd[8];
#pragma unroll
        for (int q = 0; q < 8; ++q) bd[q] = 0.f;
        GAS unsigned long long* o8 = (GAS unsigned long long*)(H + (size_t)m * D) + F.lane;
#pragma unroll
        for (int j = 0; j < 4; ++j) { const f32x4 g = *((const GAS f32x4*)FIN(1) + F.lane + 64 * j); v[j] = v[j] * rstd * g;
            o8[64 * j] = (unsigned long long)pk2(v[j].x, v[j].y) | ((unsigned long long)pk2(v[j].z, v[j].w) << 32);
#pragma unroll
            for (int i = 0; i < 4; ++i) { const int k = 256 * j + 4 * F.lane + i; const f32x4 wa = *(const LAS f32x4*)(W8 + k * 8), wb = *(const LAS f32x4*)(W8 + k * 8 + 4); const float xv = v[j][i];
                bd[0] += xv * wa.x; bd[1] += xv * wa.y; bd[2] += xv * wa.z; bd[3] += xv * wa.w; bd[4] += xv * wb.x; bd[5] += xv * wb.y; bd[6] += xv * wb.z; bd[7] += xv * wb.w; } }
#pragma unroll
        for (int q = 0; q < 8; ++q) bd[q] = wave_sum(bd[q]);
        if (F.lane == 0) { *(GAS f32x4*)(BD + (size_t)m * 8) = (f32x4){bd[0], bd[1], bd[2], bd[3]}; *(GAS f32x4*)(BD + (size_t)m * 8 + 4) = (f32x4){bd[4], bd[5], bd[6], bd[7]}; }
    }
}

typedef float f32x16 __attribute__((ext_vector_type(16)));
typedef short bf16x8v __attribute__((ext_vector_type(8)));
typedef float f32x2_t __attribute__((ext_vector_type(2))); typedef __bf16 bf16x2_t __attribute__((ext_vector_type(2)));
__device__ __forceinline__ unsigned cvtpk(float lo, float hi) { f32x2_t v = {lo, hi}; bf16x2_t b = __builtin_convertvector(v, bf16x2_t); return __builtin_bit_cast(unsigned, b); }
__device__ __forceinline__ bf16x8v pack_half(const f32x16& x, int s) {
    v4u p; p.x = cvtpk(x[8 * s], x[8 * s + 1]); p.y = cvtpk(x[8 * s + 2], x[8 * s + 3]); p.z = cvtpk(x[8 * s + 4], x[8 * s + 5]); p.w = cvtpk(x[8 * s + 6], x[8 * s + 7]);
    return __builtin_bit_cast(bf16x8v, p);
}
#define MFMA32(a, b, c) __builtin_amdgcn_mfma_f32_32x32x16_bf16((a), (b), (c), 0, 0, 0)
__device__ __forceinline__ int crow16(int r, int h) { return (r & 3) + 8 * (r >> 2) + 4 * h; }
__device__ __forceinline__ constexpr int perm16c(int p) { return (p & ~0xC) | ((p & 8) >> 1) | ((p & 4) << 1); }

constexpr int GP = 272, TPB = 144;
constexpr int GA_QS = 0, GA_KS = 17408, GA_VBT = 34816, GA_KBT = 53248, GA_AM = 71680, GA_TT = 88320, GA_TB = 105728, GA_END = 114944;
constexpr int GA_SM = LDSCTL_OFF + 1024;
static_assert(GA_END <= RING_BYTES, "GDN-A LDS");

__device__ __forceinline__ void gdn_a_phase(Frame& F) {
    const int tid = F.tid, lane = F.lane, wave = F.wave, r32 = lane & 31, hh = lane >> 5;
    LAS unsigned char* L = F.lds + RING_OFF;
    LAS float* SM = (LAS float*)(F.lds + GA_SM);
    LAS float* AM = (LAS float*)(L + GA_AM); LAS float* TT = (LAS float*)(L + GA_TT);
    const bf16* G = (const bf16*)(F.ws + WS_G); const float* BD = (const float*)(F.ws + WS_BD);
    bf16* WN = (bf16*)(F.ws + WS_WN); bf16* KDT = (bf16*)(F.ws + WS_KDT); bf16* UF = (bf16*)(F.ws + WS_U); bf16* QD = (bf16*)(F.ws + WS_QD); bf16* INp = (bf16*)(F.ws + WS_IN); float* GL = (float*)(F.ws + WS_GL);
    const int c = tid >> 3, seg = tid & 7;
    for (int item = F.vcu; item < 1024; item += F.G) {
        const int b = item >> 9, h = (item >> 7) & 3, n = item & 127, t0 = b * T + n * 64;
        if (wave == 0) {
            const float* bd = BD + (size_t)(t0 + lane) * 8; const float xd = bd[4 + h] + FIN(10)[h]; const float sp = xd > 20.f ? xd : log1pf(__expf(xd));
            float gc = -__expf(FIN(9)[h]) * sp;
#pragma unroll
            for (int d = 1; d < 64; d <<= 1) { const float o = __shfl_up(gc, d); if (lane >= d) gc += o; }
            const float g63 = __shfl(gc, 63);
            SM[lane] = gc; SM[64 + lane] = sigm(bd[h]); SM[128 + lane] = __expf(gc); SM[192 + lane] = __expf(g63 - gc);
            if (lane == 0) GL[item] = __expf(g63);
        }
        for (int i = tid; i < 64 * 68; i += NWAVES * 64) TT[i] = 0.f;
        __syncthreads();
        const float be = SM[64 + c], eg = SM[128 + c];
#pragma unroll
        for (int j = 0; j < 3; ++j) {
            const int ch = j * 512 + h * 128 + seg * 16; float a[16];
#pragma unroll
            for (int i = 0; i < 16; ++i) a[i] = 0.f;
#pragma unroll
            for (int jj = 0; jj < 4; ++jj) { const int tl = n * 64 + c - 3 + jj;
                if (tl >= 0) { const bf16* rp = G + (size_t)(b * T + tl) * 1536 + ch; const v4u r0 = *(const v4u*)rp, r1 = *(const v4u*)(rp + 8); const unsigned rw[8] = {r0.x, r0.y, r0.z, r0.w, r1.x, r1.y, r1.z, r1.w};
                    const float* wp = FIN(8) + jj * 1536 + ch;
#pragma unroll
                    for (int i = 0; i < 8; ++i) { a[2 * i] += wp[2 * i] * bflo(rw[i]); a[2 * i + 1] += wp[2 * i + 1] * bfhi(rw[i]); } } }
            float ss = 0.f;
#pragma unroll
            for (int i = 0; i < 16; ++i) { a[i] = a[i] * sigm(a[i]); ss += a[i] * a[i]; }
            ss += __shfl_xor(ss, 1); ss += __shfl_xor(ss, 2); ss += __shfl_xor(ss, 4);
            if (j == 0) {
                const float sc = 0.08838834764831845f / sqrtf(ss + EPS); unsigned w[8], wd[8];
#pragma unroll
                for (int i = 0; i < 16; ++i) a[i] *= sc;
#pragma unroll
                for (int i = 0; i < 8; ++i) { w[i] = pk2(a[2 * i], a[2 * i + 1]); wd[i] = pk2(a[perm16c(2 * i)] * eg, a[perm16c(2 * i + 1)] * eg); }
                *(LAS v4u*)(L + GA_QS + c * GP + seg * 32) = (v4u){w[0], w[1], w[2], w[3]}; *(LAS v4u*)(L + GA_QS + c * GP + seg * 32 + 16) = (v4u){w[4], w[5], w[6], w[7]};
                bf16* qp = QD + (size_t)item * 8192 + c * 128 + seg * 16; *(v4u*)qp = (v4u){wd[0], wd[1], wd[2], wd[3]}; *(v4u*)(qp + 8) = (v4u){wd[4], wd[5], wd[6], wd[7]};
            } else if (j == 1) {
                const float sc = 1.f / sqrtf(ss + EPS); unsigned w[8];
#pragma unroll
                for (int i = 0; i < 16; ++i) a[i] *= sc;
#pragma unroll
                for (int i = 0; i < 8; ++i) w[i] = pk2(a[2 * i], a[2 * i + 1]);
                *(LAS v4u*)(L + GA_KS + c * GP + seg * 32) = (v4u){w[0], w[1], w[2], w[3]}; *(LAS v4u*)(L + GA_KS + c * GP + seg * 32 + 16) = (v4u){w[4], w[5], w[6], w[7]};
                const float kb = be * eg;
#pragma unroll
                for (int i = 0; i < 16; ++i) *(LAS unsigned short*)(L + GA_KBT + (seg * 16 + i) * TPB + c * 2) = (unsigned short)f2bf(a[i] * kb);
            } else {
#pragma unroll
                for (int i = 0; i < 16; ++i) *(LAS unsigned short*)(L + GA_VBT + (seg * 16 + i) * TPB + c * 2) = (unsigned short)f2bf(a[i] * be);
            }
        }
        __syncthreads();
        {
            const int w4 = wave & 3, ta = w4 >> 1, tb = w4 & 1;
            f32x16 acc = {};
            const LAS unsigned char* ap = L + GA_KS + (32 * ta + r32) * GP + hh * 16;
            const LAS unsigned char* bp = L + (wave < 4 ? GA_KS : GA_QS) + (32 * tb + r32) * GP + hh * 16;
#pragma unroll
            for (int s = 0; s < 8; ++s) acc = MFMA32(*(const LAS bf16x8v*)(ap + s * 32), *(const LAS bf16x8v*)(bp + s * 32), acc);
            const int cidx = 32 * tb + r32; const float gcc = SM[cidx];
            if (wave < 4) {
#pragma unroll
                for (int r = 0; r < 16; ++r) { const int i = 32 * ta + crow16(r, hh); const float val = (cidx < i) ? SM[64 + i] * acc[r] * __expf(SM[i] - gcc) : 0.f; AM[i * 64 + cidx] = val; }
            } else {
#pragma unroll
                for (int r = 0; r < 16; ++r) { const int j = 32 * ta + crow16(r, hh); acc[r] = (j <= cidx) ? acc[r] * __expf(gcc - SM[j]) : 0.f; }
                bf16* ip = INp + (size_t)item * 4096 + cidx * 64 + 32 * ta + 8 * hh;
                *(bf16x8v*)ip = pack_half(acc, 0); *(bf16x8v*)(ip + 16) = pack_half(acc, 1);
            }
        }
        __syncthreads();
        if (wave == 0) {
            LAS float* tr = TT + lane * 68;
            for (int i = 0; i < 64; ++i) {
                float acc = (i == lane) ? 1.f : 0.f; const LAS float* ar = AM + i * 64;
                for (int j = 0; j < i; j += 4) { const f32x4 av = *(const LAS f32x4*)(ar + j), tv = *(const LAS f32x4*)(tr + j); acc -= (av.x * tv.x + av.y * tv.y) + (av.z * tv.z + av.w * tv.w); }
                tr[i] = acc;
            }
        }
        __syncthreads();
        { unsigned w[4];
#pragma unroll
          for (int e = 0; e < 4; ++e) w[e] = pk2(TT[(8 * seg + 2 * e) * 68 + c], TT[(8 * seg + 2 * e + 1) * 68 + c]);
          *(LAS v4u*)(L + GA_TB + c * TPB + seg * 16) = (v4u){w[0], w[1], w[2], w[3]}; }
        { const int kk = tid >> 2, cg = tid & 3; unsigned w[8];
#pragma unroll
          for (int e = 0; e < 8; ++e) { const int c0 = 16 * cg + perm16c(2 * e), c1 = 16 * cg + perm16c(2 * e + 1);
              const float v0 = bflo((unsigned)*(const LAS unsigned short*)(L + GA_KS + c0 * GP + kk * 2)) * SM[192 + c0], v1 = bflo((unsigned)*(const LAS unsigned short*)(L + GA_KS + c1 * GP + kk * 2)) * SM[192 + c1];
              w[e] = pk2(v0, v1); }
          bf16* kp = KDT + (size_t)item * 8192 + kk * 64 + cg * 16; *(v4u*)kp = (v4u){w[0], w[1], w[2], w[3]}; *(v4u*)(kp + 8) = (v4u){w[4], w[5], w[6], w[7]}; }
        __syncthreads();
#pragma unroll
        for (int rep = 0; rep < 2; ++rep) {
            const int t = wave + 8 * rep;
            if (rep == 0) {
                const int ct = t >> 2, vs = t & 3; f32x16 acc = {};
                const LAS unsigned char* ap = L + GA_TB + (32 * ct + r32) * TPB + hh * 16; const LAS unsigned char* bp = L + GA_VBT + (32 * vs + r32) * TPB + hh * 16;
#pragma unroll
                for (int s = 0; s < 4; ++s) acc = MFMA32(*(const LAS bf16x8v*)(ap + s * 32), *(const LAS bf16x8v*)(bp + s * 32), acc);
                bf16* up = UF + (size_t)item * 8192 + ((ct * 4 + vs) * 64 + lane) * 16;
                *(bf16x8v*)up = pack_half(acc, 0); *(bf16x8v*)(up + 8) = pack_half(acc, 1);
            } else {
                const int kt = (t - 8) >> 1, ct = (t - 8) & 1; f32x16 acc = {};
                const LAS unsigned char* ap = L + GA_KBT + (32 * kt + r32) * TPB + hh * 16; const LAS unsigned char* bp = L + GA_TB + (32 * ct + r32) * TPB + hh * 16;
#pragma unroll
                for (int s = 0; s < 4; ++s) acc = MFMA32(*(const LAS bf16x8v*)(ap + s * 32), *(const LAS bf16x8v*)(bp + s * 32), acc);
#pragma unroll
                for (int r = 0; r < 16; ++r) acc[r] = -acc[r];
                bf16* wp = WN + (size_t)item * 8192 + (32 * ct + r32) * 128 + 32 * kt + 8 * hh;
                *(bf16x8v*)wp = pack_half(acc, 0); *(bf16x8v*)(wp + 16) = pack_half(acc, 1);
            }
        }
        __syncthreads();
    }
}

constexpr int GB_WN = 0, GB_KD = 17408, GB_U = 35840, GB_BUF = 52224;
static_assert(2 * GB_BUF <= RING_BYTES, "GDN-B LDS");
__device__ __forceinline__ void gdn_b_phase(Frame& F) {
    if (blockIdx.x >= 8) return;
    const int tid = F.tid, lane = F.lane, wave = F.wave, r32 = lane & 31, hh = lane >> 5;
    LAS unsigned char* L = F.lds + RING_OFF;
    const bf16* WN = (const bf16*)(F.ws + WS_WN); const bf16* KDT = (const bf16*)(F.ws + WS_KDT); const bf16* UF = (const bf16*)(F.ws + WS_U); const float* GL = (const float*)(F.ws + WS_GL);
    bf16* SB = (bf16*)(F.ws + WS_SB); bf16* VB = (bf16*)(F.ws + WS_VB);
    const int item0 = blockIdx.x * 128;
    f32x16 S[4];
#pragma unroll
    for (int k = 0; k < 4; ++k) S[k] = (f32x16){};
    v4u st[6];
#define GB_LOAD(it) do { const v4u* a_ = (const v4u*)(WN + (size_t)(it) * 8192); const v4u* b_ = (const v4u*)(KDT + (size_t)(it) * 8192); const v4u* c_ = (const v4u*)(UF + (size_t)(it) * 8192); \
        st[0] = a_[tid]; st[1] = a_[tid + 512]; st[2] = b_[tid]; st[3] = b_[tid + 512]; st[4] = c_[tid]; st[5] = c_[tid + 512]; } while (0)
#define GB_WRITE(buf) do { LAS unsigned char* B_ = L + (buf) * GB_BUF; \
        *(LAS v4u*)(B_ + GB_WN + (tid >> 4) * GP + (tid & 15) * 16) = st[0]; *(LAS v4u*)(B_ + GB_WN + ((tid + 512) >> 4) * GP + (tid & 15) * 16) = st[1]; \
        *(LAS v4u*)(B_ + GB_KD + (tid >> 3) * TPB + (tid & 7) * 16) = st[2]; *(LAS v4u*)(B_ + GB_KD + ((tid + 512) >> 3) * TPB + (tid & 7) * 16) = st[3]; \
        *(LAS v4u*)(B_ + GB_U + tid * 16) = st[4]; *(LAS v4u*)(B_ + GB_U + (tid + 512) * 16) = st[5]; } while (0)
    GB_LOAD(item0); GB_WRITE(0);
    __syncthreads();
    for (int n = 0; n < 128; ++n) {
        const int item = item0 + n; const int buf = n & 1;
        if (n + 1 < 128) GB_LOAD(item + 1);
        if (wave < 4) {
            const int vs = wave; const LAS unsigned char* B_ = L + buf * GB_BUF;
            const float gl = GL[item];
            bf16x8v sb[4][2];
#pragma unroll
            for (int kt = 0; kt < 4; ++kt)
#pragma unroll
                for (int s = 0; s < 2; ++s) { sb[kt][s] = pack_half(S[kt], s); *(bf16x8v*)(SB + ((((size_t)item * 4 + vs) * 4 + kt) * 2 + s) * 512 + lane * 8) = sb[kt][s]; }
            bf16x8v vb[2][2];
#pragma unroll
            for (int ct = 0; ct < 2; ++ct) {
                const LAS unsigned char* up = B_ + GB_U + ((ct * 4 + vs) * 64 + lane) * 32; const v4u u0 = *(const LAS v4u*)up, u1 = *(const LAS v4u*)(up + 16);
                f32x16 acc; acc[0] = bflo(u0.x); acc[1] = bfhi(u0.x); acc[2] = bflo(u0.y); acc[3] = bfhi(u0.y); acc[4] = bflo(u0.z); acc[5] = bfhi(u0.z); acc[6] = bflo(u0.w); acc[7] = bfhi(u0.w);
                acc[8] = bflo(u1.x); acc[9] = bfhi(u1.x); acc[10] = bflo(u1.y); acc[11] = bfhi(u1.y); acc[12] = bflo(u1.z); acc[13] = bfhi(u1.z); acc[14] = bflo(u1.w); acc[15] = bfhi(u1.w);
                const LAS unsigned char* ap = B_ + GB_WN + (32 * ct + r32) * GP + hh * 16;
#pragma unroll
                for (int kt = 0; kt < 4; ++kt)
#pragma unroll
                    for (int s = 0; s < 2; ++s) acc = MFMA32(*(const LAS bf16x8v*)(ap + kt * 64 + s * 32), sb[kt][s], acc);
#pragma unroll
                for (int s = 0; s < 2; ++s) { vb[ct][s] = pack_half(acc, s); *(bf16x8v*)(VB + ((((size_t)item * 4 + vs) * 2 + ct) * 2 + s) * 512 + lane * 8) = vb[ct][s]; }
            }
#pragma unroll
            for (int kt = 0; kt < 4; ++kt) {
                f32x16 acc = S[kt] * gl; const LAS unsigned char* ap = B_ + GB_KD + (32 * kt + r32) * TPB + hh * 16;
#pragma unroll
                for (int ct = 0; ct < 2; ++ct)
#pragma unroll
                    for (int s = 0; s < 2; ++s) acc = MFMA32(*(const LAS bf16x8v*)(ap + ct * 64 + s * 32), vb[ct][s], acc);
                S[kt] = acc;
            }
        }
        if (n + 1 < 128) GB_WRITE(buf ^ 1);
        __syncthreads();
    }
#undef GB_LOAD
#undef GB_WRITE
}

constexpr int GC_OS = 0;
__device__ __forceinline__ void gdn_c_phase(Frame& F) {
    const int tid = F.tid, lane = F.lane, wave = F.wave, r32 = lane & 31, hh = lane >> 5;
    LAS float* OS = (LAS float*)(F.lds + RING_OFF + GC_OS);
    const bf16* QD = (const bf16*)(F.ws + WS_QD); const bf16* INp = (const bf16*)(F.ws + WS_IN); const bf16* SB = (const bf16*)(F.ws + WS_SB); const bf16* VB = (const bf16*)(F.ws + WS_VB);
    const bf16* GATE = (const bf16*)(F.ws + WS_GATE); bf16* YB = (bf16*)(F.ws + WS_K);
    const int ct = wave >> 2, vs = wave & 3, c = tid >> 3, seg = tid & 7;
    for (int item = F.vcu; item < 1024; item += F.G) {
        const int b = item >> 9, h = (item >> 7) & 3, n = item & 127, t0 = b * T + n * 64;
        f32x16 acc = {};
        const bf16* qa = QD + (size_t)item * 8192 + (32 * ct + r32) * 128 + 8 * hh;
        const bf16* sbp = SB + ((size_t)item * 4 + vs) * 4096 + lane * 8;
#pragma unroll
        for (int ks = 0; ks < 8; ++ks) acc = MFMA32(*(const bf16x8v*)(qa + ks * 16), *(const bf16x8v*)(sbp + ks * 512), acc);
        const bf16* ia = INp + (size_t)item * 4096 + (32 * ct + r32) * 64 + 8 * hh;
        const bf16* vbp = VB + ((size_t)item * 4 + vs) * 2048 + lane * 8;
#pragma unroll
        for (int ks = 0; ks < 4; ++ks) acc = MFMA32(*(const bf16x8v*)(ia + ks * 16), *(const bf16x8v*)(vbp + ks * 512), acc);
#pragma unroll
        for (int r = 0; r < 16; ++r) OS[(32 * ct + crow16(r, hh)) * 132 + 32 * vs + r32] = acc[r];
        __syncthreads();
        { const int tp = t0 + c; float o[16]; float ss = 0.f;
#pragma unroll
          for (int i = 0; i < 16; ++i) { o[i] = OS[c * 132 + seg * 16 + i]; ss += o[i] * o[i]; }
          ss += __shfl_xor(ss, 1); ss += __shfl_xor(ss, 2); ss += __shfl_xor(ss, 4);
          const float rr = 1.f / sqrtf(ss * (1.f / 128.f) + EPS);
          const v4u g0 = *(const v4u*)(GATE + (size_t)tp * 512 + h * 128 + seg * 16), g1 = *(const v4u*)(GATE + (size_t)tp * 512 + h * 128 + seg * 16 + 8);
          const unsigned gw[8] = {g0.x, g0.y, g0.z, g0.w, g1.x, g1.y, g1.z, g1.w}; unsigned ow[8];
#pragma unroll
          for (int i = 0; i < 8; ++i) { const float ga = bflo(gw[i]), gb = bfhi(gw[i]);
              const float y0 = o[2 * i] * rr * FIN(11)[seg * 16 + 2 * i] * (ga * sigm(ga)), y1 = o[2 * i + 1] * rr * FIN(11)[seg * 16 + 2 * i + 1] * (gb * sigm(gb)); ow[i] = pk2(y0, y1); }
          *(v4u*)(YB + (size_t)tp * 512 + h * 128 + seg * 16) = (v4u){ow[0], ow[1], ow[2], ow[3]}; *(v4u*)(YB + (size_t)tp * 512 + h * 128 + seg * 16 + 8) = (v4u){ow[4], ow[5], ow[6], ow[7]}; }
        __syncthreads();
    }
}

__device__ __forceinline__ void ya_phase(Frame& F) {
    const int gw = F.vcu * NWAVES + F.wave, NGW = F.G * NWAVES, l = F.lane;
    const float lam = __expf(wave_sum(FIN(3)[l] * FIN(4)[l])) - __expf(wave_sum(FIN(5)[l] * FIN(6)[l])) + 0.2f;
    const bf16* OP = (const bf16*)(F.ws + WS_H); bf16* YA = (bf16*)(F.ws + WS_Q);
    const int vh = l >> 5, d = 2 * (l & 31);
    const float g0 = FIN(7)[2 * l] * 0.8f, g1 = FIN(7)[2 * l + 1] * 0.8f;
    for (int m = gw; m < M; m += NGW) {
        const bf16* row = OP + (size_t)m * 1024; unsigned ow[4];
#pragma unroll
        for (int hh = 0; hh < 4; ++hh) {
            const unsigned p0 = *(const unsigned*)(row + ((hh * 2 + 0) * 2 + vh) * 64 + d), p1 = *(const unsigned*)(row + ((hh * 2 + 1) * 2 + vh) * 64 + d);
            const float a0 = bflo(p0) - lam * bflo(p1), a1 = bfhi(p0) - lam * bfhi(p1);
            const float ss = wave_sum(a0 * a0 + a1 * a1);
            const float r = 1.f / sqrtf(ss * (1.f / 128.f) + EPS);
            ow[hh] = pk2(a0 * r * g0, a1 * r * g1);
        }
#pragma unroll
        for (int hh = 0; hh < 4; ++hh) *(unsigned*)(YA + (size_t)m * 512 + hh * 128 + 2 * l) = ow[hh];
    }
}

__device__ __forceinline__ void router_phase(Frame& F) {
    const int gw = F.vcu * NWAVES + F.wave, NGW = F.G * NWAVES, l = F.lane;
    const float* WR = (const float*)(F.ws + WS_WR); bf16* H2 = (bf16*)(F.ws + WS_H); float* ROUTE = (float*)(F.ws + WS_ROUTE);
    f32x4 gn[4];
#pragma unroll
    for (int j = 0; j < 4; ++j) gn[j] = *((const GAS f32x4*)FIN(15) + l + 64 * j);
    for (int m = gw; m < M; m += NGW) {
        const GAS f32x4* xr = (const GAS f32x4*)(F.out + (size_t)m * D) + l;
        f32x4 v[4]; float s2 = 0.f;
#pragma unroll
        for (int j = 0; j < 4; ++j) { v[j] = xr[64 * j]; s2 += (v[j].x * v[j].x + v[j].y * v[j].y) + (v[j].z * v[j].z + v[j].w * v[j].w); }
        const float rstd = 1.f / sqrtf(wave_sum(s2) * (1.f / D) + EPS);
        GAS unsigned long long* o8 = (GAS unsigned long long*)(H2 + (size_t)m * D) + l;
#pragma unroll
        for (int j = 0; j < 4; ++j) { v[j] = v[j] * rstd * gn[j]; o8[64 * j] = (unsigned long long)pk2(v[j].x, v[j].y) | ((unsigned long long)pk2(v[j].z, v[j].w) << 32); }
        float lg[36];
#pragma unroll
        for (int c = 0; c < 36; ++c) { float a = 0.f;
#pragma unroll
            for (int j = 0; j < 4; ++j) { const f32x4 w = *((const GAS f32x4*)(WR + c * 1024) + l + 64 * j); a += (v[j].x * w.x + v[j].y * w.y) + (v[j].z * w.z + v[j].w * w.w); }
            lg[c] = wave_sum(a); }
        float gl[4];
#pragma unroll
        for (int c = 0; c < 4; ++c) gl[c] = lg[c] + FIN(17)[c];
        int gi = 0; float gm = gl[0];
#pragma unroll
        for (int c = 1; c < 4; ++c) if (gl[c] > gm) { gm = gl[c]; gi = c; }
        float den = 0.f;
#pragma unroll
        for (int c = 0; c < 4; ++c) den += __expf(gl[c] - gm);
        const float gwt = 1.f / den;
        float el[8];
#pragma unroll
        for (int j = 0; j < 8; ++j) { float a = lg[4 + j] + FIN(19)[j];
#pragma unroll
            for (int g = 1; g < 4; ++g) a = (gi == g) ? lg[4 + 8 * g + j] + FIN(19)[8 * g + j] : a;
            el[j] = a; }
        int i0 = 0; float v0 = el[0];
#pragma unroll
        for (int j = 1; j < 8; ++j) if (el[j] > v0) { v0 = el[j]; i0 = j; }
        int i1 = -1; float v1 = -INFINITY;
#pragma unroll
        for (int j = 0; j < 8; ++j) if (j != i0 && el[j] > v1) { v1 = el[j]; i1 = j; }
        const float e1 = __expf(v1 - v0), w0 = gwt / (1.f + e1), w1 = gwt * e1 / (1.f + e1);
        const int ex0 = gi * 8 + i0, ex1 = gi * 8 + i1;
        if (l == 0) { *(GAS f32x4*)(ROUTE + (size_t)m * 4) = (f32x4){__int_as_float(ex0), __int_as_float(ex1), w0, w1};
            atomicAdd((unsigned*)(F.ctl + CW_CNT + 64 * ex0), 1u); atomicAdd((unsigned*)(F.ctl + CW_CNT + 64 * ex1), 1u); }
    }
}
__device__ __forceinline__ void moe_build_ts(Frame& F) {
    LAS int* ts = (LAS int*)(F.lds + TS_OFF);
    if (F.tid == 0) { int acc = 0;
        for (int e = 0; e < 32; ++e) { ts[e] = acc; const unsigned n = __hip_atomic_load(F.ctl + CW_CNT + 64 * e, RLX_AGENT); acc += (int)((n + 255u) >> 8); }
        ts[32] = acc; }
    __syncthreads();
}
__device__ __forceinline__ void gather_phase(Frame& F) {
    moe_build_ts(F);
    const LAS int* ts = (const LAS int*)(F.lds + TS_OFF);
    const int gw = F.vcu * NWAVES + F.wave, NGW = F.G * NWAVES, l = F.lane;
    const bf16* H2 = (const bf16*)(F.ws + WS_H); const float* ROUTE = (const float*)(F.ws + WS_ROUTE); bf16* XG = (bf16*)(F.ws + WS_XG); float* ROWW = (float*)(F.ws + WS_ROWW); int* POS = (int*)(F.ws + WS_POS);
    for (int m = gw; m < M; m += NGW) {
        const f32x4 rt = *(const GAS f32x4*)(ROUTE + (size_t)m * 4);
        const int e0 = __float_as_int(rt.x), e1 = __float_as_int(rt.y);
        int p0 = 0, p1 = 0;
        if (l == 0) { p0 = ts[e0] * 256 + (int)atomicAdd((unsigned*)(F.ctl + CW_CUR + 64 * e0), 1u); p1 = ts[e1] * 256 + (int)atomicAdd((unsigned*)(F.ctl + CW_CUR + 64 * e1), 1u);
            ROWW[p0] = rt.z; ROWW[p1] = rt.w; POS[2 * m] = p0; POS[2 * m + 1] = p1; }
        p0 = __builtin_amdgcn_readfirstlane(p0); p1 = __builtin_amdgcn_readfirstlane(p1);
        const v4u a = *((const GAS v4u*)(H2 + (size_t)m * D) + l), bq = *((const GAS v4u*)(H2 + (size_t)m * D) + 64 + l);
        *((GAS v4u*)(XG + (size_t)p0 * D) + l) = a; *((GAS v4u*)(XG + (size_t)p0 * D) + 64 + l) = bq;
        *((GAS v4u*)(XG + (size_t)p1 * D) + l) = a; *((GAS v4u*)(XG + (size_t)p1 * D) + 64 + l) = bq;
    }
}
__device__ __forceinline__ void final_phase(Frame& F) {
    const int gw = F.vcu * NWAVES + F.wave, NGW = F.G * NWAVES, l = F.lane;
    const bf16* YG = (const bf16*)(F.ws + WS_YG); const int* POS = (const int*)(F.ws + WS_POS);
    f32x4 gn[4];
#pragma unroll
    for (int j = 0; j < 4; ++j) gn[j] = *((const GAS f32x4*)FIN(23) + l + 64 * j);
    for (int m = gw; m < M; m += NGW) {
        const int p0 = POS[2 * m], p1 = POS[2 * m + 1];
        GAS f32x4* xr = (GAS f32x4*)(F.out + (size_t)m * D) + l;
        const GAS v2u* y0 = (const GAS v2u*)(YG + (size_t)p0 * D) + l; const GAS v2u* y1 = (const GAS v2u*)(YG + (size_t)p1 * D) + l;
        f32x4 v[4]; float s2 = 0.f;
#pragma unroll
        for (int j = 0; j < 4; ++j) { const v2u a = y0[64 * j], bq = y1[64 * j]; v[j] = xr[64 * j];
            v[j].x += bflo(a.x) + bflo(bq.x); v[j].y += bfhi(a.x) + bfhi(bq.x); v[j].z += bflo(a.y) + bflo(bq.y); v[j].w += bfhi(a.y) + bfhi(bq.y);
            s2 += (v[j].x * v[j].x + v[j].y * v[j].y) + (v[j].z * v[j].z + v[j].w * v[j].w); }
        const float rstd = 1.f / sqrtf(wave_sum(s2) * (1.f / D) + EPS);
#pragma unroll
        for (int j = 0; j < 4; ++j) xr[64 * j] = v[j] * rstd * gn[j];
    }
}

__global__ void __launch_bounds__(NWAVES * 64, 2) mk_fwd(Args args) {
    extern __shared__ __attribute__((aligned(16))) unsigned char lds[];
    Frame F;
    F.lds = (LAS unsigned char*)lds;
    F.MISC = (volatile LAS unsigned*)(F.lds + MISC_OFF);
    F.tid = threadIdx.x; F.lane = F.tid & 63; F.wave = __builtin_amdgcn_readfirstlane(F.tid >> 6);
    F.G = gridDim.x; { const int bx = blockIdx.x; F.vcu = (F.G % 8 == 0) ? (bx % 8) * (F.G / 8) + bx / 8 : bx; }
    F.ws = args.ws; F.out = args.out; F.ctl = (gu32*)(args.ws + WS_CTL);
    F.ka = (const CAS Args*)__builtin_amdgcn_kernarg_segment_ptr();
    for (int u = F.tid; u < (LDS_BYTES - LDSCTL_OFF) / 4; u += NWAVES * 64) ((LAS unsigned*)(F.lds + LDSCTL_OFF))[u] = 0u;
    __syncthreads();
    XcdBarrier bar = xcd_barrier_post((unsigned*)(F.ctl + CW_BAR), F.MISC + 8);
    const int lo = args.ph_lo, hi = args.ph_hi;
#ifndef PHMASK
#define PHMASK 0x1fff
#endif
#define IN(k) (((PHMASK >> (k)) & 1) && lo <= (k) && (k) < hi)
#define SEAM(k) do { if (IN(k) && IN((k) + 1)) xcd_barrier(bar); } while (0)
    bf16* const WIN = (bf16*)(F.ws + WS_WIN); bf16* const Hb = (bf16*)(F.ws + WS_H);
    bf16* const Qb = (bf16*)(F.ws + WS_Q); bf16* const Kb = (bf16*)(F.ws + WS_K); bf16* const Vb = (bf16*)(F.ws + WS_V);
    bf16* const MA = (bf16*)F.out; bf16* const MB = MA + (size_t)M * 1024;

    if (IN(0)) { p0_prologue(F); } SEAM(0);
    if (IN(1)) {
        pg8::Gemm g{Hb, WIN, M, NPROJ, D}; pg8::StaticOrder S; S.init(M, NPROJ, F.G, (int)blockIdx.x);
        pg8::EpiProj E{Qb, Kb, Vb, (bf16*)(F.ws + WS_G), (bf16*)(F.ws + WS_GATE), MA, MB, attn_body::C2};
        pg8::gemm_phase<pg8::EpiProj, pg8::StaticOrder, PG8_ALIGN, PG8_SP2>(F.lds + RING_OFF, g, S, E);
    } SEAM(1);
    if (IN(2)) { gdn_a_phase(F); } SEAM(2);
    if (IN(3)) { gdn_b_phase(F); } SEAM(3);
    if (IN(4)) {
        const attn_body::AttnTensors AT{(const attn_body::bf16*)Qb, (const attn_body::bf16*)Kb, (const attn_body::bf16*)Vb, (attn_body::bf16*)Hb};
        const attn_body::StaticOrder S((int)F.G, (int)blockIdx.x);
        attn_body::attn_phase<attn_body::StaticOrder>((char*)lds + RING_OFF, AT, S);
    } SEAM(4);
    if (IN(5)) { gdn_c_phase(F); ya_phase(F); __syncthreads(); moe_weights_phase(F); } SEAM(5);
    if (IN(6)) {
        { pg8::Gemm g{Qb, (bf16*)(F.ws + WS_WA), M, D, 512}; pg8::StaticOrder S; S.init(M, D, F.G, (int)blockIdx.x);
          pg8::EpiMerge<0> E{MA, Hb}; pg8::gemm_phase<pg8::EpiMerge<0>, pg8::StaticOrder, PG8_ALIGN, PG8_SP2>(F.lds + RING_OFF, g, S, E); }
        __syncthreads();
        { pg8::Gemm g{Kb, (bf16*)(F.ws + WS_WB), M, D, 512}; pg8::StaticOrder S; S.init(M, D, F.G, (int)blockIdx.x);
          pg8::EpiMerge<1> E{MB, Hb}; pg8::gemm_phase<pg8::EpiMerge<1>, pg8::StaticOrder, PG8_ALIGN, PG8_SP2>(F.lds + RING_OFF, g, S, E); }
    } SEAM(6);
    if (IN(7)) {
        pg8::Gemm g{Hb, (bf16*)(F.ws + WS_WOUT), M, D, D}; pg8::StaticOrder S; S.init(M, D, F.G, (int)blockIdx.x);
        pg8::EpiRes E{FIN(0), F.out}; pg8::gemm_phase<pg8::EpiRes, pg8::StaticOrder, PG8_ALIGN, PG8_SP2>(F.lds + RING_OFF, g, S, E);
    } SEAM(7);
    if (IN(8)) { router_phase(F); } SEAM(8);
    if (IN(9)) { gather_phase(F); } SEAM(9);
    if (IN(10)) {
        moe_build_ts(F);
        pg8::Gemm g{(bf16*)(F.ws + WS_XG), (bf16*)(F.ws + WS_GU), XG_ROWS, NE * 512, D};
        pg8::MoeOrder S{(const LAS int*)(F.lds + TS_OFF), 2, F.G, (int)blockIdx.x};
        pg8::EpiAct E{(bf16*)(F.ws + WS_ACT), (const float*)(F.ws + WS_ROWW)};
        pg8::gemm_phase<pg8::EpiAct, pg8::MoeOrder, PG8_ALIGN, PG8_SP2>(F.lds + RING_OFF, g, S, E);
    } SEAM(10);
    if (IN(11)) {
        moe_build_ts(F);
        int Kd = FH; asm volatile("" : "+s"(Kd));
        pg8::Gemm g{(bf16*)(F.ws + WS_ACT), (bf16*)(F.ws + WS_DN), XG_ROWS, NE * 1024, Kd};
        pg8::MoeOrder S{(const LAS int*)(F.lds + TS_OFF), 4, F.G, (int)blockIdx.x};
        pg8::EpiStore E{(bf16*)(F.ws + WS_YG), 1024, 3};
        pg8::gemm_phase<pg8::EpiStore, pg8::MoeOrder, PG8_ALIGN, PG8_SP2>(F.lds + RING_OFF, g, S, E);
    } SEAM(11);
    if (IN(12)) { final_phase(F); }
#undef IN
#undef SEAM
}

#ifndef MK_N_LAUNCHES
#define MK_N_LAUNCHES 1
#endif
extern "C" void kernel_launch(void* const* d_in, const int* in_sizes, int n_in, void* d_out, int out_size, void* d_ws, size_t ws_size, hipStream_t stream) {
    static int grid = 0;
    if (grid == 0) {
        if (n_in != 24 || in_sizes[0] != M * D || out_size != M * D || ws_size < WS_END) { fprintf(stderr, "kernel_launch: unexpected shapes (n_in %d, in0 %d, out %d, ws %zu)\n", n_in, n_in > 0 ? in_sizes[0] : -1, out_size, ws_size); grid = -1; return; }
        int dev = 0, cus = 0, per_cu = 0;
        if (hipGetDevice(&dev) != hipSuccess || hipDeviceGetAttribute(&cus, hipDeviceAttributeMultiprocessorCount, dev) != hipSuccess) { grid = -1; return; }
        if (hipFuncSetAttribute((const void*)mk_fwd, hipFuncAttributeMaxDynamicSharedMemorySize, LDS_BYTES) != hipSuccess) { fprintf(stderr, "kernel_launch: hipFuncSetAttribute failed\n"); grid = -1; return; }
        if (hipOccupancyMaxActiveBlocksPerMultiprocessor(&per_cu, (const void*)mk_fwd, NWAVES * 64, LDS_BYTES) != hipSuccess || per_cu < 1) { fprintf(stderr, "kernel_launch: occupancy query says %d blocks per CU\n", per_cu); per_cu = 1; }
        (void)hipGetLastError();
        grid = cus;
        if (grid != 256) fprintf(stderr, "kernel_launch: %d CUs (built for 256)\n", grid);
    }
    if (grid < 0) return;
    if (hipMemsetAsync((char*)d_ws + WS_CTL, 0, CTL_ZERO_BYTES, stream) != hipSuccess) return;
    Args a{};
    for (int i = 0; i < 24; ++i) a.in[i] = (const float*)d_in[i];
    a.out = (float*)d_out; a.ws = (unsigned char*)d_ws;
#if MK_N_LAUNCHES == 1
    a.ph_lo = 0; a.ph_hi = N_PHASES;
    hipLaunchKernelGGL(mk_fwd, dim3(grid), dim3(NWAVES * 64), LDS_BYTES, stream, a);
#else
    for (int p = 0; p < N_PHASES; ++p) { a.ph_lo = p; a.ph_hi = p + 1; hipLaunchKernelGGL(mk_fwd, dim3(grid), dim3(NWAVES * 64), LDS_BYTES, stream, a); }
#endif
}
```

```cpp
#include <hip/hip_runtime.h>
#include <cstdio>
#include <cstdint>
namespace pg8 {
#define PG8_LAS __attribute__((address_space(3)))
typedef unsigned short bf16_t;
typedef short bf16x8 __attribute__((ext_vector_type(8)));
typedef float f32x4 __attribute__((ext_vector_type(4)));
typedef unsigned u32x4 __attribute__((ext_vector_type(4)));
constexpr int BM = 256, BK = 64, HALF = 128, HTB = HALF * BK * 2  , STAGE_BYTES = 8 * HTB, NXCD = 8, WGM = 8;

__host__ __device__ __forceinline__ int lds_byte(int r, int c) { const int st = (r >> 4) * 2 + (c >> 5), rr = r & 15, cc = c & 31, ob = rr * 64 + cc * 2; return st * 1024 + (ob ^ (((ob >> 9) & 1) << 5)); }
__host__ __device__ __forceinline__ void stage_rc(int b, int& R, int& C) { const int st = b / 1024, sb = b % 1024, swz = sb ^ (((sb >> 9) & 1) << 5); R = (st >> 1) * 16 + swz / 64; C = (st & 1) * 32 + (swz % 64) / 2; }
__host__ __device__ __forceinline__ int perm32(int rho) { const int n = rho >> 4, i = rho & 15; return 8 * (i >> 2) + 4 * n + (i & 3); }

struct Unit { int pm, pn; };
struct Gemm { const bf16_t* A; const bf16_t* Bt; int M, N, K; };

struct StaticOrder {
    int nM, nN, nwg, G, c;
    __host__ __device__ void init(int M, int N, int G_, int c_) { nM = M / BM; nN = N / BM; nwg = nM * nN; G = G_; c = c_; }
    __host__ __device__ bool next(int i, Unit& u) const {
        const long L = (long)i * G + c; if (L >= nwg) return false;
        int wgid = (int)L; { const int q = nwg / NXCD, r = nwg % NXCD, xcd = wgid % NXCD, off = wgid / NXCD; wgid = (xcd < r ? xcd * (q + 1) : r * (q + 1) + (xcd - r) * q) + off; }
        const int nig = WGM * nN, gid = wgid / nig, fm = gid * WGM, gsz = (nM - fm) < WGM ? (nM - fm) : WGM;
        u.pm = fm + ((wgid % nig) % gsz); u.pn = (wgid % nig) / gsz; return true;
    }
    __device__ __forceinline__ void a_ready(const Unit&) const {}
    __device__ __forceinline__ void done(const Unit&) const {}
};

__device__ __forceinline__ unsigned cvt_pk_bf16(float lo, float hi) { unsigned r; asm volatile("v_cvt_pk_bf16_f32 %0, %1, %2" : "=v"(r) : "v"(lo), "v"(hi)); return r; }
typedef unsigned u32x2 __attribute__((ext_vector_type(2)));
__device__ __forceinline__ float bf_lo(unsigned w) { return __uint_as_float(w << 16); }
__device__ __forceinline__ float bf_hi(unsigned w) { return __uint_as_float(w & 0xffff0000u); }
__device__ __forceinline__ float sigmoid_f(float x) { return __builtin_amdgcn_rcpf(1.0f + __expf(-x)); }
__device__ __forceinline__ float silu_f(float x) { return x * sigmoid_f(x); }
__device__ __forceinline__ u32x4 pack8(const f32x4& v0, const f32x4& v1) { u32x4 w; w.x = cvt_pk_bf16(v0[0], v0[1]); w.y = cvt_pk_bf16(v0[2], v0[3]); w.z = cvt_pk_bf16(v1[0], v1[1]); w.w = cvt_pk_bf16(v1[2], v1[3]); return w; }

struct EpiProj {
    static constexpr bool PERM = true, AFTER_DRAIN = false;
    bf16_t *Q, *Kb, *V, *G, *GATE, *MA, *MB; float qscale;
    __device__ __forceinline__ void operator()(const f32x4 (&acc)[2][2][4][2], const Unit& u, int wr, int wc, int fr, int fq) const {
        const int pn = u.pn; bf16_t* base; int ldc, colt; float sc = 1.f; bool sg = false;
        if (pn < 2) { base = Q; ldc = 512; colt = pn * 256; sc = qscale; }
        else if (pn < 4) { base = Kb; ldc = 512; colt = (pn - 2) * 256; }
        else if (pn < 6) { base = V; ldc = 512; colt = (pn - 4) * 256; }
        else if (pn < 12) { base = G; ldc = 1536; colt = (pn - 6) * 256; }
        else if (pn < 14) { base = GATE; ldc = 512; colt = (pn - 12) * 256; }
        else if (pn < 18) { base = MA; ldc = 1024; colt = (pn - 14) * 256; sg = true; }
        else { base = MB; ldc = 1024; colt = (pn - 18) * 256; sg = true; }
        const int row0 = u.pm * BM + wr * 64 + fr, col0 = colt + wc * 32 + 8 * fq;
#pragma unroll
        for (int ai = 0; ai < 2; ++ai)
#pragma unroll
            for (int m = 0; m < 4; ++m) { bf16_t* rowp = base + (size_t)(row0 + ai * HALF + m * 16) * ldc + col0;
#pragma unroll
                for (int bj = 0; bj < 2; ++bj) { f32x4 v0 = acc[ai][bj][m][0], v1 = acc[ai][bj][m][1];
                    if (sg) {
#pragma unroll
                        for (int i = 0; i < 4; ++i) { v0[i] = sigmoid_f(v0[i]); v1[i] = sigmoid_f(v1[i]); }
                    } else { v0 = v0 * sc; v1 = v1 * sc; }
                    *(u32x4*)(rowp + bj * HALF) = pack8(v0, v1); } }
    }
};
template <int PASS> struct EpiMerge {
    static constexpr bool PERM = true, AFTER_DRAIN = false;
    const bf16_t* Gt; bf16_t* O;
    __device__ __forceinline__ void operator()(const f32x4 (&acc)[2][2][4][2], const Unit& u, int wr, int wc, int fr, int fq) const {
        const int row0 = u.pm * BM + wr * 64 + fr, col0 = u.pn * BM + wc * 32 + 8 * fq;
#pragma unroll
        for (int ai = 0; ai < 2; ++ai)
#pragma unroll
            for (int m = 0; m < 4; ++m) { const size_t off = (size_t)(row0 + ai * HALF + m * 16) * 1024 + col0;
#pragma unroll
                for (int bj = 0; bj < 2; ++bj) { const u32x4 g = *(const u32x4*)(Gt + off + bj * HALF);
                    f32x4 v0 = acc[ai][bj][m][0], v1 = acc[ai][bj][m][1];
                    v0[0] *= bf_lo(g.x); v0[1] *= bf_hi(g.x); v0[2] *= bf_lo(g.y); v0[3] *= bf_hi(g.y);
                    v1[0] *= bf_lo(g.z); v1[1] *= bf_hi(g.z); v1[2] *= bf_lo(g.w); v1[3] *= bf_hi(g.w);
                    if (PASS) { const u32x4 p = *(const u32x4*)(O + off + bj * HALF);
                        v0[0] += bf_lo(p.x); v0[1] += bf_hi(p.x); v0[2] += bf_lo(p.y); v0[3] += bf_hi(p.y);
                        v1[0] += bf_lo(p.z); v1[1] += bf_hi(p.z); v1[2] += bf_lo(p.w); v1[3] += bf_hi(p.w); }
                    *(u32x4*)(O + off + bj * HALF) = pack8(v0, v1); } }
    }
};
struct EpiRes {
    static constexpr bool PERM = false, AFTER_DRAIN = false;
    const float* base; float* out;
    __device__ __forceinline__ void operator()(const f32x4 (&acc)[2][2][4][2], const Unit& u, int wr, int wc, int fr, int fq) const {
        const int row0 = u.pm * BM + wr * 64 + fr, col0 = u.pn * BM + wc * 32 + 4 * fq;
#pragma unroll
        for (int ai = 0; ai < 2; ++ai)
#pragma unroll
            for (int m = 0; m < 4; ++m) { const size_t off = (size_t)(row0 + ai * HALF + m * 16) * 1024 + col0;
#pragma unroll
                for (int bj = 0; bj < 2; ++bj)
#pragma unroll
                    for (int n = 0; n < 2; ++n) { const size_t p = off + bj * HALF + n * 16; *(f32x4*)(out + p) = *(const f32x4*)(base + p) + acc[ai][bj][m][n]; } }
    }
};
struct EpiAct {
    static constexpr bool PERM = true, AFTER_DRAIN = false;
    bf16_t* ACT; const float* roww;
    __device__ __forceinline__ void operator()(const f32x4 (&acc)[2][2][4][2], const Unit& u, int wr, int wc, int fr, int fq) const {
        const int row0 = u.pm * BM + wr * 64 + fr, col0 = (u.pn & 1) * 128 + wc * 32 + 8 * fq;
#pragma unroll
        for (int ai = 0; ai < 2; ++ai)
#pragma unroll
            for (int m = 0; m < 4; ++m) { const int row = row0 + ai * HALF + m * 16; const float w = roww[row];
                f32x4 v0, v1;
#pragma unroll
                for (int i = 0; i < 4; ++i) { v0[i] = silu_f(acc[ai][0][m][0][i]) * acc[ai][1][m][0][i] * w; v1[i] = silu_f(acc[ai][0][m][1][i]) * acc[ai][1][m][1][i] * w; }
                *(u32x4*)(ACT + (size_t)row * 256 + col0) = pack8(v0, v1); }
    }
};
struct EpiStore {
    static constexpr bool PERM = true, AFTER_DRAIN = false;
    bf16_t* O; int ldc, pn_mask;
    __device__ __forceinline__ void operator()(const f32x4 (&acc)[2][2][4][2], const Unit& u, int wr, int wc, int fr, int fq) const {
        const int row0 = u.pm * BM + wr * 64 + fr, col0 = (u.pn & pn_mask) * BM + wc * 32 + 8 * fq;
#pragma unroll
        for (int ai = 0; ai < 2; ++ai)
#pragma unroll
            for (int m = 0; m < 4; ++m) { bf16_t* rowp = O + (size_t)(row0 + ai * HALF + m * 16) * ldc + col0;
#pragma unroll
                for (int bj = 0; bj < 2; ++bj) *(u32x4*)(rowp + bj * HALF) = pack8(acc[ai][bj][m][0], acc[ai][bj][m][1]); }
    }
};
struct MoeOrder {
    const PG8_LAS int* ts; int NPN, G, c;
    __device__ __forceinline__ bool next(int i, Unit& u) const {
        const int L = i * G + c, ntl = __builtin_amdgcn_readfirstlane(ts[32]);
        if (L >= ntl * NPN) return false;
        const int rt = L / NPN, pl = L - rt * NPN; int e = 0;
#pragma unroll
        for (int k = 1; k < 32; ++k) e += (ts[k] <= rt) ? 1 : 0;
        u.pm = __builtin_amdgcn_readfirstlane(rt); u.pn = __builtin_amdgcn_readfirstlane(e * NPN + pl); return true;
    }
    __device__ __forceinline__ void a_ready(const Unit&) const {}
    __device__ __forceinline__ void done(const Unit&) const {}
};

template <class Epi, class Sched, bool ALIGN_EPI = false, bool SP2 = false>
__device__ __forceinline__ void gemm_phase(PG8_LAS unsigned char* lds, const Gemm g, const Sched& S, const Epi& E) {
    const int tid = threadIdx.x, wid = __builtin_amdgcn_readfirstlane(tid >> 6), lane = tid & 63, wr = wid >> 2, wc = wid & 3, fr = lane & 15, fq = lane >> 4;
    const int K = g.K, nt = K / BK;
    unsigned voffA[2], voffB[2];
#pragma unroll
    for (int i = 0; i < 2; ++i) { int R, C; stage_rc(tid * 16 + i * 8192, R, C); const int Rb = Epi::PERM ? ((R & ~31) + perm32(R & 31)) : R;
        voffA[i] = (unsigned)(R * K + C) * 2u; voffB[i] = (unsigned)(Rb * K + C) * 2u; }
    const size_t kstep = (size_t)(BK * 2);
    const size_t hstep = (size_t)HALF * K * 2;
    const size_t tstep = 2 * hstep;
    const unsigned ldsw = (unsigned)wid * 1024u;
    const int aoff = lds_byte(wr * 64 + fr, fq * 8), boff = lds_byte(wc * 32 + fr, fq * 8);
#define PG8_SA(b, h) (((b) * 2 + (h)) * HTB)
#define PG8_SB(b, h) ((4 + (b) * 2 + (h)) * HTB)
#define PG8_STAGE(bufoff, gbase, voff) do { _Pragma("unroll") for (int _i = 0; _i < 2; ++_i) \
        __builtin_amdgcn_global_load_lds((const unsigned*)((const char*)(gbase) + (voff)[_i]), (PG8_LAS unsigned*)(lds + (bufoff) + ldsw + _i * 8192), 16, 0, 0); } while (0)
#define PG8_LDA(dst, b, h) do { _Pragma("unroll") for (int m = 0; m < 4; ++m) _Pragma("unroll") for (int k = 0; k < 2; ++k) dst[m][k] = *(const PG8_LAS bf16x8*)(lds + PG8_SA(b, h) + aoff + m * 2048 + k * 1024); } while (0)
#define PG8_LDB(dst, b, h) do { _Pragma("unroll") for (int n = 0; n < 2; ++n) _Pragma("unroll") for (int k = 0; k < 2; ++k) dst[n][k] = *(const PG8_LAS bf16x8*)(lds + PG8_SB(b, h) + boff + n * 2048 + k * 1024); } while (0)
#define PG8_MMA(ai, bj, At, Bt) do { __builtin_amdgcn_s_setprio(1); _Pragma("unroll") for (int m = 0; m < 4; ++m) _Pragma("unroll") for (int n = 0; n < 2; ++n) _Pragma("unroll") for (int k = 0; k < 2; ++k) \
        acc[ai][bj][m][n] = __builtin_amdgcn_mfma_f32_16x16x32_bf16(Bt[n][k], At[m][k], acc[ai][bj][m][n], 0, 0, 0); __builtin_amdgcn_s_setprio(0); } while (0)
#define PG8_WAIT_V(n) asm volatile("s_waitcnt vmcnt(" #n ")" ::: "memory")
#define PG8_WAIT_L(n) asm volatile("s_waitcnt lgkmcnt(" #n ")" ::: "memory")
#define PG8_BAR __builtin_amdgcn_s_barrier()
#define PG8_SCHED __builtin_amdgcn_sched_barrier(0)
    Unit cur, nxt; int ui = 0;
    if (!S.next(0, cur)) return;
    f32x4 acc[2][2][4][2];
#pragma unroll
    for (int a = 0; a < 2; ++a)
#pragma unroll
        for (int b = 0; b < 2; ++b)
#pragma unroll
            for (int m = 0; m < 4; ++m)
#pragma unroll
                for (int n = 0; n < 2; ++n) acc[a][b][m][n] = (f32x4){0.f, 0.f, 0.f, 0.f};
    bf16x8 At[4][2], B0[2][2], B1[2][2];
    const char* cA = (const char*)g.A + (size_t)cur.pm * tstep; const char* cB = (const char*)g.Bt + (size_t)cur.pn * tstep;
    S.a_ready(cur);
    if constexpr (SP2) {
        PG8_STAGE(PG8_SB(0, 0), cB, voffB); PG8_STAGE(PG8_SB(0, 1), cB + hstep, voffB); PG8_STAGE(PG8_SA(0, 0), cA, voffA); PG8_STAGE(PG8_SA(0, 1), cA + hstep, voffA);
        if (wr == 1) PG8_BAR;
        PG8_WAIT_V(2); PG8_BAR;
        PG8_STAGE(PG8_SB(1, 0), cB + kstep, voffB); PG8_STAGE(PG8_SA(1, 0), cA + kstep, voffA); PG8_STAGE(PG8_SB(1, 1), cB + hstep + kstep, voffB);
        PG8_WAIT_V(6); PG8_BAR;
    } else {
        PG8_STAGE(PG8_SB(0, 0), cB, voffB); PG8_STAGE(PG8_SA(0, 0), cA, voffA); PG8_STAGE(PG8_SB(0, 1), cB + hstep, voffB); PG8_STAGE(PG8_SA(0, 1), cA + hstep, voffA);
        if (wr == 1) PG8_BAR;
        PG8_WAIT_V(4); PG8_BAR;
        PG8_STAGE(PG8_SB(1, 0), cB + kstep, voffB); PG8_STAGE(PG8_SA(1, 0), cA + kstep, voffA); PG8_STAGE(PG8_SB(1, 1), cB + hstep + kstep, voffB);
        PG8_WAIT_V(6); PG8_BAR;
    }
    for (;;) {
        const bool has_next = S.next(ui + 1, nxt);
        const char* nA = has_next ? (const char*)g.A + (size_t)nxt.pm * tstep : cA; const char* nB = has_next ? (const char*)g.Bt + (size_t)nxt.pn * tstep : cB;
        for (int t = 0; t < nt; t += 2) {
            const bool last = (t == nt - 2);
            const char* a1 = cA + (size_t)(t + 1) * kstep;
            const char* a2 = last ? nA : cA + (size_t)(t + 2) * kstep; const char* b2 = last ? nB : cB + (size_t)(t + 2) * kstep;
            const char* a3 = a2 + kstep; const char* b3 = b2 + kstep;
            if (last && has_next) S.a_ready(nxt);
            if constexpr (SP2) {
            PG8_LDB(B0, 0, 0); PG8_LDB(B1, 0, 1); PG8_SCHED; PG8_LDA(At, 0, 0); PG8_STAGE(PG8_SA(1, 1), a1 + hstep, voffA);
            PG8_WAIT_V(8); PG8_WAIT_L(0); PG8_BAR; PG8_MMA(0, 0, At, B0); PG8_MMA(0, 1, At, B1); PG8_BAR; PG8_SCHED;
            PG8_LDA(At, 0, 1); PG8_STAGE(PG8_SB(0, 0), b2, voffB); PG8_STAGE(PG8_SB(0, 1), b2 + hstep, voffB); PG8_STAGE(PG8_SA(0, 0), a2, voffA);
            PG8_WAIT_V(8); PG8_WAIT_L(0); PG8_BAR; PG8_MMA(1, 0, At, B0); PG8_MMA(1, 1, At, B1); PG8_BAR; PG8_SCHED;
            PG8_LDB(B0, 1, 0); PG8_LDB(B1, 1, 1); PG8_SCHED; PG8_LDA(At, 1, 0); PG8_STAGE(PG8_SA(0, 1), a2 + hstep, voffA);
            PG8_WAIT_V(8); PG8_WAIT_L(0); PG8_BAR; PG8_MMA(0, 0, At, B0); PG8_MMA(0, 1, At, B1); PG8_BAR; PG8_SCHED;
            PG8_LDA(At, 1, 1); PG8_STAGE(PG8_SB(1, 0), b3, voffB); PG8_STAGE(PG8_SB(1, 1), b3 + hstep, voffB); PG8_STAGE(PG8_SA(1, 0), a3, voffA);
            PG8_WAIT_V(8); PG8_WAIT_L(0); PG8_BAR; PG8_MMA(1, 0, At, B0); PG8_MMA(1, 1, At, B1); PG8_BAR; PG8_SCHED;
            } else {
            PG8_LDB(B0, 0, 0); PG8_SCHED; PG8_LDA(At, 0, 0); PG8_STAGE(PG8_SA(1, 1), a1 + hstep, voffA);
            PG8_WAIT_L(8); PG8_BAR; PG8_WAIT_L(0); PG8_MMA(0, 0, At, B0); PG8_BAR; PG8_SCHED;
            PG8_LDB(B1, 0, 1); PG8_STAGE(PG8_SB(0, 0), b2, voffB);
            PG8_BAR; PG8_WAIT_L(0); PG8_MMA(0, 1, At, B1); PG8_BAR;
            PG8_LDA(At, 0, 1); PG8_STAGE(PG8_SA(0, 0), a2, voffA);
            PG8_BAR; PG8_WAIT_L(0); PG8_MMA(1, 0, At, B0); PG8_BAR; PG8_SCHED;
            PG8_STAGE(PG8_SB(0, 1), b2 + hstep, voffB);
            PG8_WAIT_V(6); PG8_BAR; PG8_MMA(1, 1, At, B1); PG8_BAR;
            PG8_LDB(B0, 1, 0); PG8_SCHED; PG8_LDA(At, 1, 0); PG8_STAGE(PG8_SA(0, 1), a2 + hstep, voffA);
            PG8_WAIT_L(8); PG8_BAR; PG8_WAIT_L(0); PG8_MMA(0, 0, At, B0); PG8_BAR; PG8_SCHED;
            PG8_LDB(B1, 1, 1); PG8_STAGE(PG8_SB(1, 0), b3, voffB);
            PG8_BAR; PG8_WAIT_L(0); PG8_MMA(0, 1, At, B1); PG8_BAR;
            PG8_LDA(At, 1, 1); PG8_STAGE(PG8_SA(1, 0), a3, voffA);
            PG8_BAR; PG8_WAIT_L(0); PG8_MMA(1, 0, At, B0); PG8_BAR; PG8_SCHED;
            PG8_STAGE(PG8_SB(1, 1), b3 + hstep, voffB);
            PG8_WAIT_V(6); PG8_BAR; PG8_MMA(1, 1, At, B1); PG8_BAR;
            }
        }
        if constexpr (ALIGN_EPI) { if (wr == 0) PG8_BAR; }
        if constexpr (!Epi::AFTER_DRAIN) { E(acc, cur, wr, wc, fr, fq); S.done(cur); }
        if (!has_next) break;
#pragma unroll
        for (int a = 0; a < 2; ++a)
#pragma unroll
            for (int b = 0; b < 2; ++b)
#pragma unroll
                for (int m = 0; m < 4; ++m)
#pragma unroll
                    for (int n = 0; n < 2; ++n) acc[a][b][m][n] = (f32x4){0.f, 0.f, 0.f, 0.f};
        cur = nxt; cA = nA; cB = nB; ++ui;
        if constexpr (ALIGN_EPI) { if (wr == 1) PG8_BAR; }
    }
    PG8_WAIT_V(0);
    if constexpr (!ALIGN_EPI) { if (wr == 0) PG8_BAR; }
    PG8_BAR;
    if constexpr (Epi::AFTER_DRAIN) { E.fused(acc, cur, wr, wc, fr, fq, lds, wid, lane); S.done(cur); }
#undef PG8_SA
#undef PG8_SB
#undef PG8_STAGE
#undef PG8_LDA
#undef PG8_LDB
#undef PG8_MMA
#undef PG8_WAIT_V
#undef PG8_WAIT_L
#undef PG8_BAR
#undef PG8_SCHED
}
}

#ifndef PG8_SP2
#define PG8_SP2 true
#endif
#ifndef PG8_ALIGN
#define PG8_ALIGN true
#endif
#include <hip/hip_bf16.h>
#include <cmath>
namespace attn_body {
using bf16=__hip_bfloat16;
using bf16x8=__attribute__((ext_vector_type(8)))short;
using s16x4=__attribute__((ext_vector_type(4)))short;
using f32x16=__attribute__((ext_vector_type(16)))float;
using u32x4=__attribute__((ext_vector_type(4)))unsigned;
constexpr int BATCH=2,NHEAD=16,SEQ=8192,D=64,DM=NHEAD*D,QP=512;
constexpr int NW=8,QBLK=32,QB=QBLK*NW,KVBLK=64,NQB=SEQ/QB;
constexpr int ATTN_PITCH=DM, ATTN_UNIT_ROWS=QB;
__device__ __forceinline__ int crow(int r,int hi){return (r&3)+8*(r>>2)+4*hi;}
#define SBAR() __builtin_amdgcn_sched_barrier(0)
__device__ __forceinline__ void cmask(f32x16&p0,f32x16&p1,int jb,int qrel,int hi){
  const float NEG=-INFINITY; (void)hi;
  if(jb>(qrel>>6)){
  #pragma unroll
  for(int r=0;r<16;++r){p0[r]=NEG;p1[r]=NEG;} }
}

constexpr int NSLOT=3, SLOTB=8192;
constexpr int LDS_K=0, LDS_V=NSLOT*SLOTB, LDS_WS=2*NSLOT*SLOTB, LDS_OST=LDS_WS+NW*64*4, LDS_BYTES=LDS_OST+NW*4096;
constexpr float C2=0.125f*1.4426950408889634f;
__device__ __forceinline__ void glds16(const void*gsrc,unsigned lds_dst){unsigned keep;
  asm volatile("s_mov_b32 %0, m0\n\ts_mov_b32 m0, %2\n\ts_nop 0\n\tglobal_load_lds_dwordx4 %1, off\n\ts_mov_b32 m0, %0":"=&s"(keep):"v"(gsrc),"s"(lds_dst):"memory");}
__device__ __forceinline__ float max3f(float a,float b,float c){float r;asm("v_max3_f32 %0, %1, %2, %3":"=v"(r):"v"(a),"v"(b),"v"(c));return r;}
__device__ __forceinline__ float max2f(float a,float b){float r;asm("v_max_f32_e32 %0, %1, %2":"=v"(r):"v"(a),"v"(b));return r;}
__device__ __forceinline__ float fadd_s(float a,float b){float r;asm("v_add_f32_e32 %0, %1, %2":"=v"(r):"v"(a),"v"(b));return r;}
__device__ __forceinline__ float fsub_s(float a,float b){float r;asm("v_sub_f32_e32 %0, %1, %2":"=v"(r):"v"(a),"v"(b));return r;}
typedef float f32x2_t __attribute__((ext_vector_type(2))); typedef __bf16 bf16x2_t __attribute__((ext_vector_type(2)));
__device__ __forceinline__ unsigned cvtpk_s(float lo,float hi){f32x2_t v={lo,hi};bf16x2_t b=__builtin_convertvector(v,bf16x2_t);return __builtin_bit_cast(unsigned,b);}
#define WAIT_BAR(N) asm volatile("s_waitcnt vmcnt(" #N ") lgkmcnt(0)\n\ts_barrier":::"memory")

__device__ __forceinline__ void qkt(f32x16&p0,f32x16&p1,const char*Kslot,const bf16x8*qr,const f32x16&negm,int r32,int hi){
  const char*kb=Kslot+hi*1024+r32*16;
  #pragma unroll
  for(int d0=0;d0<4;++d0){
    const bf16x8 b0=*reinterpret_cast<const bf16x8*>(kb+d0*2048);
    const bf16x8 b1=*reinterpret_cast<const bf16x8*>(kb+d0*2048+512);
    if(d0==0){p0=__builtin_amdgcn_mfma_f32_32x32x16_bf16(b0,qr[0],negm,0,0,0);p1=__builtin_amdgcn_mfma_f32_32x32x16_bf16(b1,qr[0],negm,0,0,0);}
    else{p0=__builtin_amdgcn_mfma_f32_32x32x16_bf16(b0,qr[d0],p0,0,0,0);p1=__builtin_amdgcn_mfma_f32_32x32x16_bf16(b1,qr[d0],p1,0,0,0);}}
}
typedef __attribute__((address_space(3))) const char* lds_cptr;
typedef short v4i16_t __attribute__((ext_vector_type(4)));
__device__ __forceinline__ void kload8(bf16x8*kf,lds_cptr kp){
  kf[0]=*(const __attribute__((address_space(3))) bf16x8*)(kp);      kf[1]=*(const __attribute__((address_space(3))) bf16x8*)(kp+512);
  kf[2]=*(const __attribute__((address_space(3))) bf16x8*)(kp+2048); kf[3]=*(const __attribute__((address_space(3))) bf16x8*)(kp+2560);
  kf[4]=*(const __attribute__((address_space(3))) bf16x8*)(kp+4096); kf[5]=*(const __attribute__((address_space(3))) bf16x8*)(kp+4608);
  kf[6]=*(const __attribute__((address_space(3))) bf16x8*)(kp+6144); kf[7]=*(const __attribute__((address_space(3))) bf16x8*)(kp+6656);
}
__device__ __forceinline__ void kload2(bf16x8*kf,lds_cptr kp,int j){ kf[2*j]=*(const __attribute__((address_space(3))) bf16x8*)(kp+j*2048); kf[2*j+1]=*(const __attribute__((address_space(3))) bf16x8*)(kp+j*2048+512); }
__device__ __forceinline__ s16x4 vtr(lds_cptr p){ return __builtin_bit_cast(s16x4,__builtin_amdgcn_ds_read_tr16_b64_v4i16((__attribute__((address_space(3))) v4i16_t*)p)); }
__device__ __forceinline__ float rowmax(const f32x16&p0,const f32x16&p1){
  float a=max3f(p0[0],p0[1],p1[0]),b=max3f(p0[2],p0[3],p1[1]);a=max3f(a,p1[2],p1[3]);
  #pragma unroll
  for(int r=4;r<16;r+=4){a=max3f(a,p0[r],p0[r+1]);b=max3f(b,p0[r+2],p0[r+3]);a=max3f(a,p1[r],p1[r+1]);b=max3f(b,p1[r+2],p1[r+3]);}
  const float m=max2f(a,b);
  auto rr=__builtin_amdgcn_permlane32_swap(__float_as_uint(m),__float_as_uint(m),false,false);
  return max2f(__uint_as_float(rr[0]),__uint_as_float(rr[1]));
}
__device__ __forceinline__ void pv(f32x16*o,int vb,bf16x8 pa0,bf16x8 pa1,bf16x8 pa2,bf16x8 pa3){
  #pragma unroll
  for(int d0=0;d0<2;++d0){s16x4 lo[4],hi[4];
    #pragma unroll
    for(int ks=0;ks<4;++ks){
      asm volatile("ds_read_b64_tr_b16 %0,%1 offset:%c2":"=&v"(lo[ks]):"v"(vb),"i"(d0*4096+ks*1024):"memory");
      asm volatile("ds_read_b64_tr_b16 %0,%1 offset:%c2":"=&v"(hi[ks]):"v"(vb),"i"(d0*4096+ks*1024+512):"memory");}
    asm volatile("s_waitcnt lgkmcnt(0)":::"memory");SBAR();
    #define PK(k) (bf16x8){lo[k][0],lo[k][1],lo[k][2],lo[k][3],hi[k][0],hi[k][1],hi[k][2],hi[k][3]}
    o[d0]=__builtin_amdgcn_mfma_f32_32x32x16_bf16(pa0,PK(0),o[d0],0,0,0);
    o[d0]=__builtin_amdgcn_mfma_f32_32x32x16_bf16(pa1,PK(1),o[d0],0,0,0);
    o[d0]=__builtin_amdgcn_mfma_f32_32x32x16_bf16(pa2,PK(2),o[d0],0,0,0);
    o[d0]=__builtin_amdgcn_mfma_f32_32x32x16_bf16(pa3,PK(3),o[d0],0,0,0);
    #undef PK
  }
}

#ifndef ATTN_STORE16
#define ATTN_STORE16(p,v) (*(u32x4*)(p)=(v))
#endif
template<int THRL> __device__ __forceinline__ void attn_unit(int b,int qcol,int vcol,int ocol,int qb,const bf16*Q,const bf16*__restrict__ K,const bf16*__restrict__ V,bf16*O,char*shm){
  const int tid=threadIdx.x,lane=tid&63,r32=lane&31,hi=lane>>5; const int wid=__builtin_amdgcn_readfirstlane(tid>>6);
  const long rowbase=(long)b*SEQ; const int q0=qb*QB;
  const bf16*Qw=Q+(rowbase+q0+wid*QBLK)*QP+qcol;
  const bf16*Kh=K+rowbase*QP+qcol,*Vh=V+rowbase*QP+vcol;
  const unsigned lds0=(unsigned)(uintptr_t)shm;
  float*wsf=(float*)(shm+LDS_WS)+wid*64;
  const bf16*ksrc=Kh+(long)lane*QP+wid*8;
  const bf16*vsrc=Vh+(long)(16*(wid&3)+(lane>>2))*QP+(wid>>2)*32+(lane&3)*8;
  const unsigned kdst=lds0+LDS_K+wid*1024, vdst=lds0+LDS_V+wid*1024;
  #define DMA_K(t,slot) glds16(ksrc+(long)(t)*KVBLK*QP,(unsigned)__builtin_amdgcn_readfirstlane(kdst+(slot)))
  #define DMA_V(t,slot) glds16(vsrc+(long)(t)*KVBLK*QP,(unsigned)__builtin_amdgcn_readfirstlane(vdst+(slot)))
  const int vb0=(int)(lds0+LDS_V)+((lane>>4)&1)*32+(lane&3)*8+(4*hi+((lane&15)>>2))*64;
  const char*Kbase=shm+LDS_K; bf16x8 kf[8];
  const lds_cptr shm3=(lds_cptr)shm; const lds_cptr kp0=shm3+LDS_K+hi*1024+r32*16; const lds_cptr vp0=shm3+LDS_V+((lane>>4)&1)*32+(lane&3)*8+(4*hi+((lane&15)>>2))*64;
  const int NT=(q0+QB)/KVBLK;
  DMA_K(0,0);DMA_V(0,0);DMA_K(1,SLOTB);
  bf16x8 qr[4];
  #pragma unroll
  for(int d0=0;d0<4;++d0)qr[d0]=*reinterpret_cast<const bf16x8*>(&Qw[(long)r32*QP+d0*16+hi*8]);
  float mhat=0.f,l_reg=0.f;f32x16 o[2];o[0]=f32x16{};o[1]=f32x16{};f32x16 negm=f32x16{};asm volatile("":"+v"(negm));
  const int qrel=wid*QBLK+r32;
  #define CMASK(P0,P1,t) do{int jb_=(t)-(NT-4); if(jb_>=0)cmask(P0,P1,jb_,qrel,hi);}while(0)
  bool resc=false;
  #define START(P0,P1) do{ const float rm=rowmax(P0,P1); resc=false; \
    { const float dl=rm; mhat=fadd_s(mhat,dl); \
      _Pragma("unroll") for(int r=0;r<16;++r){P0[r]=fsub_s(P0[r],dl);P1[r]=fsub_s(P1[r],dl);} \
      _Pragma("unroll") for(int r=0;r<16;++r)negm[r]=-mhat; asm volatile("":"+v"(negm)); } \
    _Pragma("unroll") for(int r=0;r<16;++r)P0[r]=__builtin_amdgcn_exp2f(P0[r]); }while(0)
  #define RESC() do{ if(resc){ asm volatile("s_waitcnt lgkmcnt(0)":::"memory"); \
      _Pragma("unroll") for(int d_=0;d_<2;++d_) _Pragma("unroll") for(int r=0;r<16;++r)o[d_][r]*=wsf[crow(r,hi)]; } }while(0)
  f32x16 pA0,pA1,pB0,pB1;
  int sl_prev=0,sl_cur=0,sl_next=SLOTB;
  #define ROT() do{sl_prev=sl_cur;sl_cur=sl_next;sl_next=(sl_next==(NSLOT-1)*SLOTB)?0:sl_next+SLOTB;}while(0)
  DMA_K(2,2*SLOTB);
  WAIT_BAR(3);
  qkt(pA0,pA1,Kbase,qr,negm,r32,hi);asm volatile("s_nop 15\n\ts_nop 7":"+v"(pA0),"+v"(pA1));CMASK(pA0,pA1,0);
  START(pA0,pA1);
  _Pragma("unroll") for(int r=0;r<16;++r)pA1[r]=__builtin_amdgcn_exp2f(pA1[r]);
  WAIT_BAR(0);
  DMA_K(3,0);DMA_V(1,SLOTB);
  ROT();
  kload8(kf,kp0+sl_cur);
  WAIT_BAR(2);
  s16x4 vlo[8],vhi[8]; u32x4 pw0,pw1,pw2,pw3;
  #define PKW(P,B) cvtpk_s(P[B],P[B+1])
  #define PAF(k) __builtin_bit_cast(bf16x8,pw##k)
  #define VFR(i) (bf16x8){vlo[i][0],vlo[i][1],vlo[i][2],vlo[i][3],vhi[i][0],vhi[i][1],vhi[i][2],vhi[i][3]}
  #define PIN(x) asm volatile("":"+v"(x))
  #define MX3(a,b,c) __builtin_fmaxf(__builtin_fmaxf((a),(b)),(c))
  #define GAPA(MF,A0,A1,A2,A3,W0,W1,PW) do{ MF; sacc+=A0; sacc+=A1; sacc+=A2; sacc+=A3; PIN(sacc); W0; W1; PIN(PW); SBAR(); }while(0)
  #define EX(v) __builtin_amdgcn_exp2f(v)
  #define GAPB(MF,X,B) do{ MF; X[B]=EX(X[B]); X[B+1]=EX(X[B+1]); X[B+2]=EX(X[B+2]); X[B+3]=EX(X[B+3]); PIN(X); SBAR(); }while(0)
  #define VRD(i) do{ vlo[i]=vtr(vp_+(((i)>>2)*4096+((i)&3)*1024)); vhi[i]=vtr(vp_+(((i)>>2)*4096+((i)&3)*1024+512)); }while(0)
  #define KRD(G,j) do{ if(G){ kload2(kf,kp0+sl_next,j); SBAR(); } }while(0)
  #define STEP(C0,C1,P0,P1,t,GK,GV,GL) do{ SBAR(); \
    const lds_cptr vp_=vp0+sl_prev; \
    VRD(0); SBAR(); float sacc=(P0[0]+P0[1]); \
    GAPA(C0=__builtin_amdgcn_mfma_f32_32x32x16_bf16(kf[0],qr[0],negm,0,0,0), P0[2],P0[3],P0[4],P0[5],     pw0[0]=PKW(P0,0), pw0[1]=PKW(P0,2), pw0); \
    VRD(4); SBAR(); GAPA(C1=__builtin_amdgcn_mfma_f32_32x32x16_bf16(kf[1],qr[0],negm,0,0,0), P0[6],P0[7],P0[8],P0[9],     pw0[2]=PKW(P0,4), pw0[3]=PKW(P0,6), pw0); \
    VRD(1); SBAR(); GAPA(C0=__builtin_amdgcn_mfma_f32_32x32x16_bf16(kf[2],qr[1],C0,0,0,0),   P0[10],P0[11],P0[12],P0[13], pw1[0]=PKW(P0,8), pw1[1]=PKW(P0,10), pw1); \
    VRD(5); SBAR(); GAPA(C1=__builtin_amdgcn_mfma_f32_32x32x16_bf16(kf[3],qr[1],C1,0,0,0),   P0[14],P0[15],P1[0],P1[1],   pw1[2]=PKW(P0,12),pw1[3]=PKW(P0,14), pw1); \
    VRD(2); SBAR(); GAPA(C0=__builtin_amdgcn_mfma_f32_32x32x16_bf16(kf[4],qr[2],C0,0,0,0),   P1[2],P1[3],P1[4],P1[5],     pw2[0]=PKW(P1,0), pw2[1]=PKW(P1,2), pw2); \
    VRD(6); SBAR(); GAPA(C1=__builtin_amdgcn_mfma_f32_32x32x16_bf16(kf[5],qr[2],C1,0,0,0),   P1[6],P1[7],P1[8],P1[9],     pw2[2]=PKW(P1,4), pw2[3]=PKW(P1,6), pw2); \
    VRD(3); SBAR(); GAPA(C0=__builtin_amdgcn_mfma_f32_32x32x16_bf16(kf[6],qr[3],C0,0,0,0),   P1[10],P1[11],P1[12],P1[13], pw3[0]=PKW(P1,8), pw3[1]=PKW(P1,10), pw3); \
    VRD(7); SBAR(); GAPA(C1=__builtin_amdgcn_mfma_f32_32x32x16_bf16(kf[7],qr[3],C1,0,0,0),   P1[14],P1[15],0.f,0.f,       pw3[2]=PKW(P1,12),pw3[3]=PKW(P1,14), pw3); \
    l_reg+=sacc; \
    if(GK){DMA_K((t)+3,sl_cur);} if(GV){DMA_V((t)+1,sl_next);} \
    CMASK(C0,C1,t); \
    { float a=MX3(C0[0],C0[1],C1[0]),b=MX3(C0[2],C0[3],C1[1]); a=MX3(a,C1[2],C1[3]); \
      _Pragma("unroll") for(int r=4;r<16;r+=4){a=MX3(a,C0[r],C0[r+1]);b=MX3(b,C0[r+2],C0[r+3]);a=MX3(a,C1[r],C1[r+1]);b=MX3(b,C1[r+2],C1[r+3]);} \
      float rm=__builtin_fmaxf(a,b); { auto rr=__builtin_amdgcn_permlane32_swap(__float_as_uint(rm),__float_as_uint(rm),false,false); rm=__builtin_fmaxf(__uint_as_float(rr[0]),__uint_as_float(rr[1])); } \
      resc=false; \
      if(__builtin_expect(__any(rm>(float)THRL),0)){ const float dl=__builtin_fmaxf(rm,0.f); mhat+=dl; \
        _Pragma("unroll") for(int r=0;r<16;++r){C0[r]-=dl;C1[r]-=dl;} \
        _Pragma("unroll") for(int r=0;r<16;++r)negm[r]=-mhat; asm volatile("":"+v"(negm)); \
        const float f=__builtin_amdgcn_exp2f(-dl); l_reg*=f; if(hi==0)wsf[r32]=f; resc=true; } } \
    SBAR(); \
    GAPB(o[0]=__builtin_amdgcn_mfma_f32_32x32x16_bf16(PAF(0),VFR(0),o[0],0,0,0), C0,0); \
    GAPB(o[1]=__builtin_amdgcn_mfma_f32_32x32x16_bf16(PAF(0),VFR(4),o[1],0,0,0), C0,4); \
    KRD(GL,0); GAPB(o[0]=__builtin_amdgcn_mfma_f32_32x32x16_bf16(PAF(1),VFR(1),o[0],0,0,0), C0,8); \
    KRD(GL,1); GAPB(o[1]=__builtin_amdgcn_mfma_f32_32x32x16_bf16(PAF(1),VFR(5),o[1],0,0,0), C0,12); \
    KRD(GL,2); GAPB(o[0]=__builtin_amdgcn_mfma_f32_32x32x16_bf16(PAF(2),VFR(2),o[0],0,0,0), C1,0); \
    KRD(GL,3); GAPB(o[1]=__builtin_amdgcn_mfma_f32_32x32x16_bf16(PAF(2),VFR(6),o[1],0,0,0), C1,4); \
    GAPB(o[0]=__builtin_amdgcn_mfma_f32_32x32x16_bf16(PAF(3),VFR(3),o[0],0,0,0), C1,8); \
    GAPB(o[1]=__builtin_amdgcn_mfma_f32_32x32x16_bf16(PAF(3),VFR(7),o[1],0,0,0), C1,12); \
    }while(0)
  int t=1;
  #undef CMASK
  #define CMASK(P0,P1,t) do{}while(0)
  for(;t+5<NT;t+=2){
    STEP(pB0,pB1,pA0,pA1,t,true,true,true);     WAIT_BAR(2); RESC(); ROT();
    STEP(pA0,pA1,pB0,pB1,t+1,true,true,true);   WAIT_BAR(2); RESC(); ROT();
  }
  #undef CMASK
  #define CMASK(P0,P1,t) do{int jb_=(t)-(NT-4); if(jb_>=0)cmask(P0,P1,jb_,qrel,hi);}while(0)
  #define ENDW(tt) do{ if((tt)+3<NT){WAIT_BAR(2);} else if((tt)+2<NT){WAIT_BAR(1);} else {WAIT_BAR(0);} }while(0)
  for(;t+1<NT;t+=2){
    STEP(pB0,pB1,pA0,pA1,t,(t+3<NT),(t+1<NT),(t+1<NT));       ENDW(t);   RESC(); ROT();
    STEP(pA0,pA1,pB0,pB1,t+1,(t+4<NT),(t+2<NT),(t+2<NT));     ENDW(t+1); RESC(); ROT();
  }
  STEP(pB0,pB1,pA0,pA1,NT-1,false,false,false); RESC();
  { float sacc=pB0[0]+pB0[1]; _Pragma("unroll") for(int r=2;r<16;++r)sacc+=pB0[r]; _Pragma("unroll") for(int r=0;r<16;++r)sacc+=pB1[r]; l_reg+=sacc;
    pw0=(u32x4){PKW(pB0,0),PKW(pB0,2),PKW(pB0,4),PKW(pB0,6)};pw1=(u32x4){PKW(pB0,8),PKW(pB0,10),PKW(pB0,12),PKW(pB0,14)};pw2=(u32x4){PKW(pB1,0),PKW(pB1,2),PKW(pB1,4),PKW(pB1,6)};pw3=(u32x4){PKW(pB1,8),PKW(pB1,10),PKW(pB1,12),PKW(pB1,14)};
    SBAR(); pv(o,vb0+sl_cur,PAF(0),PAF(1),PAF(2),PAF(3)); }
  #undef PKW
  #undef PAF
  #undef VFR
  #undef PIN
  #undef MX3
  #undef GAPA
  #undef GAPB
  #undef EX
  #undef VRD
  #undef KRD
  #undef STEP
  #undef ENDW
  {auto rr=__builtin_amdgcn_permlane32_swap(__float_as_uint(l_reg),__float_as_uint(l_reg),false,false);l_reg=__uint_as_float(rr[0])+__uint_as_float(rr[1]);}
  if(hi==0)wsf[32+r32]=l_reg;asm volatile("s_waitcnt lgkmcnt(0)":::"memory");
  float rli[16];
  #pragma unroll
  for(int r=0;r<16;++r)rli[r]=__builtin_amdgcn_rcpf(wsf[32+crow(r,hi)]);
  bf16*Ow=O+(rowbase+q0+wid*QBLK)*DM+ocol;
  { bf16*stg=(bf16*)(shm+LDS_OST)+wid*2048;
    #pragma unroll
    for(int r=0;r<16;++r){const int orow=crow(r,hi);
      #pragma unroll
      for(int d0=0;d0<2;++d0)stg[orow*64+d0*32+r32]=__float2bfloat16(o[d0][r]*rli[r]);}
    asm volatile("s_waitcnt lgkmcnt(0)":::"memory");
    #pragma unroll
    for(int i=0;i<4;++i){const int row=i*8+(lane>>3),ch=lane&7; const u32x4 v=*(const u32x4*)(stg+row*64+ch*8); ATTN_STORE16(Ow+(long)row*DM+ch*8,v);} }
  asm volatile("s_waitcnt lgkmcnt(0)\n\ts_barrier":::"memory");
  #undef DMA_K
  #undef DMA_V
  #undef CMASK
  #undef START
  #undef RESC
  #undef ROT
}
constexpr int ATTN_LDS_BYTES=LDS_BYTES;
struct AttnTensors { const bf16* Q; const bf16* K; const bf16* V; bf16* O; };
struct AttnUnit { int bh; int qb; };
struct StaticOrder {
  int vcu;
  __device__ __forceinline__ explicit StaticOrder(int grid,int block):vcu((block%8)*(grid/8)+block/8){}
  __device__ __forceinline__ bool next(int i,AttnUnit&u)const{ if(i>=4)return false; const int s=vcu&7; u.bh=vcu>>3; u.qb=(i==0)?s:(i==1)?15-s:(i==2)?16+s:31-s; return true; }
  __device__ __forceinline__ void a_ready(const AttnUnit&)const{}
  __device__ __forceinline__ void done(const AttnUnit&)const{}
};
struct DynOrder {
  unsigned* ctr; int grp; volatile __attribute__((address_space(3))) int* slot;
  __device__ __forceinline__ bool next(int,AttnUnit&u)const{
    if(threadIdx.x==0) *slot=(int)__hip_atomic_fetch_add(ctr+64*grp,1u,__ATOMIC_RELAXED,__HIP_MEMORY_SCOPE_AGENT);
    __syncthreads(); const int idx=__builtin_amdgcn_readfirstlane(*slot); __syncthreads();
    if(idx>=128)return false; u.bh=grp*4+(idx&3); u.qb=31-(idx>>2); return true; }
  __device__ __forceinline__ void a_ready(const AttnUnit&)const{}
  __device__ __forceinline__ void done(const AttnUnit&)const{}
};
template<class Sched,int THRL=8> __device__ __forceinline__ void attn_phase(char*lds,const AttnTensors&T,const Sched&S){
  AttnUnit u;
  for(int i=0;S.next(i,u);++i){ S.a_ready(u); { const int hp=u.bh%NHEAD; attn_unit<THRL>(u.bh/NHEAD,(hp>>1)*64,(hp>>2)*128+(hp&1)*64,hp*64,u.qb,T.Q,T.K,T.V,T.O,lds); } S.done(u); }
}
#undef SBAR
#undef WAIT_BAR
}

constexpr int NWAVES = 8;
constexpr int BATCH = 2, T = 8192, D = 1024, M = BATCH * T;
constexpr int NPROJ = 5632;
constexpr int IN_W = 5640;
constexpr float EPS = 1e-6f;
constexpr int NE = 32, FH = 256;
constexpr int XG_ROWS = 160 * 256;
constexpr int N_PHASES = 13;

constexpr size_t MiB = 1u << 20;
constexpr size_t WS_CTL = 0, CTL_ZERO_BYTES = 1 * MiB;
constexpr size_t WS_WIN = 1 * MiB;
constexpr size_t WS_WA = 12 * MiB, WS_WB = 13 * MiB, WS_WOUT = 14 * MiB;
constexpr size_t WS_BD = 16 * MiB;
constexpr size_t WS_POS = 16 * MiB + 512 * 1024;
constexpr size_t WS_ROWW = 17 * MiB;
constexpr size_t WS_ROUTE = 17 * MiB + 256 * 1024;
constexpr size_t WS_WR = 17 * MiB + 512 * 1024;
constexpr size_t WS_GU = 18 * MiB;
constexpr size_t WS_WN = 18 * MiB, WS_KDT = 34 * MiB, WS_U = 50 * MiB;
constexpr size_t WS_QD = 210 * MiB, WS_IN = 226 * MiB, WS_GL = 234 * MiB;
constexpr size_t WS_SB = 146 * MiB, WS_VB = 178 * MiB;
constexpr size_t WS_DN = 50 * MiB;
constexpr size_t WS_H = 66 * MiB;
constexpr size_t WS_Q = 98 * MiB, WS_K = 114 * MiB, WS_V = 130 * MiB;
constexpr size_t WS_G = 146 * MiB;
constexpr size_t WS_GATE = 194 * MiB;
constexpr size_t WS_XG = 146 * MiB;
constexpr size_t WS_YG = 66 * MiB;
constexpr size_t WS_ACT = 226 * MiB;
constexpr size_t WS_END = 256 * MiB;
static_assert(WS_XG + (size_t)XG_ROWS * 1024 * 2 <= WS_ACT && WS_ACT + (size_t)XG_ROWS * 256 * 2 <= WS_END && WS_YG + (size_t)XG_ROWS * 1024 * 2 <= WS_XG, "ws map");
static_assert(WS_WR + 36 * 1024 * 4 <= WS_GU && WS_ROWW + XG_ROWS * 4 <= WS_ROUTE && WS_ROUTE + (size_t)M * 16 <= WS_WR, "ws map small");
constexpr int CW_TMO = 0, CW_CODE = 1;
constexpr int CW_BAR = 4096;
constexpr int CW_CNT = 16384, CW_CUR = 16384 + 32 * 64;
constexpr int CW_AQ = 16384 + 64 * 64;
constexpr int RING_OFF = 0, RING_BYTES = 131072;
constexpr int LDSCTL_OFF = RING_BYTES, MISC_OFF = LDSCTL_OFF + 320;
constexpr int TS_OFF = MISC_OFF + 128;
constexpr int GDN_AB_OFF = LDSCTL_OFF + 1024;
constexpr int LDS_BYTES = 147456;

#define GAS __attribute__((address_space(1)))
#define LAS __attribute__((address_space(3)))
typedef unsigned short bf16;
typedef unsigned v4u __attribute__((ext_vector_type(4)));
typedef unsigned v2u __attribute__((ext_vector_type(2)));
typedef float f32x4 __attribute__((ext_vector_type(4)));
typedef GAS unsigned gu32;
#define RLX_AGENT __ATOMIC_RELAXED, __HIP_MEMORY_SCOPE_AGENT
#define LDS_WAIT() asm volatile("s_waitcnt lgkmcnt(0)" ::: "memory")
#define VM_WAIT() asm volatile("s_waitcnt vmcnt(0)" ::: "memory")
__device__ __forceinline__ unsigned f2bf(float f) { unsigned u = __builtin_bit_cast(unsigned, f); return (u + 0x7fffu + ((u >> 16) & 1u)) >> 16; }
__device__ __forceinline__ unsigned pk2(float lo, float hi) { return f2bf(lo) | (f2bf(hi) << 16); }
__device__ __forceinline__ float bflo(unsigned w) { return __uint_as_float(w << 16); }
__device__ __forceinline__ float bfhi(unsigned w) { return __uint_as_float(w & 0xffff0000u); }
__device__ __forceinline__ float sigm(float x) { return 1.0f / (1.0f + __expf(-x)); }

#define XB_TMO      128
#define XB_XCNT(j)  (256  + 64 * (j))
#define XB_XSUB(j)  (1280 + 64 * (j))
#define XB_XGEN(j)  (2304 + 64 * (j))
#define XB_TOP      3328
#define XB_TOPGEN   3392
#define XCD_BAR_WORDS 3456
#define XB_SPIN_CAP (1u << 22)
__device__ __forceinline__ unsigned xb_ld(unsigned* p)              { return __hip_atomic_load(p, __ATOMIC_RELAXED, __HIP_MEMORY_SCOPE_AGENT); }
__device__ __forceinline__ unsigned xb_add(unsigned* p, unsigned v) { return __hip_atomic_fetch_add(p, v, __ATOMIC_RELAXED, __HIP_MEMORY_SCOPE_AGENT); }
__device__ __forceinline__ unsigned xb_xcc_id() { return (unsigned)__builtin_amdgcn_s_getreg((3 << 11) | 20) & 0xFu; }
#define XB_SPIN(cond, bar) do { unsigned _sp = 0; while (cond) { __builtin_amdgcn_s_sleep(1); \
    if ((++_sp & 255u) == 0u) { if (xb_ld(&(bar)[XB_TMO])) break; if (_sp > XB_SPIN_CAP) { atomicAdd(&(bar)[XB_TMO], 1u); break; } } } } while (0)
struct XcdBarrier { unsigned* bar; unsigned x; volatile LAS unsigned* st; };
__device__ __forceinline__ XcdBarrier xcd_barrier_post(unsigned* bar, volatile LAS unsigned* st) {
    XcdBarrier b; b.bar = bar; b.x = xb_xcc_id(); b.st = st;
    if (threadIdx.x == 0) (void)xb_add(&bar[XB_XCNT(b.x)], 1u);
    return b;
}
__device__ __forceinline__ void xcd_barrier_complete(unsigned* bar, unsigned x, unsigned& nloc, unsigned& nx) {
    const unsigned G = gridDim.x * gridDim.y * gridDim.z;
    unsigned sum, cnt, mine, sp = 0u;
    for (;;) {
        sum = 0u; cnt = 0u; mine = 0u;
#pragma unroll
        for (unsigned j = 0; j < 16; ++j) { const unsigned c = xb_ld(&bar[XB_XCNT(j)]); sum += c; cnt += (c > 0u) ? 1u : 0u; mine = (j == x) ? c : mine; }
        if (sum == G) break;
        __builtin_amdgcn_s_sleep(1);
        if ((++sp & 255u) == 0u) { if (xb_ld(&bar[XB_TMO])) break; if (sp > XB_SPIN_CAP) { atomicAdd(&bar[XB_TMO], 1u); break; } }
    }
    nloc = mine > 0u ? mine : 1u; nx = cnt > 0u ? cnt : 1u;
}
__device__ __forceinline__ void xcd_barrier(const XcdBarrier& b) {
    asm volatile("s_waitcnt vmcnt(0)" ::: "memory");
    __syncthreads();
    if (threadIdx.x == 0) {
        unsigned* bar = b.bar;
        __builtin_amdgcn_s_waitcnt(0);
        unsigned nloc = b.st[0], nx = b.st[1];
        if (nloc == 0u) { xcd_barrier_complete(bar, b.x, nloc, nx); b.st[0] = nloc; b.st[1] = nx; }
        const unsigned old = xb_add(&bar[XB_XSUB(b.x)], 1u);
        const unsigned gen = old / nloc;
        if (old + 1u == (gen + 1u) * nloc) {
            __builtin_amdgcn_fence(__ATOMIC_RELEASE, "agent");
            asm volatile("s_waitcnt vmcnt(0)" ::: "memory");
            const unsigned og = xb_add(&bar[XB_TOP], 1u);
            const unsigned tg = og / nx;
            if (og + 1u == (tg + 1u) * nx) xb_add(&bar[XB_TOPGEN], 1u);
            else XB_SPIN(xb_ld(&bar[XB_TOPGEN]) == tg, bar);
            __builtin_amdgcn_fence(__ATOMIC_ACQUIRE, "agent");
            xb_add(&bar[XB_XGEN(b.x)], 1u);
            asm volatile("s_waitcnt vmcnt(0)" ::: "memory");
        } else {
            XB_SPIN(xb_ld(&bar[XB_XGEN(b.x)]) == gen, bar);
            __builtin_amdgcn_fence(__ATOMIC_ACQUIRE, "agent");
            asm volatile("s_waitcnt vmcnt(0)" ::: "memory");
        }
    }
    __syncthreads();
}

#define CAS __attribute__((address_space(4)))
struct Args { const float* in[24]; float* out; unsigned char* ws; int ph_lo, ph_hi; };
#define FIN(k) (F.ka->in[k])
struct Frame {
    LAS unsigned char* lds;
    volatile LAS unsigned* MISC;
    gu32* ctl;
    int tid, lane, wave;
    int vcu, G;
    unsigned char* ws;
    float* out;
    const CAS Args* ka;
};
__device__ __forceinline__ float wave_sum(float v) {
#pragma unroll
    for (int o = 1; o < 64; o <<= 1) v += __shfl_xor(v, o);
    return v;
}
__device__ __forceinline__ void p0_transpose_item(const float* W, int ldw, int col0, int K, int nblk, bf16* WT, int dst_row0, LAS float* scr, int item, int lane) {
    const int kb = item / nblk, nb = item % nblk, k0 = 64 * kb, n0 = 32 * nb;
#pragma unroll 8
    for (int i = 0; i < 32; ++i) { const int kk = 2 * i + (lane >> 5); scr[kk * 33 + (lane & 31)] = W[(size_t)(k0 + kk) * ldw + col0 + n0 + (lane & 31)]; }
    LDS_WAIT(); asm volatile("" ::: "memory");
    const int c = lane & 7;
#pragma unroll
    for (int j = 0; j < 4; ++j) { const int n = (lane >> 3) + 8 * j; const LAS float* s = scr + (8 * c) * 33 + n;
        v4u o; o.x = pk2(s[0 * 33], s[1 * 33]); o.y = pk2(s[2 * 33], s[3 * 33]); o.z = pk2(s[4 * 33], s[5 * 33]); o.w = pk2(s[6 * 33], s[7 * 33]);
        *(GAS v4u*)(WT + (size_t)(dst_row0 + n0 + n) * K + k0 + 8 * c) = o; }
    LDS_WAIT(); asm volatile("" ::: "memory");
}

__device__ __forceinline__ void moe_weights_phase(Frame& F) {
    LAS float* scr = (LAS float*)(F.lds + RING_OFF + F.wave * 16384);
    const int gw = F.vcu * NWAVES + F.wave, NGW = F.G * NWAVES;
    bf16* GU = (bf16*)(F.ws + WS_GU); bf16* DN = (bf16*)(F.ws + WS_DN);
    constexpr int I_G1 = 16 * 4;
    constexpr int I_GU = NE * 4 * I_G1, I_DN = NE * 4 * 32;
    for (int it = gw; it < I_GU + I_DN; it += NGW) {
        int r = it;
        if (r < I_GU) { const int blk = r / I_G1, i2 = r % I_G1, e = blk >> 2, pn = (blk >> 1) & 1, isup = blk & 1;
            p0_transpose_item((isup ? FIN(21) : FIN(20)) + (size_t)e * 1024 * 256, 256, 128 * pn, 1024, 4, GU, e * 512 + 256 * pn + 128 * isup, scr, i2, F.lane); continue; } r -= I_GU;
        { const int e = r / 128, i2 = r % 128; p0_transpose_item(FIN(22) + (size_t)e * 256 * 1024, 1024, 0, 256, 32, DN, e * 1024, scr, i2, F.lane); }
    }
}

__device__ __forceinline__ void p0_prologue(Frame& F) {
    LAS float* scr = (LAS float*)(F.lds + RING_OFF + F.wave * 16384);
    const int gw = F.vcu * NWAVES + F.wave, NGW = F.G * NWAVES;
    bf16* WIN = (bf16*)(F.ws + WS_WIN); bf16* WA = (bf16*)(F.ws + WS_WA); bf16* WB = (bf16*)(F.ws + WS_WB); bf16* WO = (bf16*)(F.ws + WS_WOUT);
    constexpr int I_IN0 = 16 * 96, I_IN1 = 16 * 16, I_IN2 = 16 * 32, I_IN3 = 16 * 32;
    constexpr int I_A = 8 * 32, I_B = 8 * 32, I_O = 16 * 32;
    constexpr int NITEMS = I_IN0 + I_IN1 + I_IN2 + I_IN3 + I_A + I_B + I_O;
    for (int it = gw; it < NITEMS; it += NGW) {
        int r = it;
        if (r < I_IN0) { p0_transpose_item(FIN(2), IN_W, 0, D, 96, WIN, 0, scr, r, F.lane); continue; } r -= I_IN0;
        if (r < I_IN1) { p0_transpose_item(FIN(2), IN_W, 3080, D, 16, WIN, 3072, scr, r, F.lane); continue; } r -= I_IN1;
        if (r < I_IN2) { p0_transpose_item(FIN(2), IN_W, 3592, D, 32, WIN, 3584, scr, r, F.lane); continue; } r -= I_IN2;
        if (r < I_IN3) { p0_transpose_item(FIN(2), IN_W, 4616, D, 32, WIN, 4608, scr, r, F.lane); continue; } r -= I_IN3;
        if (r < I_A) { p0_transpose_item(FIN(12), 1024, 0, 512, 32, WA, 0, scr, r, F.lane); continue; } r -= I_A;
        if (r < I_B) { p0_transpose_item(FIN(13), 1024, 0, 512, 32, WB, 0, scr, r, F.lane); continue; } r -= I_B;
        p0_transpose_item(FIN(14), 1024, 0, 1024, 32, WO, 0, scr, r, F.lane);
    }
    { float* WR = (float*)(F.ws + WS_WR); const int gt = F.vcu * (NWAVES * 64) + F.tid, NT = F.G * NWAVES * 64;
      for (int i = gt; i < 36 * 1024; i += NT) { const int c = i >> 10, k = i & 1023; WR[i] = (c < 4) ? FIN(16)[k * 4 + c] : FIN(18)[k * 32 + (c - 4)]; } }
    __syncthreads();
    LAS float* W8 = (LAS float*)(F.lds + RING_OFF);
    for (int i = F.tid; i < 1024 * 8; i += NWAVES * 64) W8[i] = FIN(2)[(size_t)(i >> 3) * IN_W + 3072 + (i & 7)];
    __syncthreads();
    bf16* H = (bf16*)(F.ws + WS_H); float* BD = (float*)(F.ws + WS_BD);
    for (int m = gw; m < M; m += NGW) {
        const GAS f32x4* xr = (const GAS f32x4*)(FIN(0) + (size_t)m * D) + F.lane;
        f32x4 v[4]; float s2 = 0.f;
#pragma unroll
        for (int j = 0; j < 4; ++j) { v[j] = xr[64 * j]; s2 += (v[j].x * v[j].x + v[j].y * v[j].y) + (v[j].z * v[j].z + v[j].w * v[j].w); }
        const float rstd = 1.f / sqrtf(wave_sum(s2) * (1.f / D) + EPS);
        float bd[8];
#pragma unroll
        for (int q = 0; q < 8; ++q) bd[q] = 0.f;
        GAS unsigned long long* o8 = (GAS unsigned long long*)(H + (size_t)m * D) + F.lane;
#pragma unroll
        for (int j = 0; j < 4; ++j) { const f32x4 g = *((const GAS f32x4*)FIN(1) + F.lane + 64 * j); v[j] = v[j] * rstd * g;
            o8[64 * j] = (unsigned long long)pk2(v[j].x, v[j].y) | ((unsigned long long)pk2(v[j].z, v[j].w) << 32);
#pragma unroll
            for (int i = 0; i < 4; ++i) { const int k = 256 * j + 4 * F.lane + i; const f32x4 wa = *(const LAS f32x4*)(W8 + k * 8), wb = *(const LAS f32x4*)(W8 + k * 8 + 4); const float xv = v[j][i];
                bd[0] += xv * wa.x; bd[1] += xv * wa.y; bd[2] += xv * wa.z; bd[3] += xv * wa.w; bd[4] += xv * wb.x; bd[5] += xv * wb.y; bd[6] += xv * wb.z; bd[7] += xv * wb.w; } }
#pragma unroll
        for (int q = 0; q < 8; ++q) bd[q] = wave_sum(bd[q]);
        if (F.lane == 0) { *(GAS f32x4*)(BD + (size_t)m * 8) = (f32x4){bd[0], bd[1], bd[2], bd[3]}; *(GAS f32x4*)(BD + (size_t)m * 8 + 4) = (f32x4){bd[4], bd[5], bd[6], bd[7]}; }
    }
}

typedef float f32x16 __attribute__((ext_vector_type(16)));
typedef short bf16x8v __attribute__((ext_vector_type(8)));
typedef float f32x2_t __attribute__((ext_vector_type(2))); typedef __bf16 bf16x2_t __attribute__((ext_vector_type(2)));
__device__ __forceinline__ unsigned cvtpk(float lo, float hi) { f32x2_t v = {lo, hi}; bf16x2_t b = __builtin_convertvector(v, bf16x2_t); return __builtin_bit_cast(unsigned, b); }
__device__ __forceinline__ bf16x8v pack_half(const f32x16& x, int s) {
    v4u p; p.x = cvtpk(x[8 * s], x[8 * s + 1]); p.y = cvtpk(x[8 * s + 2], x[8 * s + 3]); p.z = cvtpk(x[8 * s + 4], x[8 * s + 5]); p.w = cvtpk(x[8 * s + 6], x[8 * s + 7]);
    return __builtin_bit_cast(bf16x8v, p);
}
#define MFMA32(a, b, c) __builtin_amdgcn_mfma_f32_32x32x16_bf16((a), (b), (c), 0, 0, 0)
__device__ __forceinline__ int crow16(int r, int h) { return (r & 3) + 8 * (r >> 2) + 4 * h; }
__device__ __forceinline__ constexpr int perm16c(int p) { return (p & ~0xC) | ((p & 8) >> 1) | ((p & 4) << 1); }

constexpr int GP = 272, TPB = 144;
constexpr int GA_QS = 0, GA_KS = 17408, GA_VBT = 34816, GA_KBT = 53248, GA_AM = 71680, GA_TB = 88320, GA_CW = 97536, GA_END = 103680;
constexpr int GA_SM = LDSCTL_OFF + 1024;
static_assert(GA_END <= RING_BYTES, "GDN-A LDS");

__device__ __forceinline__ void gdn_a_phase(Frame& F) {
    const int tid = F.tid, lane = F.lane, wave = F.wave, r32 = lane & 31, hh = lane >> 5;
    LAS unsigned char* L = F.lds + RING_OFF;
    LAS float* SM = (LAS float*)(F.lds + GA_SM);
    LAS float* AM = (LAS float*)(L + GA_AM); LAS float* CW = (LAS float*)(L + GA_CW);
    int cur_h = -1;
    const bf16* G = (const bf16*)(F.ws + WS_G); const float* BD = (const float*)(F.ws + WS_BD);
    bf16* WN = (bf16*)(F.ws + WS_WN); bf16* KDT = (bf16*)(F.ws + WS_KDT); bf16* UF = (bf16*)(F.ws + WS_U); bf16* QD = (bf16*)(F.ws + WS_QD); bf16* INp = (bf16*)(F.ws + WS_IN); float* GL = (float*)(F.ws + WS_GL);
    const int c = tid >> 3, seg = tid & 7;
    const int nit = (F.G == 256) ? 4 : (1024 - F.vcu + F.G - 1) / F.G;
    for (int k4 = 0; k4 < nit; ++k4) {
        const int item = (F.G == 256) ? (F.vcu & 7) * 128 + (F.vcu >> 3) + 32 * k4 : F.vcu + k4 * F.G;
        const int b = item >> 9, h = (item >> 7) & 3, n = item & 127, t0 = b * T + n * 64;
        if (h != cur_h) { cur_h = h; for (int i = tid; i < 1536; i += NWAVES * 64) { const int j = i >> 9, jj = (i >> 7) & 3, ch = i & 127; CW[i] = FIN(8)[jj * 1536 + j * 512 + h * 128 + ch]; } }
        if (wave == 0) {
            const float* bd = BD + (size_t)(t0 + lane) * 8; const float xd = bd[4 + h] + FIN(10)[h]; const float sp = xd > 20.f ? xd : log1pf(__expf(xd));
            float gc = -__expf(FIN(9)[h]) * sp;
#pragma unroll
            for (int d = 1; d < 64; d <<= 1) { const float o = __shfl_up(gc, d); if (lane >= d) gc += o; }
            const float g63 = __shfl(gc, 63);
            SM[lane] = gc; SM[64 + lane] = sigm(bd[h]); SM[128 + lane] = __expf(gc); SM[192 + lane] = __expf(g63 - gc);
            if (lane == 0) GL[item] = __expf(g63);
        }
        __syncthreads();
        const float be = SM[64 + c], eg = SM[128 + c];
#pragma unroll
        for (int j = 0; j < 3; ++j) {
            const int ch = j * 512 + h * 128 + seg * 16; float a[16];
#pragma unroll
            for (int i = 0; i < 16; ++i) a[i] = 0.f;
#pragma unroll
            for (int jj = 0; jj < 4; ++jj) { const int tl = n * 64 + c - 3 + jj;
                if (tl >= 0) { const bf16* rp = G + (size_t)(b * T + tl) * 1536 + ch; const v4u r0 = *(const v4u*)rp, r1 = *(const v4u*)(rp + 8); const unsigned rw[8] = {r0.x, r0.y, r0.z, r0.w, r1.x, r1.y, r1.z, r1.w};
                    const LAS float* wp = CW + (j * 4 + jj) * 128 + seg * 16;
#pragma unroll
                    for (int i = 0; i < 8; ++i) { a[2 * i] += wp[2 * i] * bflo(rw[i]); a[2 * i + 1] += wp[2 * i + 1] * bfhi(rw[i]); } } }
            float ss = 0.f;
#pragma unroll
            for (int i = 0; i < 16; ++i) { a[i] = a[i] * sigm(a[i]); ss += a[i] * a[i]; }
            ss += __shfl_xor(ss, 1); ss += __shfl_xor(ss, 2); ss += __shfl_xor(ss, 4);
            if (j == 0) {
                const float sc = 0.08838834764831845f / sqrtf(ss + EPS); unsigned w[8], wd[8];
#pragma unroll
                for (int i = 0; i < 16; ++i) a[i] *= sc;
#pragma unroll
                for (int i = 0; i < 8; ++i) { w[i] = pk2(a[2 * i], a[2 * i + 1]); wd[i] = pk2(a[perm16c(2 * i)] * eg, a[perm16c(2 * i + 1)] * eg); }
                *(LAS v4u*)(L + GA_QS + c * GP + seg * 32) = (v4u){w[0], w[1], w[2], w[3]}; *(LAS v4u*)(L + GA_QS + c * GP + seg * 32 + 16) = (v4u){w[4], w[5], w[6], w[7]};
                bf16* qp = QD + (size_t)item * 8192 + c * 128 + seg * 16; *(v4u*)qp = (v4u){wd[0], wd[1], wd[2], wd[3]}; *(v4u*)(qp + 8) = (v4u){wd[4], wd[5], wd[6], wd[7]};
            } else if (j == 1) {
                const float sc = 1.f / sqrtf(ss + EPS); unsigned w[8];
#pragma unroll
                for (int i = 0; i < 16; ++i) a[i] *= sc;
#pragma unroll
                for (int i = 0; i < 8; ++i) w[i] = pk2(a[2 * i], a[2 * i + 1]);
                *(LAS v4u*)(L + GA_KS + c * GP + seg * 32) = (v4u){w[0], w[1], w[2], w[3]}; *(LAS v4u*)(L + GA_KS + c * GP + seg * 32 + 16) = (v4u){w[4], w[5], w[6], w[7]};
                const float kb = be * eg;
#pragma unroll
                for (int i = 0; i < 16; ++i) *(LAS unsigned short*)(L + GA_KBT + (seg * 16 + i) * TPB + c * 2) = (unsigned short)f2bf(a[i] * kb);
            } else {
#pragma unroll
                for (int i = 0; i < 16; ++i) *(LAS unsigned short*)(L + GA_VBT + (seg * 16 + i) * TPB + c * 2) = (unsigned short)f2bf(a[i] * be);
            }
        }
        __syncthreads();
        {
            const int w4 = wave & 3, ta = w4 >> 1, tb = w4 & 1;
            f32x16 acc = {};
            const LAS unsigned char* ap = L + GA_KS + (32 * ta + r32) * GP + hh * 16;
            const LAS unsigned char* bp = L + (wave < 4 ? GA_KS : GA_QS) + (32 * tb + r32) * GP + hh * 16;
#pragma unroll
            for (int s = 0; s < 8; ++s) acc = MFMA32(*(const LAS bf16x8v*)(ap + s * 32), *(const LAS bf16x8v*)(bp + s * 32), acc);
            const int cidx = 32 * tb + r32; const float gcc = SM[cidx];
            if (wave < 4) {
#pragma unroll
                for (int r = 0; r < 16; ++r) { const int i = 32 * ta + crow16(r, hh); const float val = (cidx < i) ? SM[64 + i] * acc[r] * __expf(SM[i] - gcc) : 0.f; AM[i * 64 + cidx] = val; }
            } else {
#pragma unroll
                for (int r = 0; r < 16; ++r) { const int j = 32 * ta + crow16(r, hh); acc[r] = (j <= cidx) ? acc[r] * __expf(gcc - SM[j]) : 0.f; }
                bf16* ip = INp + (size_t)item * 4096 + cidx * 64 + 32 * ta + 8 * hh;
                *(bf16x8v*)ip = pack_half(acc, 0); *(bf16x8v*)(ip + 16) = pack_half(acc, 1);
            }
        }
        __syncthreads();
        {
            const int part = lane & 7, col = 8 * wave + (lane >> 3);
            float tj[8];
#pragma unroll
            for (int m = 0; m < 8; ++m) tj[m] = 0.f;
#pragma unroll
            for (int m = 0; m < 8; ++m)
#pragma unroll
                for (int p = 0; p < 8; ++p) {
                    const int i = 8 * m + p; const LAS float* ar = AM + i * 64 + part;
                    float s0 = 0.f, s1 = 0.f;
#pragma unroll
                    for (int mm = 0; mm <= m; ++mm) { if (mm & 1) s1 += ar[8 * mm] * tj[mm]; else s0 += ar[8 * mm] * tj[mm]; }
                    float sum = s0 + s1;
                    sum += __builtin_bit_cast(float, __builtin_amdgcn_update_dpp(0, __builtin_bit_cast(int, sum), 0xB1, 0xF, 0xF, true));
                    sum += __builtin_bit_cast(float, __builtin_amdgcn_update_dpp(0, __builtin_bit_cast(int, sum), 0x4E, 0xF, 0xF, true));
                    sum += __builtin_bit_cast(float, __builtin_amdgcn_update_dpp(0, __builtin_bit_cast(int, sum), 0x141, 0xF, 0xF, true));
                    const float val = ((i == col) ? 1.f : 0.f) - sum;
                    tj[m] = (part == p) ? val : tj[m];
                }
#pragma unroll
            for (int m = 0; m < 8; ++m) *(LAS unsigned short*)(L + GA_TB + (part + 8 * m) * TPB + col * 2) = (unsigned short)f2bf(tj[m]);
        }
        { const int kk = tid >> 2, cg = tid & 3; unsigned w[8];
#pragma unroll
          for (int e = 0; e < 8; ++e) { const int c0 = 16 * cg + perm16c(2 * e), c1 = 16 * cg + perm16c(2 * e + 1);
              const float v0 = bflo((unsigned)*(const LAS unsigned short*)(L + GA_KS + c0 * GP + kk * 2)) * SM[192 + c0], v1 = bflo((unsigned)*(const LAS unsigned short*)(L + GA_KS + c1 * GP + kk * 2)) * SM[192 + c1];
              w[e] = pk2(v0, v1); }
          bf16* kp = KDT + (size_t)item * 8192 + kk * 64 + cg * 16; *(v4u*)kp = (v4u){w[0], w[1], w[2], w[3]}; *(v4u*)(kp + 8) = (v4u){w[4], w[5], w[6], w[7]}; }
        __syncthreads();
#pragma unroll
        for (int rep = 0; rep < 2; ++rep) {
            const int t = wave + 8 * rep;
            if (rep == 0) {
                const int ct = t >> 2, vs = t & 3; f32x16 acc = {};
                const LAS unsigned char* ap = L + GA_TB + (32 * ct + r32) * TPB + hh * 16; const LAS unsigned char* bp = L + GA_VBT + (32 * vs + r32) * TPB + hh * 16;
#pragma unroll
                for (int s = 0; s < 4; ++s) acc = MFMA32(*(const LAS bf16x8v*)(ap + s * 32), *(const LAS bf16x8v*)(bp + s * 32), acc);
                bf16* up = UF + (size_t)item * 8192 + ((ct * 4 + vs) * 64 + lane) * 16;
                *(bf16x8v*)up = pack_half(acc, 0); *(bf16x8v*)(up + 8) = pack_half(acc, 1);
            } else {
                const int kt = (t - 8) >> 1, ct = (t - 8) & 1; f32x16 acc = {};
                const LAS unsigned char* ap = L + GA_KBT + (32 * kt + r32) * TPB + hh * 16; const LAS unsigned char* bp = L + GA_TB + (32 * ct + r32) * TPB + hh * 16;
#pragma unroll
                for (int s = 0; s < 4; ++s) acc = MFMA32(*(const LAS bf16x8v*)(ap + s * 32), *(const LAS bf16x8v*)(bp + s * 32), acc);
#pragma unroll
                for (int r = 0; r < 16; ++r) acc[r] = -acc[r];
                bf16* wp = WN + (size_t)item * 8192 + (32 * ct + r32) * 128 + 32 * kt + 8 * hh;
                *(bf16x8v*)wp = pack_half(acc, 0); *(bf16x8v*)(wp + 16) = pack_half(acc, 1);
            }
        }
        __syncthreads();
    }
}

constexpr int GB_WN = 0, GB_KD = 17408, GB_U = 35840, GB_BUF = 52224;
static_assert(2 * GB_BUF <= RING_BYTES, "GDN-B LDS");
__device__ __forceinline__ void gdn_b_phase(Frame& F) {
    if (blockIdx.x >= 8) return;
    const int tid = F.tid, lane = F.lane, wave = F.wave, r32 = lane & 31, hh = lane >> 5;
    LAS unsigned char* L = F.lds + RING_OFF;
    const bf16* WN = (const bf16*)(F.ws + WS_WN); const bf16* KDT = (const bf16*)(F.ws + WS_KDT); const bf16* UF = (const bf16*)(F.ws + WS_U); const float* GL = (const float*)(F.ws + WS_GL);
    bf16* SB = (bf16*)(F.ws + WS_SB); bf16* VB = (bf16*)(F.ws + WS_VB);
    const int item0 = blockIdx.x * 128;
    f32x16 S[4];
#pragma unroll
    for (int k = 0; k < 4; ++k) S[k] = (f32x16){};
    v4u st[6];
#define GB_LOAD(it) do { const v4u* a_ = (const v4u*)(WN + (size_t)(it) * 8192); const v4u* b_ = (const v4u*)(KDT + (size_t)(it) * 8192); const v4u* c_ = (const v4u*)(UF + (size_t)(it) * 8192); \
        st[0] = a_[tid]; st[1] = a_[tid + 512]; st[2] = b_[tid]; st[3] = b_[tid + 512]; st[4] = c_[tid]; st[5] = c_[tid + 512]; } while (0)
#define GB_WRITE(buf) do { LAS unsigned char* B_ = L + (buf) * GB_BUF; \
        *(LAS v4u*)(B_ + GB_WN + (tid >> 4) * GP + (tid & 15) * 16) = st[0]; *(LAS v4u*)(B_ + GB_WN + ((tid + 512) >> 4) * GP + (tid & 15) * 16) = st[1]; \
        *(LAS v4u*)(B_ + GB_KD + (tid >> 3) * TPB + (tid & 7) * 16) = st[2]; *(LAS v4u*)(B_ + GB_KD + ((tid + 512) >> 3) * TPB + (tid & 7) * 16) = st[3]; \
        *(LAS v4u*)(B_ + GB_U + tid * 16) = st[4]; *(LAS v4u*)(B_ + GB_U + (tid + 512) * 16) = st[5]; } while (0)
    LAS float* GLs = (LAS float*)(F.lds + GA_SM);
    if (tid < 128) GLs[tid] = GL[item0 + tid];
    GB_LOAD(item0); GB_WRITE(0);
    __syncthreads();
    for (int n = 0; n < 128; ++n) {
        const int item = item0 + n; const int buf = n & 1;
        if (n + 1 < 128) GB_LOAD(item + 1);
        if (wave < 4) {
            const int vs = wave; const LAS unsigned char* B_ = L + buf * GB_BUF;
            const float gl = GLs[n];
            bf16x8v sb[4][2];
#pragma unroll
            for (int kt = 0; kt < 4; ++kt)
#pragma unroll
                for (int s = 0; s < 2; ++s) { sb[kt][s] = pack_half(S[kt], s); *(bf16x8v*)(SB + ((((size_t)item * 4 + vs) * 4 + kt) * 2 + s) * 512 + lane * 8) = sb[kt][s]; }
            bf16x8v vb[2][2]; bf16x8v af[16];
            { const LAS unsigned char* ap = B_ + GB_WN + r32 * GP + hh * 16;
#pragma unroll
              for (int ct = 0; ct < 2; ++ct)
#pragma unroll
                  for (int k = 0; k < 8; ++k) af[ct * 8 + k] = *(const LAS bf16x8v*)(ap + ct * 32 * GP + k * 32); }
            f32x16 vn[2];
#pragma unroll
            for (int ct = 0; ct < 2; ++ct) {
                const LAS unsigned char* up = B_ + GB_U + ((ct * 4 + vs) * 64 + lane) * 32; const v4u u0 = *(const LAS v4u*)up, u1 = *(const LAS v4u*)(up + 16);
                f32x16 acc; acc[0] = bflo(u0.x); acc[1] = bfhi(u0.x); acc[2] = bflo(u0.y); acc[3] = bfhi(u0.y); acc[4] = bflo(u0.z); acc[5] = bfhi(u0.z); acc[6] = bflo(u0.w); acc[7] = bfhi(u0.w);
                acc[8] = bflo(u1.x); acc[9] = bfhi(u1.x); acc[10] = bflo(u1.y); acc[11] = bfhi(u1.y); acc[12] = bflo(u1.z); acc[13] = bfhi(u1.z); acc[14] = bflo(u1.w); acc[15] = bfhi(u1.w);
                vn[ct] = acc; }
            __builtin_amdgcn_sched_barrier(0);
#pragma unroll
            for (int ct = 0; ct < 2; ++ct)
#pragma unroll
                for (int k = 0; k < 8; ++k) vn[ct] = MFMA32(af[ct * 8 + k], sb[k >> 1][k & 1], vn[ct]);
            __builtin_amdgcn_sched_barrier(0);
            { const LAS unsigned char* ap = B_ + GB_KD + r32 * TPB + hh * 16;
#pragma unroll
              for (int kt = 0; kt < 4; ++kt)
#pragma unroll
                  for (int k = 0; k < 4; ++k) af[kt * 4 + k] = *(const LAS bf16x8v*)(ap + kt * 32 * TPB + k * 32); }
#pragma unroll
            for (int ct = 0; ct < 2; ++ct)
#pragma unroll
                for (int s2 = 0; s2 < 2; ++s2) { vb[ct][s2] = pack_half(vn[ct], s2); *(bf16x8v*)(VB + ((((size_t)item * 4 + vs) * 2 + ct) * 2 + s2) * 512 + lane * 8) = vb[ct][s2]; }
#pragma unroll
            for (int kt = 0; kt < 4; ++kt) S[kt] = S[kt] * gl;
            __builtin_amdgcn_sched_barrier(0);
#pragma unroll
            for (int kt = 0; kt < 4; ++kt)
#pragma unroll
                for (int k = 0; k < 4; ++k) S[kt] = MFMA32(af[kt * 4 + k], vb[k >> 1][k & 1], S[kt]);
        }
        if (n + 1 < 128) GB_WRITE(buf ^ 1);
        __syncthreads();
    }
#undef GB_LOAD
#undef GB_WRITE
}

constexpr int GC_OS = 0;
__device__ __forceinline__ void gdn_c_phase(Frame& F) {
    const int tid = F.tid, lane = F.lane, wave = F.wave, r32 = lane & 31, hh = lane >> 5;
    LAS float* OS = (LAS float*)(F.lds + RING_OFF + GC_OS);
    const bf16* QD = (const bf16*)(F.ws + WS_QD); const bf16* INp = (const bf16*)(F.ws + WS_IN); const bf16* SB = (const bf16*)(F.ws + WS_SB); const bf16* VB = (const bf16*)(F.ws + WS_VB);
    const bf16* GATE = (const bf16*)(F.ws + WS_GATE); bf16* YB = (bf16*)(F.ws + WS_K);
    const int ct = wave >> 2, vs = wave & 3, c = tid >> 3, seg = tid & 7;
    for (int item = F.vcu; item < 1024; item += F.G) {
        const int b = item >> 9, h = (item >> 7) & 3, n = item & 127, t0 = b * T + n * 64;
        f32x16 acc = {};
        const bf16* qa = QD + (size_t)item * 8192 + (32 * ct + r32) * 128 + 8 * hh;
        const bf16* sbp = SB + ((size_t)item * 4 + vs) * 4096 + lane * 8;
#pragma unroll
        for (int ks = 0; ks < 8; ++ks) acc = MFMA32(*(const bf16x8v*)(qa + ks * 16), *(const bf16x8v*)(sbp + ks * 512), acc);
        const bf16* ia = INp + (size_t)item * 4096 + (32 * ct + r32) * 64 + 8 * hh;
        const bf16* vbp = VB + ((size_t)item * 4 + vs) * 2048 + lane * 8;
#pragma unroll
        for (int ks = 0; ks < 4; ++ks) acc = MFMA32(*(const bf16x8v*)(ia + ks * 16), *(const bf16x8v*)(vbp + ks * 512), acc);
#pragma unroll
        for (int r = 0; r < 16; ++r) OS[(32 * ct + crow16(r, hh)) * 132 + 32 * vs + r32] = acc[r];
        __syncthreads();
        { const int tp = t0 + c; float o[16]; float ss = 0.f;
#pragma unroll
          for (int i = 0; i < 16; ++i) { o[i] = OS[c * 132 + seg * 16 + i]; ss += o[i] * o[i]; }
          ss += __shfl_xor(ss, 1); ss += __shfl_xor(ss, 2); ss += __shfl_xor(ss, 4);
          const float rr = 1.f / sqrtf(ss * (1.f / 128.f) + EPS);
          const v4u g0 = *(const v4u*)(GATE + (size_t)tp * 512 + h * 128 + seg * 16), g1 = *(const v4u*)(GATE + (size_t)tp * 512 + h * 128 + seg * 16 + 8);
          const unsigned gw[8] = {g0.x, g0.y, g0.z, g0.w, g1.x, g1.y, g1.z, g1.w}; unsigned ow[8];
#pragma unroll
          for (int i = 0; i < 8; ++i) { const float ga = bflo(gw[i]), gb = bfhi(gw[i]);
              const float y0 = o[2 * i] * rr * FIN(11)[seg * 16 + 2 * i] * (ga * sigm(ga)), y1 = o[2 * i + 1] * rr * FIN(11)[seg * 16 + 2 * i + 1] * (gb * sigm(gb)); ow[i] = pk2(y0, y1); }
          *(v4u*)(YB + (size_t)tp * 512 + h * 128 + seg * 16) = (v4u){ow[0], ow[1], ow[2], ow[3]}; *(v4u*)(YB + (size_t)tp * 512 + h * 128 + seg * 16 + 8) = (v4u){ow[4], ow[5], ow[6], ow[7]}; }
        __syncthreads();
    }
}

__device__ __forceinline__ void ya_phase(Frame& F) {
    const int gw = F.vcu * NWAVES + F.wave, NGW = F.G * NWAVES, l = F.lane;
    const float lam = __expf(wave_sum(FIN(3)[l] * FIN(4)[l])) - __expf(wave_sum(FIN(5)[l] * FIN(6)[l])) + 0.2f;
    const bf16* OP = (const bf16*)(F.ws + WS_H); bf16* YA = (bf16*)(F.ws + WS_Q);
    const int vh = l >> 5, d = 2 * (l & 31);
    const float g0 = FIN(7)[2 * l] * 0.8f, g1 = FIN(7)[2 * l + 1] * 0.8f;
    for (int m = gw; m < M; m += NGW) {
        const bf16* row = OP + (size_t)m * 1024; unsigned ow[4];
#pragma unroll
        for (int hh = 0; hh < 4; ++hh) {
            const unsigned p0 = *(const unsigned*)(row + ((hh * 2 + 0) * 2 + vh) * 64 + d), p1 = *(const unsigned*)(row + ((hh * 2 + 1) * 2 + vh) * 64 + d);
            const float a0 = bflo(p0) - lam * bflo(p1), a1 = bfhi(p0) - lam * bfhi(p1);
            const float ss = wave_sum(a0 * a0 + a1 * a1);
            const float r = 1.f / sqrtf(ss * (1.f / 128.f) + EPS);
            ow[hh] = pk2(a0 * r * g0, a1 * r * g1);
        }
#pragma unroll
        for (int hh = 0; hh < 4; ++hh) *(unsigned*)(YA + (size_t)m * 512 + hh * 128 + 2 * l) = ow[hh];
    }
}

__device__ __forceinline__ void router_phase(Frame& F, bool count) {
    const int gw = F.vcu * NWAVES + F.wave, NGW = F.G * NWAVES, l = F.lane;
    const float* WR = (const float*)(F.ws + WS_WR); bf16* H2 = (bf16*)(F.ws + WS_H); float* ROUTE = (float*)(F.ws + WS_ROUTE);
    f32x4 gn[4];
#pragma unroll
    for (int j = 0; j < 4; ++j) gn[j] = *((const GAS f32x4*)FIN(15) + l + 64 * j);
    for (int m = gw; m < M; m += NGW) {
        const GAS f32x4* xr = (const GAS f32x4*)(F.out + (size_t)m * D) + l;
        f32x4 v[4]; float s2 = 0.f;
#pragma unroll
        for (int j = 0; j < 4; ++j) { v[j] = xr[64 * j]; s2 += (v[j].x * v[j].x + v[j].y * v[j].y) + (v[j].z * v[j].z + v[j].w * v[j].w); }
        const float rstd = 1.f / sqrtf(wave_sum(s2) * (1.f / D) + EPS);
        GAS unsigned long long* o8 = (GAS unsigned long long*)(H2 + (size_t)m * D) + l;
#pragma unroll
        for (int j = 0; j < 4; ++j) { v[j] = v[j] * rstd * gn[j]; o8[64 * j] = (unsigned long long)pk2(v[j].x, v[j].y) | ((unsigned long long)pk2(v[j].z, v[j].w) << 32); }
        float lg[36];
#pragma unroll
        for (int c = 0; c < 36; ++c) { float a = 0.f;
#pragma unroll
            for (int j = 0; j < 4; ++j) { const f32x4 w = *((const GAS f32x4*)(WR + c * 1024) + l + 64 * j); a += (v[j].x * w.x + v[j].y * w.y) + (v[j].z * w.z + v[j].w * w.w); }
            lg[c] = wave_sum(a); }
        float gl[4];
#pragma unroll
        for (int c = 0; c < 4; ++c) gl[c] = lg[c] + FIN(17)[c];
        int gi = 0; float gm = gl[0];
#pragma unroll
        for (int c = 1; c < 4; ++c) if (gl[c] > gm) { gm = gl[c]; gi = c; }
        float den = 0.f;
#pragma unroll
        for (int c = 0; c < 4; ++c) den += __expf(gl[c] - gm);
        const float gwt = 1.f / den;
        float el[8];
#pragma unroll
        for (int j = 0; j < 8; ++j) { float a = lg[4 + j] + FIN(19)[j];
#pragma unroll
            for (int g = 1; g < 4; ++g) a = (gi == g) ? lg[4 + 8 * g + j] + FIN(19)[8 * g + j] : a;
            el[j] = a; }
        int i0 = 0; float v0 = el[0];
#pragma unroll
        for (int j = 1; j < 8; ++j) if (el[j] > v0) { v0 = el[j]; i0 = j; }
        int i1 = -1; float v1 = -INFINITY;
#pragma unroll
        for (int j = 0; j < 8; ++j) if (j != i0 && el[j] > v1) { v1 = el[j]; i1 = j; }
        const float e1 = __expf(v1 - v0), w0 = gwt / (1.f + e1), w1 = gwt * e1 / (1.f + e1);
        const int ex0 = gi * 8 + i0, ex1 = gi * 8 + i1;
        if (l == 0) { *(GAS f32x4*)(ROUTE + (size_t)m * 4) = (f32x4){__int_as_float(ex0), __int_as_float(ex1), w0, w1};
            if (count) { atomicAdd((unsigned*)(F.ctl + CW_CNT + 64 * ex0), 1u); atomicAdd((unsigned*)(F.ctl + CW_CNT + 64 * ex1), 1u); } }
    }
}
__device__ __forceinline__ void moe_build_ts(Frame& F) {
    LAS int* ts = (LAS int*)(F.lds + TS_OFF);
    if (F.tid == 0) { int acc = 0;
        for (int e = 0; e < 32; ++e) { ts[e] = acc; const unsigned n = __hip_atomic_load(F.ctl + CW_CNT + 64 * e, RLX_AGENT); acc += (int)((n + 255u) >> 8); }
        ts[32] = acc; }
    __syncthreads();
}
__device__ __forceinline__ void gather_phase(Frame& F) {
    moe_build_ts(F);
    const LAS int* ts = (const LAS int*)(F.lds + TS_OFF);
    const int gw = F.vcu * NWAVES + F.wave, NGW = F.G * NWAVES, l = F.lane;
    const bf16* H2 = (const bf16*)(F.ws + WS_H); const float* ROUTE = (const float*)(F.ws + WS_ROUTE); bf16* XG = (bf16*)(F.ws + WS_XG); float* ROWW = (float*)(F.ws + WS_ROWW); int* POS = (int*)(F.ws + WS_POS);
    for (int m = gw; m < M; m += NGW) {
        const f32x4 rt = *(const GAS f32x4*)(ROUTE + (size_t)m * 4);
        const int e0 = __float_as_int(rt.x), e1 = __float_as_int(rt.y);
        int p0 = 0, p1 = 0;
        if (l == 0) { p0 = ts[e0] * 256 + (int)atomicAdd((unsigned*)(F.ctl + CW_CUR + 64 * e0), 1u); p1 = ts[e1] * 256 + (int)atomicAdd((unsigned*)(F.ctl + CW_CUR + 64 * e1), 1u);
            ROWW[p0] = rt.z; ROWW[p1] = rt.w; POS[2 * m] = p0; POS[2 * m + 1] = p1; }
        p0 = __builtin_amdgcn_readfirstlane(p0); p1 = __builtin_amdgcn_readfirstlane(p1);
        const v4u a = *((const GAS v4u*)(H2 + (size_t)m * D) + l), bq = *((const GAS v4u*)(H2 + (size_t)m * D) + 64 + l);
        *((GAS v4u*)(XG + (size_t)p0 * D) + l) = a; *((GAS v4u*)(XG + (size_t)p0 * D) + 64 + l) = bq;
        *((GAS v4u*)(XG + (size_t)p1 * D) + l) = a; *((GAS v4u*)(XG + (size_t)p1 * D) + 64 + l) = bq;
    }
}
__device__ __forceinline__ void final_phase(Frame& F) {
    const int gw = F.vcu * NWAVES + F.wave, NGW = F.G * NWAVES, l = F.lane;
    const bf16* YG = (const bf16*)(F.ws + WS_YG); const int* POS = (const int*)(F.ws + WS_POS);
    f32x4 gn[4];
#pragma unroll
    for (int j = 0; j < 4; ++j) gn[j] = *((const GAS f32x4*)FIN(23) + l + 64 * j);
    for (int m = gw; m < M; m += NGW) {
        const int p0 = POS[2 * m], p1 = POS[2 * m + 1];
        GAS f32x4* xr = (GAS f32x4*)(F.out + (size_t)m * D) + l;
        const GAS v2u* y0 = (const GAS v2u*)(YG + (size_t)p0 * D) + l; const GAS v2u* y1 = (const GAS v2u*)(YG + (size_t)p1 * D) + l;
        f32x4 v[4]; float s2 = 0.f;
#pragma unroll
        for (int j = 0; j < 4; ++j) { const v2u a = y0[64 * j], bq = y1[64 * j]; v[j] = xr[64 * j];
            v[j].x += bflo(a.x) + bflo(bq.x); v[j].y += bfhi(a.x) + bfhi(bq.x); v[j].z += bflo(a.y) + bflo(bq.y); v[j].w += bfhi(a.y) + bfhi(bq.y);
            s2 += (v[j].x * v[j].x + v[j].y * v[j].y) + (v[j].z * v[j].z + v[j].w * v[j].w); }
        const float rstd = 1.f / sqrtf(wave_sum(s2) * (1.f / D) + EPS);
#pragma unroll
        for (int j = 0; j < 4; ++j) xr[64 * j] = v[j] * rstd * gn[j];
    }
}

__global__ void __launch_bounds__(NWAVES * 64, 2) mk_fwd(Args args) {
    extern __shared__ __attribute__((aligned(16))) unsigned char lds[];
    Frame F;
    F.lds = (LAS unsigned char*)lds;
    F.MISC = (volatile LAS unsigned*)(F.lds + MISC_OFF);
    F.tid = threadIdx.x; F.lane = F.tid & 63; F.wave = __builtin_amdgcn_readfirstlane(F.tid >> 6);
    F.G = gridDim.x; { const int bx = blockIdx.x; F.vcu = (F.G % 8 == 0) ? (bx % 8) * (F.G / 8) + bx / 8 : bx; }
    F.ws = args.ws; F.out = args.out; F.ctl = (gu32*)(args.ws + WS_CTL);
    F.ka = (const CAS Args*)__builtin_amdgcn_kernarg_segment_ptr();
    for (int u = F.tid; u < (LDS_BYTES - LDSCTL_OFF) / 4; u += NWAVES * 64) ((LAS unsigned*)(F.lds + LDSCTL_OFF))[u] = 0u;
    __syncthreads();
    XcdBarrier bar = xcd_barrier_post((unsigned*)(F.ctl + CW_BAR), F.MISC + 8);
    const int lo = args.ph_lo, hi = args.ph_hi;
#ifndef PHMASK
#define PHMASK 0x1fff
#endif
#define IN(k) (((PHMASK >> (k)) & 1) && lo <= (k) && (k) < hi)
#ifndef REPMASK
#define REPMASK 0
#endif
#define NREP(k) ((((REPMASK) >> (k)) & 1) ? 2 : 1)
#define SEAM(k) do { if (IN(k) && IN((k) + 1)) xcd_barrier(bar); } while (0)
    bf16* const WIN = (bf16*)(F.ws + WS_WIN); bf16* const Hb = (bf16*)(F.ws + WS_H);
    bf16* const Qb = (bf16*)(F.ws + WS_Q); bf16* const Kb = (bf16*)(F.ws + WS_K); bf16* const Vb = (bf16*)(F.ws + WS_V);
    bf16* const MA = (bf16*)F.out; bf16* const MB = MA + (size_t)M * 1024;

    if (IN(0)) for (int rep_ = 0; rep_ < NREP(0); ++rep_) { p0_prologue(F); } SEAM(0);
    if (IN(1)) for (int rep_ = 0; rep_ < NREP(1); ++rep_) {
        pg8::Gemm g{Hb, WIN, M, NPROJ, D}; pg8::StaticOrder S; S.init(M, NPROJ, F.G, (int)blockIdx.x);
        pg8::EpiProj E{Qb, Kb, Vb, (bf16*)(F.ws + WS_G), (bf16*)(F.ws + WS_GATE), MA, MB, attn_body::C2};
        pg8::gemm_phase<pg8::EpiProj, pg8::StaticOrder, PG8_ALIGN, PG8_SP2>(F.lds + RING_OFF, g, S, E);
    } SEAM(1);
    if (IN(2)) for (int rep_ = 0; rep_ < NREP(2); ++rep_) { gdn_a_phase(F); } SEAM(2);
    if (IN(4)) for (int rep_ = 0; rep_ < NREP(4); ++rep_) {
        gdn_b_phase(F);
        __syncthreads();
        const attn_body::AttnTensors AT{(const attn_body::bf16*)Qb, (const attn_body::bf16*)Kb, (const attn_body::bf16*)Vb, (attn_body::bf16*)Hb};
        const attn_body::DynOrder S{(unsigned*)(F.ctl + CW_AQ), (int)(blockIdx.x & 7), (volatile LAS int*)(F.lds + MISC_OFF + 64)};
        attn_body::attn_phase<attn_body::DynOrder>((char*)lds + RING_OFF, AT, S);
    } SEAM(4);
    if (IN(5)) for (int rep_ = 0; rep_ < NREP(5); ++rep_) { gdn_c_phase(F); ya_phase(F); __syncthreads(); moe_weights_phase(F); } SEAM(5);
    if (IN(6)) for (int rep_ = 0; rep_ < NREP(6); ++rep_) {
        { pg8::Gemm g{Qb, (bf16*)(F.ws + WS_WA), M, D, 512}; pg8::StaticOrder S; S.init(M, D, F.G, (int)blockIdx.x);
          pg8::EpiMerge<0> E{MA, Hb}; pg8::gemm_phase<pg8::EpiMerge<0>, pg8::StaticOrder, PG8_ALIGN, PG8_SP2>(F.lds + RING_OFF, g, S, E); }
        __syncthreads();
        { pg8::Gemm g{Kb, (bf16*)(F.ws + WS_WB), M, D, 512}; pg8::StaticOrder S; S.init(M, D, F.G, (int)blockIdx.x);
          pg8::EpiMerge<1> E{MB, Hb}; pg8::gemm_phase<pg8::EpiMerge<1>, pg8::StaticOrder, PG8_ALIGN, PG8_SP2>(F.lds + RING_OFF, g, S, E); }
    } SEAM(6);
    if (IN(7)) for (int rep_ = 0; rep_ < NREP(7); ++rep_) {
        pg8::Gemm g{Hb, (bf16*)(F.ws + WS_WOUT), M, D, D}; pg8::StaticOrder S; S.init(M, D, F.G, (int)blockIdx.x);
        pg8::EpiRes E{FIN(0), F.out}; pg8::gemm_phase<pg8::EpiRes, pg8::StaticOrder, PG8_ALIGN, PG8_SP2>(F.lds + RING_OFF, g, S, E);
    } SEAM(7);
    if (IN(8)) for (int rep_ = 0; rep_ < NREP(8); ++rep_) { router_phase(F, rep_ == 0); } SEAM(8);
    if (IN(9)) for (int rep_ = 0; rep_ < NREP(9); ++rep_) { gather_phase(F); } SEAM(9);
    if (IN(10)) for (int rep_ = 0; rep_ < NREP(10); ++rep_) {
        moe_build_ts(F);
        pg8::Gemm g{(bf16*)(F.ws + WS_XG), (bf16*)(F.ws + WS_GU), XG_ROWS, NE * 512, D};
        pg8::MoeOrder S{(const LAS int*)(F.lds + TS_OFF), 2, F.G, (int)blockIdx.x};
        pg8::EpiAct E{(bf16*)(F.ws + WS_ACT), (const float*)(F.ws + WS_ROWW)};
        pg8::gemm_phase<pg8::EpiAct, pg8::MoeOrder, PG8_ALIGN, PG8_SP2>(F.lds + RING_OFF, g, S, E);
    } SEAM(10);
    if (IN(11)) for (int rep_ = 0; rep_ < NREP(11); ++rep_) {
        moe_build_ts(F);
        int Kd = FH; asm volatile("" : "+s"(Kd));
        pg8::Gemm g{(bf16*)(F.ws + WS_ACT), (bf16*)(F.ws + WS_DN), XG_ROWS, NE * 1024, Kd};
        pg8::MoeOrder S{(const LAS int*)(F.lds + TS_OFF), 4, F.G, (int)blockIdx.x};
        pg8::EpiStore E{(bf16*)(F.ws + WS_YG), 1024, 3};
        pg8::gemm_phase<pg8::EpiStore, pg8::MoeOrder, PG8_ALIGN, PG8_SP2>(F.lds + RING_OFF, g, S, E);
    } SEAM(11);
    if (IN(12)) for (int rep_ = 0; rep_ < NREP(12); ++rep_) { final_phase(F); }
#undef IN
#undef SEAM
}

#ifndef MK_N_LAUNCHES
#define MK_N_LAUNCHES 1
#endif
extern "C" void kernel_launch(void* const* d_in, const int* in_sizes, int n_in, void* d_out, int out_size, void* d_ws, size_t ws_size, hipStream_t stream) {
    static int grid = 0;
    if (grid == 0) {
        if (n_in != 24 || in_sizes[0] != M * D || out_size != M * D || ws_size < WS_END) { fprintf(stderr, "kernel_launch: unexpected shapes (n_in %d, in0 %d, out %d, ws %zu)\n", n_in, n_in > 0 ? in_sizes[0] : -1, out_size, ws_size); grid = -1; return; }
        int dev = 0, cus = 0, per_cu = 0;
        if (hipGetDevice(&dev) != hipSuccess || hipDeviceGetAttribute(&cus, hipDeviceAttributeMultiprocessorCount, dev) != hipSuccess) { grid = -1; return; }
        if (hipFuncSetAttribute((const void*)mk_fwd, hipFuncAttributeMaxDynamicSharedMemorySize, LDS_BYTES) != hipSuccess) { fprintf(stderr, "kernel_launch: hipFuncSetAttribute failed\n"); grid = -1; return; }
        if (hipOccupancyMaxActiveBlocksPerMultiprocessor(&per_cu, (const void*)mk_fwd, NWAVES * 64, LDS_BYTES) != hipSuccess || per_cu < 1) { fprintf(stderr, "kernel_launch: occupancy query says %d blocks per CU\n", per_cu); per_cu = 1; }
        (void)hipGetLastError();
        grid = cus;
        if (grid != 256) fprintf(stderr, "kernel_launch: %d CUs (built for 256)\n", grid);
    }
    if (grid < 0) return;
    if (hipMemsetAsync((char*)d_ws + WS_CTL, 0, CTL_ZERO_BYTES, stream) != hipSuccess) return;
    Args a{};
    for (int i = 0; i < 24; ++i) a.in[i] = (const float*)d_in[i];
    a.out = (float*)d_out; a.ws = (unsigned char*)d_ws;
#if MK_N_LAUNCHES == 1
    a.ph_lo = 0; a.ph_hi = N_PHASES;
    hipLaunchKernelGGL(mk_fwd, dim3(grid), dim3(NWAVES * 64), LDS_BYTES, stream, a);
#else
    for (int p = 0; p < N_PHASES; ++p) { a.ph_lo = p; a.ph_hi = p + 1; hipLaunchKernelGGL(mk_fwd, dim3(grid), dim3(NWAVES * 64), LDS_BYTES, stream, a); }
#endif
}
```

```cpp
#include <hip/hip_runtime.h>
#include <cstdio>
#include <cstdint>
namespace pg8 {
#define PG8_LAS __attribute__((address_space(3)))
typedef unsigned short bf16_t;
typedef short bf16x8 __attribute__((ext_vector_type(8)));
typedef float f32x4 __attribute__((ext_vector_type(4)));
typedef unsigned u32x4 __attribute__((ext_vector_type(4)));
constexpr int BM = 256, BK = 64, HALF = 128, HTB = HALF * BK * 2  , STAGE_BYTES = 8 * HTB, NXCD = 8, WGM = 8;

__host__ __device__ __forceinline__ int lds_byte(int r, int c) { const int st = (r >> 4) * 2 + (c >> 5), rr = r & 15, cc = c & 31, ob = rr * 64 + cc * 2; return st * 1024 + (ob ^ (((ob >> 9) & 1) << 5)); }
__host__ __device__ __forceinline__ void stage_rc(int b, int& R, int& C) { const int st = b / 1024, sb = b % 1024, swz = sb ^ (((sb >> 9) & 1) << 5); R = (st >> 1) * 16 + swz / 64; C = (st & 1) * 32 + (swz % 64) / 2; }
__host__ __device__ __forceinline__ int perm32(int rho) { const int n = rho >> 4, i = rho & 15; return 8 * (i >> 2) + 4 * n + (i & 3); }

struct Unit { int pm, pn; };
struct Gemm { const bf16_t* A; const bf16_t* Bt; int M, N, K; };

struct StaticOrder {
    int nM, nN, nwg, G, c;
    __host__ __device__ void init(int M, int N, int G_, int c_) { nM = M / BM; nN = N / BM; nwg = nM * nN; G = G_; c = c_; }
    __host__ __device__ bool next(int i, Unit& u) const {
        const long L = (long)i * G + c; if (L >= nwg) return false;
        int wgid = (int)L; { const int q = nwg / NXCD, r = nwg % NXCD, xcd = wgid % NXCD, off = wgid / NXCD; wgid = (xcd < r ? xcd * (q + 1) : r * (q + 1) + (xcd - r) * q) + off; }
        const int nig = WGM * nN, gid = wgid / nig, fm = gid * WGM, gsz = (nM - fm) < WGM ? (nM - fm) : WGM;
        u.pm = fm + ((wgid % nig) % gsz); u.pn = (wgid % nig) / gsz; return true;
    }
    __device__ __forceinline__ void a_ready(const Unit&) const {}
    __device__ __forceinline__ void done(const Unit&) const {}
};

__device__ __forceinline__ unsigned cvt_pk_bf16(float lo, float hi) { unsigned r; asm volatile("v_cvt_pk_bf16_f32 %0, %1, %2" : "=v"(r) : "v"(lo), "v"(hi)); return r; }
typedef unsigned u32x2 __attribute__((ext_vector_type(2)));
__device__ __forceinline__ float bf_lo(unsigned w) { return __uint_as_float(w << 16); }
__device__ __forceinline__ float bf_hi(unsigned w) { return __uint_as_float(w & 0xffff0000u); }
__device__ __forceinline__ float sigmoid_f(float x) { return __builtin_amdgcn_rcpf(1.0f + __expf(-x)); }
__device__ __forceinline__ float silu_f(float x) { return x * sigmoid_f(x); }
__device__ __forceinline__ u32x4 pack8(const f32x4& v0, const f32x4& v1) { u32x4 w; w.x = cvt_pk_bf16(v0[0], v0[1]); w.y = cvt_pk_bf16(v0[2], v0[3]); w.z = cvt_pk_bf16(v1[0], v1[1]); w.w = cvt_pk_bf16(v1[2], v1[3]); return w; }

struct EpiProj {
    static constexpr bool PERM = true, AFTER_DRAIN = false;
    bf16_t *Q, *Kb, *V, *G, *GATE, *MA, *MB; float qscale;
    __device__ __forceinline__ void operator()(const f32x4 (&acc)[2][2][4][2], const Unit& u, int wr, int wc, int fr, int fq) const {
        const int pn = u.pn; bf16_t* base; int ldc, colt; float sc = 1.f; bool sg = false;
        if (pn < 2) { base = Q; ldc = 512; colt = pn * 256; sc = qscale; }
        else if (pn < 4) { base = Kb; ldc = 512; colt = (pn - 2) * 256; }
        else if (pn < 6) { base = V; ldc = 512; colt = (pn - 4) * 256; }
        else if (pn < 12) { base = G; ldc = 1536; colt = (pn - 6) * 256; }
        else if (pn < 14) { base = GATE; ldc = 512; colt = (pn - 12) * 256; }
        else if (pn < 18) { base = MA; ldc = 1024; colt = (pn - 14) * 256; sg = true; }
        else { base = MB; ldc = 1024; colt = (pn - 18) * 256; sg = true; }
        const int row0 = u.pm * BM + wr * 64 + fr, col0 = colt + wc * 32 + 8 * fq;
#pragma unroll
        for (int ai = 0; ai < 2; ++ai)
#pragma unroll
            for (int m = 0; m < 4; ++m) { bf16_t* rowp = base + (size_t)(row0 + ai * HALF + m * 16) * ldc + col0;
#pragma unroll
                for (int bj = 0; bj < 2; ++bj) { f32x4 v0 = acc[ai][bj][m][0], v1 = acc[ai][bj][m][1];
                    if (sg) {
#pragma unroll
                        for (int i = 0; i < 4; ++i) { v0[i] = sigmoid_f(v0[i]); v1[i] = sigmoid_f(v1[i]); }
                    } else { v0 = v0 * sc; v1 = v1 * sc; }
                    *(u32x4*)(rowp + bj * HALF) = pack8(v0, v1); } }
    }
};
template <int PASS> struct EpiMerge {
    static constexpr bool PERM = true, AFTER_DRAIN = false;
    const bf16_t* Gt; bf16_t* O;
    __device__ __forceinline__ void operator()(const f32x4 (&acc)[2][2][4][2], const Unit& u, int wr, int wc, int fr, int fq) const {
        const int row0 = u.pm * BM + wr * 64 + fr, col0 = u.pn * BM + wc * 32 + 8 * fq;
#pragma unroll
        for (int ai = 0; ai < 2; ++ai)
#pragma unroll
            for (int m = 0; m < 4; ++m) { const size_t off = (size_t)(row0 + ai * HALF + m * 16) * 1024 + col0;
#pragma unroll
                for (int bj = 0; bj < 2; ++bj) { const u32x4 g = *(const u32x4*)(Gt + off + bj * HALF);
                    f32x4 v0 = acc[ai][bj][m][0], v1 = acc[ai][bj][m][1];
                    v0[0] *= bf_lo(g.x); v0[1] *= bf_hi(g.x); v0[2] *= bf_lo(g.y); v0[3] *= bf_hi(g.y);
                    v1[0] *= bf_lo(g.z); v1[1] *= bf_hi(g.z); v1[2] *= bf_lo(g.w); v1[3] *= bf_hi(g.w);
                    if (PASS) { const u32x4 p = *(const u32x4*)(O + off + bj * HALF);
                        v0[0] += bf_lo(p.x); v0[1] += bf_hi(p.x); v0[2] += bf_lo(p.y); v0[3] += bf_hi(p.y);
                        v1[0] += bf_lo(p.z); v1[1] += bf_hi(p.z); v1[2] += bf_lo(p.w); v1[3] += bf_hi(p.w); }
                    *(u32x4*)(O + off + bj * HALF) = pack8(v0, v1); } }
    }
};
struct EpiRes {
    static constexpr bool PERM = false, AFTER_DRAIN = false;
    const float* base; float* out;
    __device__ __forceinline__ void operator()(const f32x4 (&acc)[2][2][4][2], const Unit& u, int wr, int wc, int fr, int fq) const {
        const int row0 = u.pm * BM + wr * 64 + fr, col0 = u.pn * BM + wc * 32 + 4 * fq;
#pragma unroll
        for (int ai = 0; ai < 2; ++ai)
#pragma unroll
            for (int m = 0; m < 4; ++m) { const size_t off = (size_t)(row0 + ai * HALF + m * 16) * 1024 + col0;
#pragma unroll
                for (int bj = 0; bj < 2; ++bj)
#pragma unroll
                    for (int n = 0; n < 2; ++n) { const size_t p = off + bj * HALF + n * 16; *(f32x4*)(out + p) = *(const f32x4*)(base + p) + acc[ai][bj][m][n]; } }
    }
};
struct EpiAct {
    static constexpr bool PERM = true, AFTER_DRAIN = false;
    bf16_t* ACT; const float* roww;
    __device__ __forceinline__ void operator()(const f32x4 (&acc)[2][2][4][2], const Unit& u, int wr, int wc, int fr, int fq) const {
        const int row0 = u.pm * BM + wr * 64 + fr, col0 = (u.pn & 1) * 128 + wc * 32 + 8 * fq;
#pragma unroll
        for (int ai = 0; ai < 2; ++ai)
#pragma unroll
            for (int m = 0; m < 4; ++m) { const int row = row0 + ai * HALF + m * 16; const float w = roww[row];
                f32x4 v0, v1;
#pragma unroll
                for (int i = 0; i < 4; ++i) { v0[i] = silu_f(acc[ai][0][m][0][i]) * acc[ai][1][m][0][i] * w; v1[i] = silu_f(acc[ai][0][m][1][i]) * acc[ai][1][m][1][i] * w; }
                *(u32x4*)(ACT + (size_t)row * 256 + col0) = pack8(v0, v1); }
    }
};
struct EpiStore {
    static constexpr bool PERM = true, AFTER_DRAIN = false;
    bf16_t* O; int ldc, pn_mask;
    __device__ __forceinline__ void operator()(const f32x4 (&acc)[2][2][4][2], const Unit& u, int wr, int wc, int fr, int fq) const {
        const int row0 = u.pm * BM + wr * 64 + fr, col0 = (u.pn & pn_mask) * BM + wc * 32 + 8 * fq;
#pragma unroll
        for (int ai = 0; ai < 2; ++ai)
#pragma unroll
            for (int m = 0; m < 4; ++m) { bf16_t* rowp = O + (size_t)(row0 + ai * HALF + m * 16) * ldc + col0;
#pragma unroll
                for (int bj = 0; bj < 2; ++bj) *(u32x4*)(rowp + bj * HALF) = pack8(acc[ai][bj][m][0], acc[ai][bj][m][1]); }
    }
};
struct MoeOrder {
    const PG8_LAS int* ts; int NPN, G, c, e_split, e_shift;
    __device__ __forceinline__ bool next(int i, Unit& u) const {
        const int L = i * G + c, ntl = __builtin_amdgcn_readfirstlane(ts[32]);
        if (L >= ntl * NPN) return false;
        const int rt = L / NPN, pl = L - rt * NPN; int e = 0;
#pragma unroll
        for (int k = 1; k < 32; ++k) e += (ts[k] <= rt) ? 1 : 0;
        u.pm = __builtin_amdgcn_readfirstlane(rt); u.pn = __builtin_amdgcn_readfirstlane((e < e_split ? e : e + e_shift) * NPN + pl); return true;
    }
    __device__ __forceinline__ void a_ready(const Unit&) const {}
    __device__ __forceinline__ void done(const Unit&) const {}
};

template <class Epi, class Sched, bool ALIGN_EPI = false, bool SP2 = false>
__device__ __forceinline__ void gemm_phase(PG8_LAS unsigned char* lds, const Gemm g, const Sched& S, const Epi& E) {
    const int tid = threadIdx.x, wid = __builtin_amdgcn_readfirstlane(tid >> 6), lane = tid & 63, wr = wid >> 2, wc = wid & 3, fr = lane & 15, fq = lane >> 4;
    const int K = g.K, nt = K / BK;
    unsigned voffA[2], voffB[2];
#pragma unroll
    for (int i = 0; i < 2; ++i) { int R, C; stage_rc(tid * 16 + i * 8192, R, C); const int Rb = Epi::PERM ? ((R & ~31) + perm32(R & 31)) : R;
        voffA[i] = (unsigned)(R * K + C) * 2u; voffB[i] = (unsigned)(Rb * K + C) * 2u; }
    const size_t kstep = (size_t)(BK * 2);
    const size_t hstep = (size_t)HALF * K * 2;
    const size_t tstep = 2 * hstep;
    const unsigned ldsw = (unsigned)wid * 1024u;
    const int aoff = lds_byte(wr * 64 + fr, fq * 8), boff = lds_byte(wc * 32 + fr, fq * 8);
#define PG8_SA(b, h) (((b) * 2 + (h)) * HTB)
#define PG8_SB(b, h) ((4 + (b) * 2 + (h)) * HTB)
#define PG8_STAGE(bufoff, gbase, voff) do { _Pragma("unroll") for (int _i = 0; _i < 2; ++_i) \
        __builtin_amdgcn_global_load_lds((const unsigned*)((const char*)(gbase) + (voff)[_i]), (PG8_LAS unsigned*)(lds + (bufoff) + ldsw + _i * 8192), 16, 0, 0); } while (0)
#define PG8_LDA(dst, b, h) do { _Pragma("unroll") for (int m = 0; m < 4; ++m) _Pragma("unroll") for (int k = 0; k < 2; ++k) dst[m][k] = *(const PG8_LAS bf16x8*)(lds + PG8_SA(b, h) + aoff + m * 2048 + k * 1024); } while (0)
#define PG8_LDB(dst, b, h) do { _Pragma("unroll") for (int n = 0; n < 2; ++n) _Pragma("unroll") for (int k = 0; k < 2; ++k) dst[n][k] = *(const PG8_LAS bf16x8*)(lds + PG8_SB(b, h) + boff + n * 2048 + k * 1024); } while (0)
#define PG8_MMA(ai, bj, At, Bt) do { __builtin_amdgcn_s_setprio(1); _Pragma("unroll") for (int m = 0; m < 4; ++m) _Pragma("unroll") for (int n = 0; n < 2; ++n) _Pragma("unroll") for (int k = 0; k < 2; ++k) \
        acc[ai][bj][m][n] = __builtin_amdgcn_mfma_f32_16x16x32_bf16(Bt[n][k], At[m][k], acc[ai][bj][m][n], 0, 0, 0); __builtin_amdgcn_s_setprio(0); } while (0)
#define PG8_WAIT_V(n) asm volatile("s_waitcnt vmcnt(" #n ")" ::: "memory")
#define PG8_WAIT_L(n) asm volatile("s_waitcnt lgkmcnt(" #n ")" ::: "memory")
#define PG8_BAR __builtin_amdgcn_s_barrier()
#define PG8_SCHED __builtin_amdgcn_sched_barrier(0)
    Unit cur, nxt; int ui = 0;
    if (!S.next(0, cur)) return;
    f32x4 acc[2][2][4][2];
#pragma unroll
    for (int a = 0; a < 2; ++a)
#pragma unroll
        for (int b = 0; b < 2; ++b)
#pragma unroll
            for (int m = 0; m < 4; ++m)
#pragma unroll
                for (int n = 0; n < 2; ++n) acc[a][b][m][n] = (f32x4){0.f, 0.f, 0.f, 0.f};
    bf16x8 At[4][2], B0[2][2], B1[2][2];
    const char* cA = (const char*)g.A + (size_t)cur.pm * tstep; const char* cB = (const char*)g.Bt + (size_t)cur.pn * tstep;
    S.a_ready(cur);
    if constexpr (SP2) {
        PG8_STAGE(PG8_SB(0, 0), cB, voffB); PG8_STAGE(PG8_SB(0, 1), cB + hstep, voffB); PG8_STAGE(PG8_SA(0, 0), cA, voffA); PG8_STAGE(PG8_SA(0, 1), cA + hstep, voffA);
        if (wr == 1) PG8_BAR;
        PG8_WAIT_V(2); PG8_BAR;
        PG8_STAGE(PG8_SB(1, 0), cB + kstep, voffB); PG8_STAGE(PG8_SA(1, 0), cA + kstep, voffA); PG8_STAGE(PG8_SB(1, 1), cB + hstep + kstep, voffB);
        PG8_WAIT_V(6); PG8_BAR;
    } else {
        PG8_STAGE(PG8_SB(0, 0), cB, voffB); PG8_STAGE(PG8_SA(0, 0), cA, voffA); PG8_STAGE(PG8_SB(0, 1), cB + hstep, voffB); PG8_STAGE(PG8_SA(0, 1), cA + hstep, voffA);
        if (wr == 1) PG8_BAR;
        PG8_WAIT_V(4); PG8_BAR;
        PG8_STAGE(PG8_SB(1, 0), cB + kstep, voffB); PG8_STAGE(PG8_SA(1, 0), cA + kstep, voffA); PG8_STAGE(PG8_SB(1, 1), cB + hstep + kstep, voffB);
        PG8_WAIT_V(6); PG8_BAR;
    }
    for (;;) {
        const bool has_next = S.next(ui + 1, nxt);
        const char* nA = has_next ? (const char*)g.A + (size_t)nxt.pm * tstep : cA; const char* nB = has_next ? (const char*)g.Bt + (size_t)nxt.pn * tstep : cB;
        for (int t = 0; t < nt; t += 2) {
            const bool last = (t == nt - 2);
            const char* a1 = cA + (size_t)(t + 1) * kstep;
            const char* a2 = last ? nA : cA + (size_t)(t + 2) * kstep; const char* b2 = last ? nB : cB + (size_t)(t + 2) * kstep;
            const char* a3 = a2 + kstep; const char* b3 = b2 + kstep;
            if (last && has_next) S.a_ready(nxt);
            if constexpr (SP2) {
            PG8_LDB(B0, 0, 0); PG8_LDB(B1, 0, 1); PG8_SCHED; PG8_LDA(At, 0, 0); PG8_STAGE(PG8_SA(1, 1), a1 + hstep, voffA);
            PG8_WAIT_V(8); PG8_WAIT_L(0); PG8_BAR; PG8_MMA(0, 0, At, B0); PG8_MMA(0, 1, At, B1); PG8_BAR; PG8_SCHED;
            PG8_LDA(At, 0, 1); PG8_STAGE(PG8_SB(0, 0), b2, voffB); PG8_STAGE(PG8_SB(0, 1), b2 + hstep, voffB); PG8_STAGE(PG8_SA(0, 0), a2, voffA);
            PG8_WAIT_V(8); PG8_WAIT_L(0); PG8_BAR; PG8_MMA(1, 0, At, B0); PG8_MMA(1, 1, At, B1); PG8_BAR; PG8_SCHED;
            PG8_LDB(B0, 1, 0); PG8_LDB(B1, 1, 1); PG8_SCHED; PG8_LDA(At, 1, 0); PG8_STAGE(PG8_SA(0, 1), a2 + hstep, voffA);
            PG8_WAIT_V(8); PG8_WAIT_L(0); PG8_BAR; PG8_MMA(0, 0, At, B0); PG8_MMA(0, 1, At, B1); PG8_BAR; PG8_SCHED;
            PG8_LDA(At, 1, 1); PG8_STAGE(PG8_SB(1, 0), b3, voffB); PG8_STAGE(PG8_SB(1, 1), b3 + hstep, voffB); PG8_STAGE(PG8_SA(1, 0), a3, voffA);
            PG8_WAIT_V(8); PG8_WAIT_L(0); PG8_BAR; PG8_MMA(1, 0, At, B0); PG8_MMA(1, 1, At, B1); PG8_BAR; PG8_SCHED;
            } else {
            PG8_LDB(B0, 0, 0); PG8_SCHED; PG8_LDA(At, 0, 0); PG8_STAGE(PG8_SA(1, 1), a1 + hstep, voffA);
            PG8_WAIT_L(8); PG8_BAR; PG8_WAIT_L(0); PG8_MMA(0, 0, At, B0); PG8_BAR; PG8_SCHED;
            PG8_LDB(B1, 0, 1); PG8_STAGE(PG8_SB(0, 0), b2, voffB);
            PG8_BAR; PG8_WAIT_L(0); PG8_MMA(0, 1, At, B1); PG8_BAR;
            PG8_LDA(At, 0, 1); PG8_STAGE(PG8_SA(0, 0), a2, voffA);
            PG8_BAR; PG8_WAIT_L(0); PG8_MMA(1, 0, At, B0); PG8_BAR; PG8_SCHED;
            PG8_STAGE(PG8_SB(0, 1), b2 + hstep, voffB);
            PG8_WAIT_V(6); PG8_BAR; PG8_MMA(1, 1, At, B1); PG8_BAR;
            PG8_LDB(B0, 1, 0); PG8_SCHED; PG8_LDA(At, 1, 0); PG8_STAGE(PG8_SA(0, 1), a2 + hstep, voffA);
            PG8_WAIT_L(8); PG8_BAR; PG8_WAIT_L(0); PG8_MMA(0, 0, At, B0); PG8_BAR; PG8_SCHED;
            PG8_LDB(B1, 1, 1); PG8_STAGE(PG8_SB(1, 0), b3, voffB);
            PG8_BAR; PG8_WAIT_L(0); PG8_MMA(0, 1, At, B1); PG8_BAR;
            PG8_LDA(At, 1, 1); PG8_STAGE(PG8_SA(1, 0), a3, voffA);
            PG8_BAR; PG8_WAIT_L(0); PG8_MMA(1, 0, At, B0); PG8_BAR; PG8_SCHED;
            PG8_STAGE(PG8_SB(1, 1), b3 + hstep, voffB);
            PG8_WAIT_V(6); PG8_BAR; PG8_MMA(1, 1, At, B1); PG8_BAR;
            }
        }
        if constexpr (ALIGN_EPI) { if (wr == 0) PG8_BAR; }
        if constexpr (!Epi::AFTER_DRAIN) { E(acc, cur, wr, wc, fr, fq); S.done(cur); }
        if (!has_next) break;
#pragma unroll
        for (int a = 0; a < 2; ++a)
#pragma unroll
            for (int b = 0; b < 2; ++b)
#pragma unroll
                for (int m = 0; m < 4; ++m)
#pragma unroll
                    for (int n = 0; n < 2; ++n) acc[a][b][m][n] = (f32x4){0.f, 0.f, 0.f, 0.f};
        cur = nxt; cA = nA; cB = nB; ++ui;
        if constexpr (ALIGN_EPI) { if (wr == 1) PG8_BAR; }
    }
    PG8_WAIT_V(0);
    if constexpr (!ALIGN_EPI) { if (wr == 0) PG8_BAR; }
    PG8_BAR;
    if constexpr (Epi::AFTER_DRAIN) { E.fused(acc, cur, wr, wc, fr, fq, lds, wid, lane); S.done(cur); }
#undef PG8_SA
#undef PG8_SB
#undef PG8_STAGE
#undef PG8_LDA
#undef PG8_LDB
#undef PG8_MMA
#undef PG8_WAIT_V
#undef PG8_WAIT_L
#undef PG8_BAR
#undef PG8_SCHED
}
}

#ifndef PG8_SP2
#define PG8_SP2 true
#endif
#ifndef PG8_ALIGN
#define PG8_ALIGN true
#endif
#include <hip/hip_bf16.h>
#include <cmath>
namespace attn_body {
using bf16=__hip_bfloat16;
using bf16x8=__attribute__((ext_vector_type(8)))short;
using s16x4=__attribute__((ext_vector_type(4)))short;
using f32x16=__attribute__((ext_vector_type(16)))float;
using u32x4=__attribute__((ext_vector_type(4)))unsigned;
constexpr int BATCH=2,NHEAD=16,SEQ=8192,D=64,DM=NHEAD*D,QP=512;
constexpr int NW=8,QBLK=32,QB=QBLK*NW,KVBLK=64,NQB=SEQ/QB;
constexpr int ATTN_PITCH=DM, ATTN_UNIT_ROWS=QB;
__device__ __forceinline__ int crow(int r,int hi){return (r&3)+8*(r>>2)+4*hi;}
#define SBAR() __builtin_amdgcn_sched_barrier(0)
__device__ __forceinline__ void cmask(f32x16&p0,f32x16&p1,int jb,int qrel,int hi){
  const float NEG=-INFINITY; (void)hi;
  if(jb>(qrel>>6)){
  #pragma unroll
  for(int r=0;r<16;++r){p0[r]=NEG;p1[r]=NEG;} }
}

constexpr int NSLOT=3, SLOTB=8192;
constexpr int LDS_K=0, LDS_V=NSLOT*SLOTB, LDS_WS=2*NSLOT*SLOTB, LDS_OST=LDS_WS+NW*64*4, LDS_BYTES=LDS_OST+NW*4096;
constexpr float C2=0.125f*1.4426950408889634f;
__device__ __forceinline__ void glds16(const void*gsrc,unsigned lds_dst){unsigned keep;
  asm volatile("s_mov_b32 %0, m0\n\ts_mov_b32 m0, %2\n\ts_nop 0\n\tglobal_load_lds_dwordx4 %1, off\n\ts_mov_b32 m0, %0":"=&s"(keep):"v"(gsrc),"s"(lds_dst):"memory");}
__device__ __forceinline__ float max3f(float a,float b,float c){float r;asm("v_max3_f32 %0, %1, %2, %3":"=v"(r):"v"(a),"v"(b),"v"(c));return r;}
__device__ __forceinline__ float max2f(float a,float b){float r;asm("v_max_f32_e32 %0, %1, %2":"=v"(r):"v"(a),"v"(b));return r;}
__device__ __forceinline__ float fadd_s(float a,float b){float r;asm("v_add_f32_e32 %0, %1, %2":"=v"(r):"v"(a),"v"(b));return r;}
__device__ __forceinline__ float fsub_s(float a,float b){float r;asm("v_sub_f32_e32 %0, %1, %2":"=v"(r):"v"(a),"v"(b));return r;}
typedef float f32x2_t __attribute__((ext_vector_type(2))); typedef __bf16 bf16x2_t __attribute__((ext_vector_type(2)));
__device__ __forceinline__ unsigned cvtpk_s(float lo,float hi){f32x2_t v={lo,hi};bf16x2_t b=__builtin_convertvector(v,bf16x2_t);return __builtin_bit_cast(unsigned,b);}
#define WAIT_BAR(N) asm volatile("s_waitcnt vmcnt(" #N ") lgkmcnt(0)\n\ts_barrier":::"memory")

__device__ __forceinline__ void qkt(f32x16&p0,f32x16&p1,const char*Kslot,const bf16x8*qr,const f32x16&negm,int r32,int hi){
  const char*kb=Kslot+hi*1024+r32*16;
  #pragma unroll
  for(int d0=0;d0<4;++d0){
    const bf16x8 b0=*reinterpret_cast<const bf16x8*>(kb+d0*2048);
    const bf16x8 b1=*reinterpret_cast<const bf16x8*>(kb+d0*2048+512);
    if(d0==0){p0=__builtin_amdgcn_mfma_f32_32x32x16_bf16(b0,qr[0],negm,0,0,0);p1=__builtin_amdgcn_mfma_f32_32x32x16_bf16(b1,qr[0],negm,0,0,0);}
    else{p0=__builtin_amdgcn_mfma_f32_32x32x16_bf16(b0,qr[d0],p0,0,0,0);p1=__builtin_amdgcn_mfma_f32_32x32x16_bf16(b1,qr[d0],p1,0,0,0);}}
}
typedef __attribute__((address_space(3))) const char* lds_cptr;
typedef short v4i16_t __attribute__((ext_vector_type(4)));
__device__ __forceinline__ void kload8(bf16x8*kf,lds_cptr kp){
  kf[0]=*(const __attribute__((address_space(3))) bf16x8*)(kp);      kf[1]=*(const __attribute__((address_space(3))) bf16x8*)(kp+512);
  kf[2]=*(const __attribute__((address_space(3))) bf16x8*)(kp+2048); kf[3]=*(const __attribute__((address_space(3))) bf16x8*)(kp+2560);
  kf[4]=*(const __attribute__((address_space(3))) bf16x8*)(kp+4096); kf[5]=*(const __attribute__((address_space(3))) bf16x8*)(kp+4608);
  kf[6]=*(const __attribute__((address_space(3))) bf16x8*)(kp+6144); kf[7]=*(const __attribute__((address_space(3))) bf16x8*)(kp+6656);
}
__device__ __forceinline__ void kload2(bf16x8*kf,lds_cptr kp,int j){ kf[2*j]=*(const __attribute__((address_space(3))) bf16x8*)(kp+j*2048); kf[2*j+1]=*(const __attribute__((address_space(3))) bf16x8*)(kp+j*2048+512); }
__device__ __forceinline__ s16x4 vtr(lds_cptr p){ return __builtin_bit_cast(s16x4,__builtin_amdgcn_ds_read_tr16_b64_v4i16((__attribute__((address_space(3))) v4i16_t*)p)); }
__device__ __forceinline__ float rowmax(const f32x16&p0,const f32x16&p1){
  float a=max3f(p0[0],p0[1],p1[0]),b=max3f(p0[2],p0[3],p1[1]);a=max3f(a,p1[2],p1[3]);
  #pragma unroll
  for(int r=4;r<16;r+=4){a=max3f(a,p0[r],p0[r+1]);b=max3f(b,p0[r+2],p0[r+3]);a=max3f(a,p1[r],p1[r+1]);b=max3f(b,p1[r+2],p1[r+3]);}
  const float m=max2f(a,b);
  auto rr=__builtin_amdgcn_permlane32_swap(__float_as_uint(m),__float_as_uint(m),false,false);
  return max2f(__uint_as_float(rr[0]),__uint_as_float(rr[1]));
}
__device__ __forceinline__ void pv(f32x16*o,int vb,bf16x8 pa0,bf16x8 pa1,bf16x8 pa2,bf16x8 pa3){
  #pragma unroll
  for(int d0=0;d0<2;++d0){s16x4 lo[4],hi[4];
    #pragma unroll
    for(int ks=0;ks<4;++ks){
      asm volatile("ds_read_b64_tr_b16 %0,%1 offset:%c2":"=&v"(lo[ks]):"v"(vb),"i"(d0*4096+ks*1024):"memory");
      asm volatile("ds_read_b64_tr_b16 %0,%1 offset:%c2":"=&v"(hi[ks]):"v"(vb),"i"(d0*4096+ks*1024+512):"memory");}
    asm volatile("s_waitcnt lgkmcnt(0)":::"memory");SBAR();
    #define PK(k) (bf16x8){lo[k][0],lo[k][1],lo[k][2],lo[k][3],hi[k][0],hi[k][1],hi[k][2],hi[k][3]}
    o[d0]=__builtin_amdgcn_mfma_f32_32x32x16_bf16(pa0,PK(0),o[d0],0,0,0);
    o[d0]=__builtin_amdgcn_mfma_f32_32x32x16_bf16(pa1,PK(1),o[d0],0,0,0);
    o[d0]=__builtin_amdgcn_mfma_f32_32x32x16_bf16(pa2,PK(2),o[d0],0,0,0);
    o[d0]=__builtin_amdgcn_mfma_f32_32x32x16_bf16(pa3,PK(3),o[d0],0,0,0);
    #undef PK
  }
}

#ifndef ATTN_STORE16
#define ATTN_STORE16(p,v) (*(u32x4*)(p)=(v))
#endif
template<int THRL> __device__ __forceinline__ void attn_unit(int b,int qcol,int vcol,int ocol,int qb,const bf16*Q,const bf16*__restrict__ K,const bf16*__restrict__ V,bf16*O,char*shm){
  const int tid=threadIdx.x,lane=tid&63,r32=lane&31,hi=lane>>5; const int wid=__builtin_amdgcn_readfirstlane(tid>>6);
  const long rowbase=(long)b*SEQ; const int q0=qb*QB;
  const bf16*Qw=Q+(rowbase+q0+wid*QBLK)*QP+qcol;
  const bf16*Kh=K+rowbase*QP+qcol,*Vh=V+rowbase*QP+vcol;
  const unsigned lds0=(unsigned)(uintptr_t)shm;
  float*wsf=(float*)(shm+LDS_WS)+wid*64;
  const bf16*ksrc=Kh+(long)lane*QP+wid*8;
  const bf16*vsrc=Vh+(long)(16*(wid&3)+(lane>>2))*QP+(wid>>2)*32+(lane&3)*8;
  const unsigned kdst=lds0+LDS_K+wid*1024, vdst=lds0+LDS_V+wid*1024;
  #define DMA_K(t,slot) glds16(ksrc+(long)(t)*KVBLK*QP,(unsigned)__builtin_amdgcn_readfirstlane(kdst+(slot)))
  #define DMA_V(t,slot) glds16(vsrc+(long)(t)*KVBLK*QP,(unsigned)__builtin_amdgcn_readfirstlane(vdst+(slot)))
  const int vb0=(int)(lds0+LDS_V)+((lane>>4)&1)*32+(lane&3)*8+(4*hi+((lane&15)>>2))*64;
  const char*Kbase=shm+LDS_K; bf16x8 kf[8];
  const lds_cptr shm3=(lds_cptr)shm; const lds_cptr kp0=shm3+LDS_K+hi*1024+r32*16; const lds_cptr vp0=shm3+LDS_V+((lane>>4)&1)*32+(lane&3)*8+(4*hi+((lane&15)>>2))*64;
  const int NT=(q0+QB)/KVBLK;
  DMA_K(0,0);DMA_V(0,0);DMA_K(1,SLOTB);
  bf16x8 qr[4];
  #pragma unroll
  for(int d0=0;d0<4;++d0)qr[d0]=*reinterpret_cast<const bf16x8*>(&Qw[(long)r32*QP+d0*16+hi*8]);
  float mhat=0.f,l_reg=0.f;f32x16 o[2];o[0]=f32x16{};o[1]=f32x16{};f32x16 negm=f32x16{};asm volatile("":"+v"(negm));
  const int qrel=wid*QBLK+r32;
  #define CMASK(P0,P1,t) do{int jb_=(t)-(NT-4); if(jb_>=0)cmask(P0,P1,jb_,qrel,hi);}while(0)
  bool resc=false;
  #define START(P0,P1) do{ const float rm=rowmax(P0,P1); resc=false; \
    { const float dl=rm; mhat=fadd_s(mhat,dl); \
      _Pragma("unroll") for(int r=0;r<16;++r){P0[r]=fsub_s(P0[r],dl);P1[r]=fsub_s(P1[r],dl);} \
      _Pragma("unroll") for(int r=0;r<16;++r)negm[r]=-mhat; asm volatile("":"+v"(negm)); } \
    _Pragma("unroll") for(int r=0;r<16;++r)P0[r]=__builtin_amdgcn_exp2f(P0[r]); }while(0)
  #define RESC() do{ if(resc){ asm volatile("s_waitcnt lgkmcnt(0)":::"memory"); \
      _Pragma("unroll") for(int d_=0;d_<2;++d_) _Pragma("unroll") for(int r=0;r<16;++r)o[d_][r]*=wsf[crow(r,hi)]; } }while(0)
  f32x16 pA0,pA1,pB0,pB1;
  int sl_prev=0,sl_cur=0,sl_next=SLOTB;
  #define ROT() do{sl_prev=sl_cur;sl_cur=sl_next;sl_next=(sl_next==(NSLOT-1)*SLOTB)?0:sl_next+SLOTB;}while(0)
  DMA_K(2,2*SLOTB);
  WAIT_BAR(3);
  qkt(pA0,pA1,Kbase,qr,negm,r32,hi);asm volatile("s_nop 15\n\ts_nop 7":"+v"(pA0),"+v"(pA1));CMASK(pA0,pA1,0);
  START(pA0,pA1);
  _Pragma("unroll") for(int r=0;r<16;++r)pA1[r]=__builtin_amdgcn_exp2f(pA1[r]);
  WAIT_BAR(0);
  DMA_K(3,0);DMA_V(1,SLOTB);
  ROT();
  kload8(kf,kp0+sl_cur);
  WAIT_BAR(2);
  s16x4 vlo[8],vhi[8]; u32x4 pw0,pw1,pw2,pw3;
  #define PKW(P,B) cvtpk_s(P[B],P[B+1])
  #define PAF(k) __builtin_bit_cast(bf16x8,pw##k)
  #define VFR(i) (bf16x8){vlo[i][0],vlo[i][1],vlo[i][2],vlo[i][3],vhi[i][0],vhi[i][1],vhi[i][2],vhi[i][3]}
  #define PIN(x) asm volatile("":"+v"(x))
  #define MX3(a,b,c) __builtin_fmaxf(__builtin_fmaxf((a),(b)),(c))
  #define GAPA(MF,A0,A1,A2,A3,W0,W1,PW) do{ MF; sacc+=A0; sacc+=A1; sacc+=A2; sacc+=A3; PIN(sacc); W0; W1; PIN(PW); SBAR(); }while(0)
  #define EX(v) __builtin_amdgcn_exp2f(v)
  #define GAPB(MF,X,B) do{ MF; X[B]=EX(X[B]); X[B+1]=EX(X[B+1]); X[B+2]=EX(X[B+2]); X[B+3]=EX(X[B+3]); PIN(X); SBAR(); }while(0)
  #define VRD(i) do{ vlo[i]=vtr(vp_+(((i)>>2)*4096+((i)&3)*1024)); vhi[i]=vtr(vp_+(((i)>>2)*4096+((i)&3)*1024+512)); }while(0)
  #define KRD(G,j) do{ if(G){ kload2(kf,kp0+sl_next,j); SBAR(); } }while(0)
  #define STEP(C0,C1,P0,P1,t,GK,GV,GL) do{ SBAR(); \
    const lds_cptr vp_=vp0+sl_prev; \
    VRD(0); SBAR(); float sacc=(P0[0]+P0[1]); \
    GAPA(C0=__builtin_amdgcn_mfma_f32_32x32x16_bf16(kf[0],qr[0],negm,0,0,0), P0[2],P0[3],P0[4],P0[5],     pw0[0]=PKW(P0,0), pw0[1]=PKW(P0,2), pw0); \
    VRD(4); SBAR(); GAPA(C1=__builtin_amdgcn_mfma_f32_32x32x16_bf16(kf[1],qr[0],negm,0,0,0), P0[6],P0[7],P0[8],P0[9],     pw0[2]=PKW(P0,4), pw0[3]=PKW(P0,6), pw0); \
    VRD(1); SBAR(); GAPA(C0=__builtin_amdgcn_mfma_f32_32x32x16_bf16(kf[2],qr[1],C0,0,0,0),   P0[10],P0[11],P0[12],P0[13], pw1[0]=PKW(P0,8), pw1[1]=PKW(P0,10), pw1); \
    VRD(5); SBAR(); GAPA(C1=__builtin_amdgcn_mfma_f32_32x32x16_bf16(kf[3],qr[1],C1,0,0,0),   P0[14],P0[15],P1[0],P1[1],   pw1[2]=PKW(P0,12),pw1[3]=PKW(P0,14), pw1); \
    VRD(2); SBAR(); GAPA(C0=__builtin_amdgcn_mfma_f32_32x32x16_bf16(kf[4],qr[2],C0,0,0,0),   P1[2],P1[3],P1[4],P1[5],     pw2[0]=PKW(P1,0), pw2[1]=PKW(P1,2), pw2); \
    VRD(6); SBAR(); GAPA(C1=__builtin_amdgcn_mfma_f32_32x32x16_bf16(kf[5],qr[2],C1,0,0,0),   P1[6],P1[7],P1[8],P1[9],     pw2[2]=PKW(P1,4), pw2[3]=PKW(P1,6), pw2); \
    VRD(3); SBAR(); GAPA(C0=__builtin_amdgcn_mfma_f32_32x32x16_bf16(kf[6],qr[3],C0,0,0,0),   P1[10],P1[11],P1[12],P1[13], pw3[0]=PKW(P1,8), pw3[1]=PKW(P1,10), pw3); \
    VRD(7); SBAR(); GAPA(C1=__builtin_amdgcn_mfma_f32_32x32x16_bf16(kf[7],qr[3],C1,0,0,0),   P1[14],P1[15],0.f,0.f,       pw3[2]=PKW(P1,12),pw3[3]=PKW(P1,14), pw3); \
    l_reg+=sacc; \
    if(GK){DMA_K((t)+3,sl_cur);} if(GV){DMA_V((t)+1,sl_next);} \
    CMASK(C0,C1,t); \
    { float a=MX3(C0[0],C0[1],C1[0]),b=MX3(C0[2],C0[3],C1[1]); a=MX3(a,C1[2],C1[3]); \
      _Pragma("unroll") for(int r=4;r<16;r+=4){a=MX3(a,C0[r],C0[r+1]);b=MX3(b,C0[r+2],C0[r+3]);a=MX3(a,C1[r],C1[r+1]);b=MX3(b,C1[r+2],C1[r+3]);} \
      float rm=__builtin_fmaxf(a,b); { auto rr=__builtin_amdgcn_permlane32_swap(__float_as_uint(rm),__float_as_uint(rm),false,false); rm=__builtin_fmaxf(__uint_as_float(rr[0]),__uint_as_float(rr[1])); } \
      resc=false; \
      if(__builtin_expect(__any(rm>(float)THRL),0)){ const float dl=__builtin_fmaxf(rm,0.f); mhat+=dl; \
        _Pragma("unroll") for(int r=0;r<16;++r){C0[r]-=dl;C1[r]-=dl;} \
        _Pragma("unroll") for(int r=0;r<16;++r)negm[r]=-mhat; asm volatile("":"+v"(negm)); \
        const float f=__builtin_amdgcn_exp2f(-dl); l_reg*=f; if(hi==0)wsf[r32]=f; resc=true; } } \
    SBAR(); \
    GAPB(o[0]=__builtin_amdgcn_mfma_f32_32x32x16_bf16(PAF(0),VFR(0),o[0],0,0,0), C0,0); \
    GAPB(o[1]=__builtin_amdgcn_mfma_f32_32x32x16_bf16(PAF(0),VFR(4),o[1],0,0,0), C0,4); \
    KRD(GL,0); GAPB(o[0]=__builtin_amdgcn_mfma_f32_32x32x16_bf16(PAF(1),VFR(1),o[0],0,0,0), C0,8); \
    KRD(GL,1); GAPB(o[1]=__builtin_amdgcn_mfma_f32_32x32x16_bf16(PAF(1),VFR(5),o[1],0,0,0), C0,12); \
    KRD(GL,2); GAPB(o[0]=__builtin_amdgcn_mfma_f32_32x32x16_bf16(PAF(2),VFR(2),o[0],0,0,0), C1,0); \
    KRD(GL,3); GAPB(o[1]=__builtin_amdgcn_mfma_f32_32x32x16_bf16(PAF(2),VFR(6),o[1],0,0,0), C1,4); \
    GAPB(o[0]=__builtin_amdgcn_mfma_f32_32x32x16_bf16(PAF(3),VFR(3),o[0],0,0,0), C1,8); \
    GAPB(o[1]=__builtin_amdgcn_mfma_f32_32x32x16_bf16(PAF(3),VFR(7),o[1],0,0,0), C1,12); \
    }while(0)
  int t=1;
  #undef CMASK
  #define CMASK(P0,P1,t) do{}while(0)
  for(;t+5<NT;t+=2){
    STEP(pB0,pB1,pA0,pA1,t,true,true,true);     WAIT_BAR(2); RESC(); ROT();
    STEP(pA0,pA1,pB0,pB1,t+1,true,true,true);   WAIT_BAR(2); RESC(); ROT();
  }
  #undef CMASK
  #define CMASK(P0,P1,t) do{int jb_=(t)-(NT-4); if(jb_>=0)cmask(P0,P1,jb_,qrel,hi);}while(0)
  #define ENDW(tt) do{ if((tt)+3<NT){WAIT_BAR(2);} else if((tt)+2<NT){WAIT_BAR(1);} else {WAIT_BAR(0);} }while(0)
  for(;t+1<NT;t+=2){
    STEP(pB0,pB1,pA0,pA1,t,(t+3<NT),(t+1<NT),(t+1<NT));       ENDW(t);   RESC(); ROT();
    STEP(pA0,pA1,pB0,pB1,t+1,(t+4<NT),(t+2<NT),(t+2<NT));     ENDW(t+1); RESC(); ROT();
  }
  STEP(pB0,pB1,pA0,pA1,NT-1,false,false,false); RESC();
  { float sacc=pB0[0]+pB0[1]; _Pragma("unroll") for(int r=2;r<16;++r)sacc+=pB0[r]; _Pragma("unroll") for(int r=0;r<16;++r)sacc+=pB1[r]; l_reg+=sacc;
    pw0=(u32x4){PKW(pB0,0),PKW(pB0,2),PKW(pB0,4),PKW(pB0,6)};pw1=(u32x4){PKW(pB0,8),PKW(pB0,10),PKW(pB0,12),PKW(pB0,14)};pw2=(u32x4){PKW(pB1,0),PKW(pB1,2),PKW(pB1,4),PKW(pB1,6)};pw3=(u32x4){PKW(pB1,8),PKW(pB1,10),PKW(pB1,12),PKW(pB1,14)};
    SBAR(); pv(o,vb0+sl_cur,PAF(0),PAF(1),PAF(2),PAF(3)); }
  #undef PKW
  #undef PAF
  #undef VFR
  #undef PIN
  #undef MX3
  #undef GAPA
  #undef GAPB
  #undef EX
  #undef VRD
  #undef KRD
  #undef STEP
  #undef ENDW
  {auto rr=__builtin_amdgcn_permlane32_swap(__float_as_uint(l_reg),__float_as_uint(l_reg),false,false);l_reg=__uint_as_float(rr[0])+__uint_as_float(rr[1]);}
  if(hi==0)wsf[32+r32]=l_reg;asm volatile("s_waitcnt lgkmcnt(0)":::"memory");
  float rli[16];
  #pragma unroll
  for(int r=0;r<16;++r)rli[r]=__builtin_amdgcn_rcpf(wsf[32+crow(r,hi)]);
  bf16*Ow=O+(rowbase+q0+wid*QBLK)*DM+ocol;
  { bf16*stg=(bf16*)(shm+LDS_OST)+wid*2048;
    #pragma unroll
    for(int r=0;r<16;++r){const int orow=crow(r,hi);
      #pragma unroll
      for(int d0=0;d0<2;++d0)stg[orow*64+d0*32+r32]=__float2bfloat16(o[d0][r]*rli[r]);}
    asm volatile("s_waitcnt lgkmcnt(0)":::"memory");
    #pragma unroll
    for(int i=0;i<4;++i){const int row=i*8+(lane>>3),ch=lane&7; const u32x4 v=*(const u32x4*)(stg+row*64+ch*8); ATTN_STORE16(Ow+(long)row*DM+ch*8,v);} }
  asm volatile("s_waitcnt lgkmcnt(0)\n\ts_barrier":::"memory");
  #undef DMA_K
  #undef DMA_V
  #undef CMASK
  #undef START
  #undef RESC
  #undef ROT
}
constexpr int ATTN_LDS_BYTES=LDS_BYTES;
struct AttnTensors { const bf16* Q; const bf16* K; const bf16* V; bf16* O; };
struct AttnUnit { int bh; int qb; };
struct StaticOrder {
  int vcu;
  __device__ __forceinline__ explicit StaticOrder(int grid,int block):vcu((block%8)*(grid/8)+block/8){}
  __device__ __forceinline__ bool next(int i,AttnUnit&u)const{ if(i>=4)return false; const int s=vcu&7; u.bh=vcu>>3; u.qb=(i==0)?s:(i==1)?15-s:(i==2)?16+s:31-s; return true; }
  __device__ __forceinline__ void a_ready(const AttnUnit&)const{}
  __device__ __forceinline__ void done(const AttnUnit&)const{}
};
struct DynOrder {
  unsigned* ctr; int grp; volatile __attribute__((address_space(3))) int* slot;
  __device__ __forceinline__ bool next(int,AttnUnit&u)const{
    if(threadIdx.x==0) *slot=(int)__hip_atomic_fetch_add(ctr+64*grp,1u,__ATOMIC_RELAXED,__HIP_MEMORY_SCOPE_AGENT);
    __syncthreads(); const int idx=__builtin_amdgcn_readfirstlane(*slot); __syncthreads();
    if(idx>=128)return false; u.bh=grp*4+(idx&3); u.qb=31-(idx>>2); return true; }
  __device__ __forceinline__ void a_ready(const AttnUnit&)const{}
  __device__ __forceinline__ void done(const AttnUnit&)const{}
};
template<class Sched,int THRL=8> __device__ __forceinline__ void attn_phase(char*lds,const AttnTensors&T,const Sched&S){
  AttnUnit u;
  for(int i=0;S.next(i,u);++i){ S.a_ready(u); { const int hp=u.bh%NHEAD; attn_unit<THRL>(u.bh/NHEAD,(hp>>1)*64,(hp>>2)*128+(hp&1)*64,hp*64,u.qb,T.Q,T.K,T.V,T.O,lds); } S.done(u); }
}
#undef SBAR
#undef WAIT_BAR
}
namespace attn128 {
using bf16=__hip_bfloat16;
using bf16x8=__attribute__((ext_vector_type(8)))short;
using s16x4=__attribute__((ext_vector_type(4)))short;
using f32x16=__attribute__((ext_vector_type(16)))float;
using u32x4=__attribute__((ext_vector_type(4)))unsigned;
constexpr int BATCH=2,NHEAD=8,SEQ=8192,D=64,DM=1024,QP=512;
constexpr int NW=8,QBLK=32,QB=QBLK*NW,KVBLK=64,NQB=SEQ/QB;
constexpr int ATTN_PITCH=DM, ATTN_UNIT_ROWS=QB;
__device__ __forceinline__ int crow(int r,int hi){return (r&3)+8*(r>>2)+4*hi;}
#define SBAR() __builtin_amdgcn_sched_barrier(0)
__device__ __forceinline__ void cmask(f32x16&p0,f32x16&p1,int jb,int qrel,int hi){
  const float NEG=-INFINITY; (void)hi;
  if(jb>(qrel>>6)){
  #pragma unroll
  for(int r=0;r<16;++r){p0[r]=NEG;p1[r]=NEG;} }
}

constexpr int NSLOT=3, SLOTB=8192;
constexpr int LDS_K=0, LDS_V=NSLOT*SLOTB, LDS_WS=3*NSLOT*SLOTB, LDS_OST=LDS_WS+NW*64*4, LDS_BYTES=LDS_OST+NW*4096;
constexpr float C2=0.125f*1.4426950408889634f;
__device__ __forceinline__ void glds16(const void*gsrc,unsigned lds_dst){unsigned keep;
  asm volatile("s_mov_b32 %0, m0\n\ts_mov_b32 m0, %2\n\ts_nop 0\n\tglobal_load_lds_dwordx4 %1, off\n\ts_mov_b32 m0, %0":"=&s"(keep):"v"(gsrc),"s"(lds_dst):"memory");}
__device__ __forceinline__ float max3f(float a,float b,float c){float r;asm("v_max3_f32 %0, %1, %2, %3":"=v"(r):"v"(a),"v"(b),"v"(c));return r;}
__device__ __forceinline__ float max2f(float a,float b){float r;asm("v_max_f32_e32 %0, %1, %2":"=v"(r):"v"(a),"v"(b));return r;}
__device__ __forceinline__ float fadd_s(float a,float b){float r;asm("v_add_f32_e32 %0, %1, %2":"=v"(r):"v"(a),"v"(b));return r;}
__device__ __forceinline__ float fsub_s(float a,float b){float r;asm("v_sub_f32_e32 %0, %1, %2":"=v"(r):"v"(a),"v"(b));return r;}
typedef float f32x2_t __attribute__((ext_vector_type(2))); typedef __bf16 bf16x2_t __attribute__((ext_vector_type(2)));
__device__ __forceinline__ unsigned cvtpk_s(float lo,float hi){f32x2_t v={lo,hi};bf16x2_t b=__builtin_convertvector(v,bf16x2_t);return __builtin_bit_cast(unsigned,b);}
#define WAIT_BAR(N) asm volatile("s_waitcnt vmcnt(" #N ") lgkmcnt(0)\n\ts_barrier":::"memory")

__device__ __forceinline__ void qkt(f32x16&p0,f32x16&p1,const char*Kslot,const bf16x8*qr,int r32,int hi){ const f32x16 negm=f32x16{};
  const char*kb=Kslot+hi*1024+r32*16;
  #pragma unroll
  for(int d0=0;d0<4;++d0){
    const bf16x8 b0=*reinterpret_cast<const bf16x8*>(kb+d0*2048);
    const bf16x8 b1=*reinterpret_cast<const bf16x8*>(kb+d0*2048+512);
    if(d0==0){p0=__builtin_amdgcn_mfma_f32_32x32x16_bf16(b0,qr[0],negm,0,0,0);p1=__builtin_amdgcn_mfma_f32_32x32x16_bf16(b1,qr[0],negm,0,0,0);}
    else{p0=__builtin_amdgcn_mfma_f32_32x32x16_bf16(b0,qr[d0],p0,0,0,0);p1=__builtin_amdgcn_mfma_f32_32x32x16_bf16(b1,qr[d0],p1,0,0,0);}}
}
typedef __attribute__((address_space(3))) const char* lds_cptr;
typedef short v4i16_t __attribute__((ext_vector_type(4)));
__device__ __forceinline__ void kload8(bf16x8*kf,lds_cptr kp){
  kf[0]=*(const __attribute__((address_space(3))) bf16x8*)(kp);      kf[1]=*(const __attribute__((address_space(3))) bf16x8*)(kp+512);
  kf[2]=*(const __attribute__((address_space(3))) bf16x8*)(kp+2048); kf[3]=*(const __attribute__((address_space(3))) bf16x8*)(kp+2560);
  kf[4]=*(const __attribute__((address_space(3))) bf16x8*)(kp+4096); kf[5]=*(const __attribute__((address_space(3))) bf16x8*)(kp+4608);
  kf[6]=*(const __attribute__((address_space(3))) bf16x8*)(kp+6144); kf[7]=*(const __attribute__((address_space(3))) bf16x8*)(kp+6656);
}
__device__ __forceinline__ void kload2(bf16x8*kf,lds_cptr kp,int j){ kf[2*j]=*(const __attribute__((address_space(3))) bf16x8*)(kp+j*2048); kf[2*j+1]=*(const __attribute__((address_space(3))) bf16x8*)(kp+j*2048+512); }
__device__ __forceinline__ s16x4 vtr(lds_cptr p){ return __builtin_bit_cast(s16x4,__builtin_amdgcn_ds_read_tr16_b64_v4i16((__attribute__((address_space(3))) v4i16_t*)p)); }
__device__ __forceinline__ float rowmax(const f32x16&p0,const f32x16&p1){
  float a=max3f(p0[0],p0[1],p1[0]),b=max3f(p0[2],p0[3],p1[1]);a=max3f(a,p1[2],p1[3]);
  #pragma unroll
  for(int r=4;r<16;r+=4){a=max3f(a,p0[r],p0[r+1]);b=max3f(b,p0[r+2],p0[r+3]);a=max3f(a,p1[r],p1[r+1]);b=max3f(b,p1[r+2],p1[r+3]);}
  const float m=max2f(a,b);
  auto rr=__builtin_amdgcn_permlane32_swap(__float_as_uint(m),__float_as_uint(m),false,false);
  return max2f(__uint_as_float(rr[0]),__uint_as_float(rr[1]));
}
__device__ __forceinline__ void pv(f32x16*o,int vb,bf16x8 pa0,bf16x8 pa1,bf16x8 pa2,bf16x8 pa3){
  #pragma unroll
  for(int d0=0;d0<4;++d0){s16x4 lo[4],hi[4];
    #pragma unroll
    for(int ks=0;ks<4;++ks){
      asm volatile("ds_read_b64_tr_b16 %0,%1 offset:%c2":"=&v"(lo[ks]):"v"(vb),"i"(d0*4096+ks*1024):"memory");
      asm volatile("ds_read_b64_tr_b16 %0,%1 offset:%c2":"=&v"(hi[ks]):"v"(vb),"i"(d0*4096+ks*1024+512):"memory");}
    asm volatile("s_waitcnt lgkmcnt(0)":::"memory");SBAR();
    #define PK(k) (bf16x8){lo[k][0],lo[k][1],lo[k][2],lo[k][3],hi[k][0],hi[k][1],hi[k][2],hi[k][3]}
    o[d0]=__builtin_amdgcn_mfma_f32_32x32x16_bf16(pa0,PK(0),o[d0],0,0,0);
    o[d0]=__builtin_amdgcn_mfma_f32_32x32x16_bf16(pa1,PK(1),o[d0],0,0,0);
    o[d0]=__builtin_amdgcn_mfma_f32_32x32x16_bf16(pa2,PK(2),o[d0],0,0,0);
    o[d0]=__builtin_amdgcn_mfma_f32_32x32x16_bf16(pa3,PK(3),o[d0],0,0,0);
    #undef PK
  }
}

#ifndef ATTN_STORE16
#define ATTN_STORE16(p,v) (*(u32x4*)(p)=(v))
#endif
template<int THRL> __device__ __forceinline__ void attn_unit(int b,int qcol,int vcol,int ocol,int qb,const bf16*Q,const bf16*__restrict__ K,const bf16*__restrict__ V,bf16*O,char*shm){
  const int tid=threadIdx.x,lane=tid&63,r32=lane&31,hi=lane>>5; const int wid=__builtin_amdgcn_readfirstlane(tid>>6);
  const long rowbase=(long)b*SEQ; const int q0=qb*QB;
  const bf16*Qw=Q+(rowbase+q0+wid*QBLK)*QP+qcol;
  const bf16*Kh=K+rowbase*QP+qcol,*Vh=V+rowbase*QP+vcol;
  const unsigned lds0=(unsigned)(uintptr_t)shm;
  float*wsf=(float*)(shm+LDS_WS)+wid*64;
  const bf16*ksrc=Kh+(long)lane*QP+wid*8;
  const bf16*vsrc=Vh+(long)(16*(wid&3)+(lane>>2))*QP+(wid>>2)*32+(lane&3)*8;
  const unsigned kdst=lds0+LDS_K+wid*1024, vdst=lds0+LDS_V+wid*1024;
  #define DMA_K(t,slot) glds16(ksrc+(long)(t)*KVBLK*QP,(unsigned)__builtin_amdgcn_readfirstlane(kdst+(slot)))
  #define DMA_V(t,slot) do{ glds16(vsrc+(long)(t)*KVBLK*QP,(unsigned)__builtin_amdgcn_readfirstlane(vdst+2*(slot))); glds16(vsrc+(long)(t)*KVBLK*QP+64,(unsigned)__builtin_amdgcn_readfirstlane(vdst+2*(slot)+8192)); }while(0)
  const int vb0=(int)(lds0+LDS_V)+((lane>>4)&1)*32+(lane&3)*8+(4*hi+((lane&15)>>2))*64;
  const char*Kbase=shm+LDS_K; bf16x8 kf[8];
  const lds_cptr shm3=(lds_cptr)shm; const lds_cptr kp0=shm3+LDS_K+hi*1024+r32*16; const lds_cptr vp0=shm3+LDS_V+((lane>>4)&1)*32+(lane&3)*8+(4*hi+((lane&15)>>2))*64;
  const int NT=(q0+QB)/KVBLK;
  DMA_K(0,0);DMA_V(0,0);DMA_K(1,SLOTB);
  bf16x8 qr[4];
  #pragma unroll
  for(int d0=0;d0<4;++d0)qr[d0]=*reinterpret_cast<const bf16x8*>(&Qw[(long)r32*QP+d0*16+hi*8]);
  const lds_cptr qf0=(lds_cptr)shm+LDS_OST+wid*4096+lane*16;
  #define QLD(j) (*(const __attribute__((address_space(3))) bf16x8*)(qf0+(j)*1024))
  float mhat=0.f,l_reg=0.f;f32x16 o[4];o[0]=f32x16{};o[1]=f32x16{};o[2]=f32x16{};o[3]=f32x16{};
  const int qrel=wid*QBLK+r32;
  #define CMASK(P0,P1,t) do{int jb_=(t)-(NT-4); if(jb_>=0)cmask(P0,P1,jb_,qrel,hi);}while(0)
  bool resc=false;
  #define START(P0,P1) do{ const float rm=rowmax(P0,P1); resc=false; \
    { const float dl=rm; mhat=fadd_s(mhat,dl); \
      _Pragma("unroll") for(int r=0;r<16;++r){P0[r]=fsub_s(P0[r],dl);P1[r]=fsub_s(P1[r],dl);} \
      } \
    _Pragma("unroll") for(int r=0;r<16;++r)P0[r]=__builtin_amdgcn_exp2f(P0[r]); }while(0)
  #define RESC() do{ if(resc){ asm volatile("s_waitcnt lgkmcnt(0)":::"memory"); \
      _Pragma("unroll") for(int d_=0;d_<4;++d_) _Pragma("unroll") for(int r=0;r<16;++r)o[d_][r]*=wsf[crow(r,hi)]; } }while(0)
  f32x16 pA0,pA1,pB0,pB1;
  int sl_prev=0,sl_cur=0,sl_next=SLOTB;
  #define ROT() do{sl_prev=sl_cur;sl_cur=sl_next;sl_next=(sl_next==(NSLOT-1)*SLOTB)?0:sl_next+SLOTB;}while(0)
  DMA_K(2,2*SLOTB);
  WAIT_BAR(3);
  { _Pragma("unroll") for(int d0=0;d0<4;++d0) *(__attribute__((address_space(3))) bf16x8*)((__attribute__((address_space(3))) char*)(uintptr_t)(lds0+LDS_OST+wid*4096+lane*16+d0*1024))=qr[d0]; }
  qkt(pA0,pA1,Kbase,qr,r32,hi);asm volatile("s_nop 15\n\ts_nop 7":"+v"(pA0),"+v"(pA1));CMASK(pA0,pA1,0);
  START(pA0,pA1);
  _Pragma("unroll") for(int r=0;r<16;++r)pA1[r]=__builtin_amdgcn_exp2f(pA1[r]);
  WAIT_BAR(0);
  DMA_K(3,0);DMA_V(1,SLOTB);
  ROT();
  kload8(kf,kp0+sl_cur);
  WAIT_BAR(3);
  s16x4 vlo[8],vhi[8]; u32x4 pw0,pw1,pw2,pw3;
  #define PKW(P,B) cvtpk_s(P[B],P[B+1])
  #define PAF(k) __builtin_bit_cast(bf16x8,pw##k)
  #define VFR(i) (bf16x8){vlo[i][0],vlo[i][1],vlo[i][2],vlo[i][3],vhi[i][0],vhi[i][1],vhi[i][2],vhi[i][3]}
  #define PIN(x) asm volatile("":"+v"(x))
  #define MX3(a,b,c) __builtin_fmaxf(__builtin_fmaxf((a),(b)),(c))
  #define GAPA(MF,A0,A1,A2,A3,W0,W1,PW) do{ MF; sacc+=A0; sacc+=A1; sacc+=A2; sacc+=A3; PIN(sacc); W0; W1; PIN(PW); SBAR(); }while(0)
  #define EX(v) __builtin_amdgcn_exp2f(v)
  #define GAPB(MF,X,B) do{ MF; X[B]=EX(X[B]); X[B+1]=EX(X[B+1]); X[B+2]=EX(X[B+2]); X[B+3]=EX(X[B+3]); PIN(X); SBAR(); }while(0)
  #define VRD(i) do{ vlo[i]=vtr(vp_+(((i)>>2)*4096+((i)&3)*1024)); vhi[i]=vtr(vp_+(((i)>>2)*4096+((i)&3)*1024+512)); }while(0)
  #define VRD2(i) do{ vlo[i]=vtr(vp_+(8192+((i)>>2)*4096+((i)&3)*1024)); vhi[i]=vtr(vp_+(8192+((i)>>2)*4096+((i)&3)*1024+512)); SBAR(); }while(0)
  #define GAPB2(MF,X,B) do{ MF; X[B]=EX(X[B]-mhat); X[B+1]=EX(X[B+1]-mhat); PIN(X); SBAR(); }while(0)
  #define KRD(G,j) do{ if(G){ kload2(kf,kp0+sl_next,j); SBAR(); } }while(0)
  #define STEP(C0,C1,P0,P1,t,GK,GV,GL) do{ SBAR(); \
    const lds_cptr vp_=vp0+2*sl_prev; \
    VRD(0); bf16x8 qa_=QLD(0), qb_=QLD(1); SBAR(); float sacc=(P0[0]+P0[1]); \
    GAPA(C0=__builtin_amdgcn_mfma_f32_32x32x16_bf16(kf[0],qa_,f32x16{},0,0,0), P0[2],P0[3],P0[4],P0[5], pw0[0]=PKW(P0,0), pw0[1]=PKW(P0,2), pw0); \
    VRD(4); SBAR(); GAPA(C1=__builtin_amdgcn_mfma_f32_32x32x16_bf16(kf[1],qa_,f32x16{},0,0,0), P0[6],P0[7],P0[8],P0[9], pw0[2]=PKW(P0,4), pw0[3]=PKW(P0,6), pw0); \
    VRD(1); qa_=QLD(2); SBAR(); GAPA(C0=__builtin_amdgcn_mfma_f32_32x32x16_bf16(kf[2],qb_,C0,0,0,0), P0[10],P0[11],P0[12],P0[13], pw1[0]=PKW(P0,8), pw1[1]=PKW(P0,10), pw1); \
    VRD(5); SBAR(); GAPA(C1=__builtin_amdgcn_mfma_f32_32x32x16_bf16(kf[3],qb_,C1,0,0,0), P0[14],P0[15],P1[0],P1[1], pw1[2]=PKW(P0,12),pw1[3]=PKW(P0,14), pw1); \
    VRD(2); qb_=QLD(3); SBAR(); GAPA(C0=__builtin_amdgcn_mfma_f32_32x32x16_bf16(kf[4],qa_,C0,0,0,0), P1[2],P1[3],P1[4],P1[5], pw2[0]=PKW(P1,0), pw2[1]=PKW(P1,2), pw2); \
    VRD(6); SBAR(); GAPA(C1=__builtin_amdgcn_mfma_f32_32x32x16_bf16(kf[5],qa_,C1,0,0,0), P1[6],P1[7],P1[8],P1[9], pw2[2]=PKW(P1,4), pw2[3]=PKW(P1,6), pw2); \
    VRD(3); SBAR(); GAPA(C0=__builtin_amdgcn_mfma_f32_32x32x16_bf16(kf[6],qb_,C0,0,0,0), P1[10],P1[11],P1[12],P1[13], pw3[0]=PKW(P1,8), pw3[1]=PKW(P1,10), pw3); \
    VRD(7); SBAR(); GAPA(C1=__builtin_amdgcn_mfma_f32_32x32x16_bf16(kf[7],qb_,C1,0,0,0), P1[14],P1[15],0.f,0.f, pw3[2]=PKW(P1,12),pw3[3]=PKW(P1,14), pw3); \
    l_reg+=sacc; \
    if(GK){DMA_K((t)+3,sl_cur);} if(GV){DMA_V((t)+1,sl_next);} \
    CMASK(C0,C1,t); \
    { float a=MX3(C0[0],C0[1],C1[0]),b=MX3(C0[2],C0[3],C1[1]); a=MX3(a,C1[2],C1[3]); \
      _Pragma("unroll") for(int r=4;r<16;r+=4){a=MX3(a,C0[r],C0[r+1]);b=MX3(b,C0[r+2],C0[r+3]);a=MX3(a,C1[r],C1[r+1]);b=MX3(b,C1[r+2],C1[r+3]);} \
      float rm=__builtin_fmaxf(a,b); { auto rr=__builtin_amdgcn_permlane32_swap(__float_as_uint(rm),__float_as_uint(rm),false,false); rm=__builtin_fmaxf(__uint_as_float(rr[0]),__uint_as_float(rr[1])); } \
      rm-=mhat; resc=false; \
      if(__builtin_expect(__any(rm>(float)THRL),0)){ const float dl=__builtin_fmaxf(rm,0.f); mhat+=dl; \
        const float f=__builtin_amdgcn_exp2f(-dl); l_reg*=f; if(hi==0)wsf[r32]=f; resc=true; } } \
    SBAR(); \
    GAPB2(o[0]=__builtin_amdgcn_mfma_f32_32x32x16_bf16(PAF(0),VFR(0),o[0],0,0,0), C0,0); VRD2(0); \
    GAPB2(o[1]=__builtin_amdgcn_mfma_f32_32x32x16_bf16(PAF(0),VFR(4),o[1],0,0,0), C0,2); VRD2(4); \
    GAPB2(o[0]=__builtin_amdgcn_mfma_f32_32x32x16_bf16(PAF(1),VFR(1),o[0],0,0,0), C0,4); VRD2(1); \
    GAPB2(o[1]=__builtin_amdgcn_mfma_f32_32x32x16_bf16(PAF(1),VFR(5),o[1],0,0,0), C0,6); VRD2(5); \
    GAPB2(o[0]=__builtin_amdgcn_mfma_f32_32x32x16_bf16(PAF(2),VFR(2),o[0],0,0,0), C0,8); VRD2(2); \
    GAPB2(o[1]=__builtin_amdgcn_mfma_f32_32x32x16_bf16(PAF(2),VFR(6),o[1],0,0,0), C0,10); VRD2(6); \
    GAPB2(o[0]=__builtin_amdgcn_mfma_f32_32x32x16_bf16(PAF(3),VFR(3),o[0],0,0,0), C0,12); VRD2(3); \
    GAPB2(o[1]=__builtin_amdgcn_mfma_f32_32x32x16_bf16(PAF(3),VFR(7),o[1],0,0,0), C0,14); VRD2(7); \
    GAPB2(o[2]=__builtin_amdgcn_mfma_f32_32x32x16_bf16(PAF(0),VFR(0),o[2],0,0,0), C1,0); \
    GAPB2(o[3]=__builtin_amdgcn_mfma_f32_32x32x16_bf16(PAF(0),VFR(4),o[3],0,0,0), C1,2); \
    KRD(GL,0); GAPB2(o[2]=__builtin_amdgcn_mfma_f32_32x32x16_bf16(PAF(1),VFR(1),o[2],0,0,0), C1,4); \
    KRD(GL,1); GAPB2(o[3]=__builtin_amdgcn_mfma_f32_32x32x16_bf16(PAF(1),VFR(5),o[3],0,0,0), C1,6); \
    KRD(GL,2); GAPB2(o[2]=__builtin_amdgcn_mfma_f32_32x32x16_bf16(PAF(2),VFR(2),o[2],0,0,0), C1,8); \
    KRD(GL,3); GAPB2(o[3]=__builtin_amdgcn_mfma_f32_32x32x16_bf16(PAF(2),VFR(6),o[3],0,0,0), C1,10); \
    GAPB2(o[2]=__builtin_amdgcn_mfma_f32_32x32x16_bf16(PAF(3),VFR(3),o[2],0,0,0), C1,12); \
    GAPB2(o[3]=__builtin_amdgcn_mfma_f32_32x32x16_bf16(PAF(3),VFR(7),o[3],0,0,0), C1,14); \
    }while(0)
  int t=1;
  #undef CMASK
  #define CMASK(P0,P1,t) do{}while(0)
  for(;t+5<NT;t+=2){
    STEP(pB0,pB1,pA0,pA1,t,true,true,true);     WAIT_BAR(3); RESC(); ROT();
    STEP(pA0,pA1,pB0,pB1,t+1,true,true,true);   WAIT_BAR(3); RESC(); ROT();
  }
  #undef CMASK
  #define CMASK(P0,P1,t) do{int jb_=(t)-(NT-4); if(jb_>=0)cmask(P0,P1,jb_,qrel,hi);}while(0)
  #define ENDW(tt) do{ if((tt)+3<NT){WAIT_BAR(3);} else if((tt)+2<NT){WAIT_BAR(2);} else {WAIT_BAR(0);} }while(0)
  for(;t+1<NT;t+=2){
    STEP(pB0,pB1,pA0,pA1,t,(t+3<NT),(t+1<NT),(t+1<NT));       ENDW(t);   RESC(); ROT();
    STEP(pA0,pA1,pB0,pB1,t+1,(t+4<NT),(t+2<NT),(t+2<NT));     ENDW(t+1); RESC(); ROT();
  }
  STEP(pB0,pB1,pA0,pA1,NT-1,false,false,false); RESC();
  { float sacc=pB0[0]+pB0[1]; _Pragma("unroll") for(int r=2;r<16;++r)sacc+=pB0[r]; _Pragma("unroll") for(int r=0;r<16;++r)sacc+=pB1[r]; l_reg+=sacc;
    pw0=(u32x4){PKW(pB0,0),PKW(pB0,2),PKW(pB0,4),PKW(pB0,6)};pw1=(u32x4){PKW(pB0,8),PKW(pB0,10),PKW(pB0,12),PKW(pB0,14)};pw2=(u32x4){PKW(pB1,0),PKW(pB1,2),PKW(pB1,4),PKW(pB1,6)};pw3=(u32x4){PKW(pB1,8),PKW(pB1,10),PKW(pB1,12),PKW(pB1,14)};
    SBAR(); pv(o,vb0+2*sl_cur,PAF(0),PAF(1),PAF(2),PAF(3)); }
  #undef PKW
  #undef PAF
  #undef VFR
  #undef PIN
  #undef MX3
  #undef GAPA
  #undef GAPB
  #undef EX
  #undef VRD
  #undef KRD
  #undef STEP
  #undef ENDW
  {auto rr=__builtin_amdgcn_permlane32_swap(__float_as_uint(l_reg),__float_as_uint(l_reg),false,false);l_reg=__uint_as_float(rr[0])+__uint_as_float(rr[1]);}
  if(hi==0)wsf[32+r32]=l_reg;asm volatile("s_waitcnt lgkmcnt(0)":::"memory");
  float rli[16];
  #pragma unroll
  for(int r=0;r<16;++r)rli[r]=__builtin_amdgcn_rcpf(wsf[32+crow(r,hi)]);
  bf16*Ow=O+(rowbase+q0+wid*QBLK)*DM+ocol;
  { bf16*stg=(bf16*)(shm+LDS_OST)+wid*2048;
    #pragma unroll
    for(int ps=0;ps<2;++ps){
    #pragma unroll
    for(int r=0;r<16;++r){const int orow=crow(r,hi);
      #pragma unroll
      for(int d0=0;d0<2;++d0)stg[orow*64+d0*32+r32]=__float2bfloat16(o[2*ps+d0][r]*rli[r]);}
    asm volatile("s_waitcnt lgkmcnt(0)":::"memory");
    #pragma unroll
    for(int i=0;i<4;++i){const int row=i*8+(lane>>3),ch=lane&7; const u32x4 v=*(const u32x4*)(stg+row*64+ch*8); ATTN_STORE16(Ow+(long)row*DM+ps*64+ch*8,v);}
    asm volatile("s_waitcnt lgkmcnt(0)":::"memory"); } }
  asm volatile("s_waitcnt lgkmcnt(0)\n\ts_barrier":::"memory");
  #undef DMA_K
  #undef DMA_V
  #undef CMASK
  #undef START
  #undef RESC
  #undef ROT
}
constexpr int ATTN_LDS_BYTES=LDS_BYTES;
struct AttnTensors { const bf16* Q; const bf16* K; const bf16* V; bf16* O; };
struct AttnUnit { int bh; int qb; };
struct DynOrder {
  unsigned* ctr; int grp; volatile __attribute__((address_space(3))) int* slot;
  __device__ __forceinline__ bool next(int,AttnUnit&u)const{
    if(threadIdx.x==0) *slot=(int)__hip_atomic_fetch_add(ctr+64*grp,1u,__ATOMIC_RELAXED,__HIP_MEMORY_SCOPE_AGENT);
    __syncthreads(); const int idx=__builtin_amdgcn_readfirstlane(*slot); __syncthreads();
    if(idx>=64)return false; u.bh=grp*2+(idx&1); u.qb=31-(idx>>1); return true; }
  __device__ __forceinline__ void a_ready(const AttnUnit&)const{}
  __device__ __forceinline__ void done(const AttnUnit&)const{}
};
template<class Sched,int THRL=8> __device__ __forceinline__ void attn_phase(char*lds,const AttnTensors&T,const Sched&S){
  AttnUnit u;
  for(int i=0;S.next(i,u);++i){ S.a_ready(u); { const int hp=u.bh%NHEAD; attn_unit<THRL>(u.bh/NHEAD,hp*64,(hp>>1)*128,hp*128,u.qb,T.Q,T.K,T.V,T.O,lds); } S.done(u); }
}
#undef SBAR
#undef WAIT_BAR
}


#ifndef ATTN_DV128
#define ATTN_DV128 1
#endif
constexpr int NWAVES = 8;
constexpr int BATCH = 2, T = 8192, D = 1024, M = BATCH * T;
constexpr int NPROJ = 5632;
constexpr int IN_W = 5640;
constexpr float EPS = 1e-6f;
constexpr int NE = 32, FH = 256;
constexpr int XG_ROWS = 160 * 256;
constexpr int N_PHASES = 13;

constexpr size_t MiB = 1u << 20;
constexpr size_t WS_CTL = 0, CTL_ZERO_BYTES = 1 * MiB;
constexpr size_t WS_WIN = 1 * MiB;
constexpr size_t WS_WA = 12 * MiB, WS_WB = 13 * MiB, WS_WOUT = 14 * MiB;
constexpr size_t WS_BD = 16 * MiB;
constexpr size_t WS_POS = 16 * MiB + 512 * 1024;
constexpr size_t WS_ROWW = 17 * MiB;
constexpr size_t WS_ROUTE = 17 * MiB + 256 * 1024;
constexpr size_t WS_WR = 17 * MiB + 512 * 1024;
constexpr size_t WS_GU = 1 * MiB;
constexpr int GU_SPLIT = 11, GU_SHIFT = 223;
constexpr size_t WS_WN = 18 * MiB, WS_KDT = 34 * MiB, WS_U = 50 * MiB;
constexpr size_t WS_QD = 210 * MiB, WS_IN = 226 * MiB, WS_GL = 234 * MiB;
constexpr size_t WS_SB = 146 * MiB, WS_VB = 178 * MiB;
constexpr size_t WS_DN = 50 * MiB;
constexpr size_t WS_H = 66 * MiB;
constexpr size_t WS_Q = 98 * MiB, WS_K = 114 * MiB, WS_V = 130 * MiB;
constexpr size_t WS_G = 146 * MiB;
constexpr size_t WS_GATE = 194 * MiB;
constexpr size_t WS_XG = 146 * MiB;
constexpr size_t WS_YG = 66 * MiB;
constexpr size_t WS_ACT = 18 * MiB;
constexpr size_t WS_END = 256 * MiB;
static_assert(WS_XG + (size_t)XG_ROWS * 1024 * 2 <= 226 * MiB && WS_ACT + (size_t)XG_ROWS * 256 * 2 <= WS_DN && WS_YG + (size_t)XG_ROWS * 1024 * 2 <= WS_XG && WS_GL + 4096 <= 235 * MiB, "ws map");
static_assert(WS_WR + 2 * 48 * 1024 * 2 <= 18 * MiB && WS_ROWW + XG_ROWS * 4 <= WS_ROUTE && WS_ROUTE + (size_t)M * 16 <= WS_WR, "ws map small");
constexpr int CW_TMO = 0, CW_CODE = 1;
constexpr int CW_BAR = 4096;
constexpr int CW_CNT = 16384, CW_CUR = 16384 + 32 * 64;
constexpr int CW_WQ2 = 16384 + 64 * 64 + 9 * 64;
constexpr int CW_WQ = 16384 + 64 * 64 + 8 * 64;
constexpr int CW_AQ = 16384 + 64 * 64;
constexpr int RING_OFF = 0, RING_BYTES = 131072;
constexpr int LDSCTL_OFF = RING_BYTES, MISC_OFF = LDSCTL_OFF + 320;
constexpr int TS_OFF = MISC_OFF + 128;
constexpr int GDN_AB_OFF = LDSCTL_OFF + 1024;
constexpr int LDS_BYTES = 147456;

#define GAS __attribute__((address_space(1)))
#define LAS __attribute__((address_space(3)))
typedef unsigned short bf16;
typedef unsigned v4u __attribute__((ext_vector_type(4)));
typedef unsigned v2u __attribute__((ext_vector_type(2)));
typedef float f32x4 __attribute__((ext_vector_type(4)));
typedef GAS unsigned gu32;
#define RLX_AGENT __ATOMIC_RELAXED, __HIP_MEMORY_SCOPE_AGENT
#define LDS_WAIT() asm volatile("s_waitcnt lgkmcnt(0)" ::: "memory")
#define VM_WAIT() asm volatile("s_waitcnt vmcnt(0)" ::: "memory")
__device__ __forceinline__ unsigned f2bf(float f) { unsigned u = __builtin_bit_cast(unsigned, f); return (u + 0x7fffu + ((u >> 16) & 1u)) >> 16; }
__device__ __forceinline__ unsigned pk2(float lo, float hi) { return f2bf(lo) | (f2bf(hi) << 16); }
__device__ __forceinline__ float bflo(unsigned w) { return __uint_as_float(w << 16); }
__device__ __forceinline__ float bfhi(unsigned w) { return __uint_as_float(w & 0xffff0000u); }
__device__ __forceinline__ float sigm(float x) { return 1.0f / (1.0f + __expf(-x)); }

#define XB_TMO      128
#define XB_XCNT(j)  (256  + 64 * (j))
#define XB_XSUB(j)  (1280 + 64 * (j))
#define XB_XGEN(j)  (2304 + 64 * (j))
#define XB_TOP      3328
#define XB_TOPGEN   3392
#define XCD_BAR_WORDS 3456
#define XB_SPIN_CAP (1u << 22)
__device__ __forceinline__ unsigned xb_ld(unsigned* p)              { return __hip_atomic_load(p, __ATOMIC_RELAXED, __HIP_MEMORY_SCOPE_AGENT); }
__device__ __forceinline__ unsigned xb_add(unsigned* p, unsigned v) { return __hip_atomic_fetch_add(p, v, __ATOMIC_RELAXED, __HIP_MEMORY_SCOPE_AGENT); }
__device__ __forceinline__ unsigned xb_xcc_id() { return (unsigned)__builtin_amdgcn_s_getreg((3 << 11) | 20) & 0xFu; }
#define XB_SPIN(cond, bar) do { unsigned _sp = 0; while (cond) { __builtin_amdgcn_s_sleep(1); \
    if ((++_sp & 255u) == 0u) { if (xb_ld(&(bar)[XB_TMO])) break; if (_sp > XB_SPIN_CAP) { atomicAdd(&(bar)[XB_TMO], 1u); break; } } } } while (0)
struct XcdBarrier { unsigned* bar; unsigned x; volatile LAS unsigned* st; };
__device__ __forceinline__ XcdBarrier xcd_barrier_post(unsigned* bar, volatile LAS unsigned* st) {
    XcdBarrier b; b.bar = bar; b.x = xb_xcc_id(); b.st = st;
    if (threadIdx.x == 0) (void)xb_add(&bar[XB_XCNT(b.x)], 1u);
    return b;
}
__device__ __forceinline__ void xcd_barrier_complete(unsigned* bar, unsigned x, unsigned& nloc, unsigned& nx) {
    const unsigned G = gridDim.x * gridDim.y * gridDim.z;
    unsigned sum, cnt, mine, sp = 0u;
    for (;;) {
        sum = 0u; cnt = 0u; mine = 0u;
#pragma unroll
        for (unsigned j = 0; j < 16; ++j) { const unsigned c = xb_ld(&bar[XB_XCNT(j)]); sum += c; cnt += (c > 0u) ? 1u : 0u; mine = (j == x) ? c : mine; }
        if (sum == G) break;
        __builtin_amdgcn_s_sleep(1);
        if ((++sp & 255u) == 0u) { if (xb_ld(&bar[XB_TMO])) break; if (sp > XB_SPIN_CAP) { atomicAdd(&bar[XB_TMO], 1u); break; } }
    }
    nloc = mine > 0u ? mine : 1u; nx = cnt > 0u ? cnt : 1u;
}
__device__ __forceinline__ void xcd_barrier(const XcdBarrier& b) {
    asm volatile("s_waitcnt vmcnt(0)" ::: "memory");
    __syncthreads();
    if (threadIdx.x == 0) {
        unsigned* bar = b.bar;
        __builtin_amdgcn_s_waitcnt(0);
        unsigned nloc = b.st[0], nx = b.st[1];
        if (nloc == 0u) { xcd_barrier_complete(bar, b.x, nloc, nx); b.st[0] = nloc; b.st[1] = nx; }
        const unsigned old = xb_add(&bar[XB_XSUB(b.x)], 1u);
        const unsigned gen = old / nloc;
        if (old + 1u == (gen + 1u) * nloc) {
            __builtin_amdgcn_fence(__ATOMIC_RELEASE, "agent");
            asm volatile("s_waitcnt vmcnt(0)" ::: "memory");
            const unsigned og = xb_add(&bar[XB_TOP], 1u);
            const unsigned tg = og / nx;
            if (og + 1u == (tg + 1u) * nx) xb_add(&bar[XB_TOPGEN], 1u);
            else XB_SPIN(xb_ld(&bar[XB_TOPGEN]) == tg, bar);
            __builtin_amdgcn_fence(__ATOMIC_ACQUIRE, "agent");
            xb_add(&bar[XB_XGEN(b.x)], 1u);
            asm volatile("s_waitcnt vmcnt(0)" ::: "memory");
        } else {
            XB_SPIN(xb_ld(&bar[XB_XGEN(b.x)]) == gen, bar);
            __builtin_amdgcn_fence(__ATOMIC_ACQUIRE, "agent");
            asm volatile("s_waitcnt vmcnt(0)" ::: "memory");
        }
    }
    __syncthreads();
}

#define CAS __attribute__((address_space(4)))
struct Args { const float* in[24]; float* out; unsigned char* ws; int ph_lo, ph_hi; };
#define FIN(k) (F.ka->in[k])
struct Frame {
    LAS unsigned char* lds;
    volatile LAS unsigned* MISC;
    gu32* ctl;
    int tid, lane, wave;
    int vcu, G;
    unsigned char* ws;
    float* out;
    const CAS Args* ka;
};
__device__ __forceinline__ float wave_sum(float v) {
#pragma unroll
    for (int o = 1; o < 64; o <<= 1) v += __shfl_xor(v, o);
    return v;
}
__device__ __forceinline__ void p0_transpose_item(const float* W, int ldw, int col0, int K, int nblk, bf16* WT, int dst_row0, LAS float* scr, int item, int lane) {
    const int kb = item / nblk, nb = item % nblk, k0 = 64 * kb, n0 = 32 * nb;
#pragma unroll 8
    for (int i = 0; i < 32; ++i) { const int kk = 2 * i + (lane >> 5); scr[kk * 33 + (lane & 31)] = W[(size_t)(k0 + kk) * ldw + col0 + n0 + (lane & 31)]; }
    LDS_WAIT(); asm volatile("" ::: "memory");
    const int c = lane & 7;
#pragma unroll
    for (int j = 0; j < 4; ++j) { const int n = (lane >> 3) + 8 * j; const LAS float* s = scr + (8 * c) * 33 + n;
        v4u o; o.x = pk2(s[0 * 33], s[1 * 33]); o.y = pk2(s[2 * 33], s[3 * 33]); o.z = pk2(s[4 * 33], s[5 * 33]); o.w = pk2(s[6 * 33], s[7 * 33]);
        *(GAS v4u*)(WT + (size_t)(dst_row0 + n0 + n) * K + k0 + 8 * c) = o; }
    LDS_WAIT(); asm volatile("" ::: "memory");
}

__device__ __forceinline__ void moe_weights_phase(Frame& F, const int which) {
    LAS float* scr = (LAS float*)(F.lds + RING_OFF + F.wave * 16384);
    const int gw = F.vcu * NWAVES + F.wave, NGW = F.G * NWAVES;
    bf16* GU = (bf16*)(F.ws + WS_GU); bf16* DN = (bf16*)(F.ws + WS_DN);
    constexpr int I_G1 = 16 * 4;
    constexpr int I_GU = NE * 4 * I_G1, I_DN = NE * 4 * 32;
    const int NBLK = (which ? I_DN : I_GU) / 64; gu32* const qhead = F.ctl + (which ? CW_WQ2 : CW_WQ);
    (void)gw; (void)NGW;
    for (;;) {
        if (F.tid == 0) *(volatile LAS int*)(F.lds + MISC_OFF + 64) = (int)__hip_atomic_fetch_add((unsigned*)qhead, 1u, __ATOMIC_RELAXED, __HIP_MEMORY_SCOPE_AGENT);
        __syncthreads(); const int blk_ = __builtin_amdgcn_readfirstlane(*(volatile LAS int*)(F.lds + MISC_OFF + 64)); __syncthreads();
        if (blk_ >= NBLK) break;
      for (int i8 = 0; i8 < 8; ++i8) {
        int r = blk_ * 64 + F.wave * 8 + i8 + (which ? I_GU : 0);
        if (r < I_GU) { const int blk = r / I_G1, i2 = r % I_G1, e = blk >> 2, pn = (blk >> 1) & 1, isup = blk & 1;
            p0_transpose_item((isup ? FIN(21) : FIN(20)) + (size_t)e * 1024 * 256, 256, 128 * pn, 1024, 4, GU, (e < GU_SPLIT ? e : e + GU_SHIFT) * 512 + 256 * pn + 128 * isup, scr, i2, F.lane); continue; } r -= I_GU;
        { const int e = r / 128, i2 = r % 128; p0_transpose_item(FIN(22) + (size_t)e * 256 * 1024, 1024, 0, 256, 32, DN, e * 1024, scr, i2, F.lane); }
      }
    }
}

__device__ __forceinline__ void p0_prologue(Frame& F) {
    LAS float* scr = (LAS float*)(F.lds + RING_OFF + F.wave * 16384);
    const int gw = F.vcu * NWAVES + F.wave, NGW = F.G * NWAVES;
    bf16* WIN = (bf16*)(F.ws + WS_WIN); bf16* WA = (bf16*)(F.ws + WS_WA); bf16* WB = (bf16*)(F.ws + WS_WB); bf16* WO = (bf16*)(F.ws + WS_WOUT);
    constexpr int I_IN0 = 16 * 96, I_IN1 = 16 * 16, I_IN2 = 16 * 32, I_IN3 = 16 * 32;
    constexpr int I_A = 8 * 32, I_B = 8 * 32, I_O = 16 * 32;
    constexpr int NITEMS = I_IN0 + I_IN1 + I_IN2 + I_IN3 + I_A + I_B + I_O;
    for (int it = gw; it < NITEMS; it += NGW) {
        int r = it;
        if (r < I_IN0) { p0_transpose_item(FIN(2), IN_W, 0, D, 96, WIN, 0, scr, r, F.lane); continue; } r -= I_IN0;
        if (r < I_IN1) { p0_transpose_item(FIN(2), IN_W, 3080, D, 16, WIN, 3072, scr, r, F.lane); continue; } r -= I_IN1;
        if (r < I_IN2) { p0_transpose_item(FIN(2), IN_W, 3592, D, 32, WIN, 3584, scr, r, F.lane); continue; } r -= I_IN2;
        if (r < I_IN3) { p0_transpose_item(FIN(2), IN_W, 4616, D, 32, WIN, 4608, scr, r, F.lane); continue; } r -= I_IN3;
        if (r < I_A) { p0_transpose_item(FIN(12), 1024, 0, 512, 32, WA, 0, scr, r, F.lane); continue; } r -= I_A;
        if (r < I_B) { p0_transpose_item(FIN(13), 1024, 0, 512, 32, WB, 0, scr, r, F.lane); continue; } r -= I_B;
        p0_transpose_item(FIN(14), 1024, 0, 1024, 32, WO, 0, scr, r, F.lane);
    }
    { bf16* WRS = (bf16*)(F.ws + WS_WR); const int gt = F.vcu * (NWAVES * 64) + F.tid, NT = F.G * NWAVES * 64;
      for (int i = gt; i < 48 * 1024; i += NT) { const int c = i >> 10, k = i & 1023; float w = (c < 4) ? FIN(16)[k * 4 + c] : (c < 36) ? FIN(18)[k * 32 + (c - 4)] : 0.f; w *= FIN(15)[k];
          const unsigned hi = f2bf(w), lo = f2bf(w - __uint_as_float(hi << 16)); WRS[i] = (bf16)hi; WRS[48 * 1024 + i] = (bf16)lo; } }
    __syncthreads();
    LAS float* W8 = (LAS float*)(F.lds + RING_OFF);
    for (int i = F.tid; i < 1024 * 8; i += NWAVES * 64) W8[i] = FIN(2)[(size_t)(i >> 3) * IN_W + 3072 + (i & 7)];
    __syncthreads();
    bf16* H = (bf16*)(F.ws + WS_H); float* BD = (float*)(F.ws + WS_BD);
    for (int m = gw; m < M; m += NGW) {
        const GAS f32x4* xr = (const GAS f32x4*)(FIN(0) + (size_t)m * D) + F.lane;
        f32x4 v[4]; float s2 = 0.f;
#pragma unroll
        for (int j = 0; j < 4; ++j) { v[j] = xr[64 * j]; s2 += (v[j].x * v[j].x + v[j].y * v[j].y) + (v[j].z * v[j].z + v[j].w * v[j].w); }
        const float rstd = 1.f / sqrtf(wave_sum(s2) * (1.f / D) + EPS);
        float bd[8];
#pragma unroll
        for (int q = 0; q < 8; ++q) bd[q] = 0.f;
        GAS unsigned long long* o8 = (GAS unsigned long long*)(H + (size_t)m * D) + F.lane;
#pragma unroll
        for (int j = 0; j < 4; ++j) { const f32x4 g = *((const GAS f32x4*)FIN(1) + F.lane + 64 * j); v[j] = v[j] * rstd * g;
            o8[64 * j] = (unsigned long long)pk2(v[j].x, v[j].y) | ((unsigned long long)pk2(v[j].z, v[j].w) << 32);
#pragma unroll
            for (int i = 0; i < 4; ++i) { const int k = 256 * j + 4 * F.lane + i; const f32x4 wa = *(const LAS f32x4*)(W8 + k * 8), wb = *(const LAS f32x4*)(W8 + k * 8 + 4); const float xv = v[j][i];
                bd[0] += xv * wa.x; bd[1] += xv * wa.y; bd[2] += xv * wa.z; bd[3] += xv * wa.w; bd[4] += xv * wb.x; bd[5] += xv * wb.y; bd[6] += xv * wb.z; bd[7] += xv * wb.w; } }
#pragma unroll
        for (int q = 0; q < 8; ++q) bd[q] = wave_sum(bd[q]);
        if (F.lane == 0) { *(GAS f32x4*)(BD + (size_t)m * 8) = (f32x4){bd[0], bd[1], bd[2], bd[3]}; *(GAS f32x4*)(BD + (size_t)m * 8 + 4) = (f32x4){bd[4], bd[5], bd[6], bd[7]}; }
    }
}

typedef float f32x16 __attribute__((ext_vector_type(16)));
typedef short bf16x8v __attribute__((ext_vector_type(8)));
typedef float f32x2_t __attribute__((ext_vector_type(2))); typedef __bf16 bf16x2_t __attribute__((ext_vector_type(2)));
__device__ __forceinline__ unsigned cvtpk(float lo, float hi) { f32x2_t v = {lo, hi}; bf16x2_t b = __builtin_convertvector(v, bf16x2_t); return __builtin_bit_cast(unsigned, b); }
__device__ __forceinline__ bf16x8v pack_half(const f32x16& x, int s) {
    v4u p; p.x = cvtpk(x[8 * s], x[8 * s + 1]); p.y = cvtpk(x[8 * s + 2], x[8 * s + 3]); p.z = cvtpk(x[8 * s + 4], x[8 * s + 5]); p.w = cvtpk(x[8 * s + 6], x[8 * s + 7]);
    return __builtin_bit_cast(bf16x8v, p);
}
#define MFMA32(a, b, c) __builtin_amdgcn_mfma_f32_32x32x16_bf16((a), (b), (c), 0, 0, 0)
__device__ __forceinline__ int crow16(int r, int h) { return (r & 3) + 8 * (r >> 2) + 4 * h; }
__device__ __forceinline__ constexpr int perm16c(int p) { return (p & ~0xC) | ((p & 8) >> 1) | ((p & 4) << 1); }

constexpr int GP = 272, TPB = 144;
constexpr int GA_QS = 0, GA_KS = 17408, GA_VBT = 34816, GA_KBT = 53248, GA_AM = 71680, GA_TB = 88320, GA_CW = 97536, GA_END = 103680;
constexpr int GA_SM = LDSCTL_OFF + 1024;
static_assert(GA_END <= RING_BYTES, "GDN-A LDS");

__device__ __forceinline__ void gdn_a_phase(Frame& F) {
    const int tid = F.tid, lane = F.lane, wave = F.wave, r32 = lane & 31, hh = lane >> 5;
    LAS unsigned char* L = F.lds + RING_OFF;
    LAS float* SM = (LAS float*)(F.lds + GA_SM);
    LAS float* AM = (LAS float*)(L + GA_AM); LAS float* CW = (LAS float*)(L + GA_CW);
    int cur_h = -1;
    const bf16* G = (const bf16*)(F.ws + WS_G); const float* BD = (const float*)(F.ws + WS_BD);
    bf16* WN = (bf16*)(F.ws + WS_WN); bf16* KDT = (bf16*)(F.ws + WS_KDT); bf16* UF = (bf16*)(F.ws + WS_U); bf16* QD = (bf16*)(F.ws + WS_QD); bf16* INp = (bf16*)(F.ws + WS_IN); float* GL = (float*)(F.ws + WS_GL);
    const int c = tid >> 3, seg = tid & 7;
    const int nit = (F.G == 256) ? 4 : (1024 - F.vcu + F.G - 1) / F.G;
    for (int k4 = 0; k4 < nit; ++k4) {
        const int item = (F.G == 256) ? (F.vcu & 7) * 128 + (F.vcu >> 3) + 32 * k4 : F.vcu + k4 * F.G;
        const int b = item >> 9, h = (item >> 7) & 3, n = item & 127, t0 = b * T + n * 64;
        if (h != cur_h) { cur_h = h; for (int i = tid; i < 1536; i += NWAVES * 64) { const int j = i >> 9, jj = (i >> 7) & 3, ch = i & 127; CW[i] = FIN(8)[jj * 1536 + j * 512 + h * 128 + ch]; } }
        if (wave == 0) {
            const float* bd = BD + (size_t)(t0 + lane) * 8; const float xd = bd[4 + h] + FIN(10)[h]; const float sp = xd > 20.f ? xd : log1pf(__expf(xd));
            float gc = -__expf(FIN(9)[h]) * sp;
#pragma unroll
            for (int d = 1; d < 64; d <<= 1) { const float o = __shfl_up(gc, d); if (lane >= d) gc += o; }
            const float g63 = __shfl(gc, 63);
            SM[lane] = gc; SM[64 + lane] = sigm(bd[h]); SM[128 + lane] = __expf(gc); SM[192 + lane] = __expf(g63 - gc);
            if (lane == 0) GL[item] = __expf(g63);
        }
        __syncthreads();
        const float be = SM[64 + c], eg = SM[128 + c];
#pragma unroll
        for (int j = 0; j < 3; ++j) {
            const int ch = j * 512 + h * 128 + seg * 16; float a[16];
#pragma unroll
            for (int i = 0; i < 16; ++i) a[i] = 0.f;
#pragma unroll
            for (int jj = 0; jj < 4; ++jj) { const int tl = n * 64 + c - 3 + jj;
                if (tl >= 0) { const bf16* rp = G + (size_t)(b * T + tl) * 1536 + ch; const v4u r0 = *(const v4u*)rp, r1 = *(const v4u*)(rp + 8); const unsigned rw[8] = {r0.x, r0.y, r0.z, r0.w, r1.x, r1.y, r1.z, r1.w};
                    const LAS float* wp = CW + (j * 4 + jj) * 128 + seg * 16;
#pragma unroll
                    for (int i = 0; i < 8; ++i) { a[2 * i] += wp[2 * i] * bflo(rw[i]); a[2 * i + 1] += wp[2 * i + 1] * bfhi(rw[i]); } } }
            float ss = 0.f;
#pragma unroll
            for (int i = 0; i < 16; ++i) { a[i] = a[i] * sigm(a[i]); ss += a[i] * a[i]; }
            ss += __shfl_xor(ss, 1); ss += __shfl_xor(ss, 2); ss += __shfl_xor(ss, 4);
            if (j == 0) {
                const float sc = 0.08838834764831845f / sqrtf(ss + EPS); unsigned w[8], wd[8];
#pragma unroll
                for (int i = 0; i < 16; ++i) a[i] *= sc;
#pragma unroll
                for (int i = 0; i < 8; ++i) { w[i] = pk2(a[2 * i], a[2 * i + 1]); wd[i] = pk2(a[perm16c(2 * i)] * eg, a[perm16c(2 * i + 1)] * eg); }
                *(LAS v4u*)(L + GA_QS + c * GP + seg * 32) = (v4u){w[0], w[1], w[2], w[3]}; *(LAS v4u*)(L + GA_QS + c * GP + seg * 32 + 16) = (v4u){w[4], w[5], w[6], w[7]};
                bf16* qp = QD + (size_t)item * 8192 + c * 128 + seg * 16; *(v4u*)qp = (v4u){wd[0], wd[1], wd[2], wd[3]}; *(v4u*)(qp + 8) = (v4u){wd[4], wd[5], wd[6], wd[7]};
            } else if (j == 1) {
                const float sc = 1.f / sqrtf(ss + EPS); unsigned w[8];
#pragma unroll
                for (int i = 0; i < 16; ++i) a[i] *= sc;
#pragma unroll
                for (int i = 0; i < 8; ++i) w[i] = pk2(a[2 * i], a[2 * i + 1]);
                *(LAS v4u*)(L + GA_KS + c * GP + seg * 32) = (v4u){w[0], w[1], w[2], w[3]}; *(LAS v4u*)(L + GA_KS + c * GP + seg * 32 + 16) = (v4u){w[4], w[5], w[6], w[7]};
                const float kb = be * eg;
#pragma unroll
                for (int i = 0; i < 16; ++i) *(LAS unsigned short*)(L + GA_KBT + (seg * 16 + i) * TPB + c * 2) = (unsigned short)f2bf(a[i] * kb);
            } else {
#pragma unroll
                for (int i = 0; i < 16; ++i) *(LAS unsigned short*)(L + GA_VBT + (seg * 16 + i) * TPB + c * 2) = (unsigned short)f2bf(a[i] * be);
            }
        }
        __syncthreads();
        {
            const int w4 = wave & 3, ta = w4 >> 1, tb = w4 & 1;
            f32x16 acc = {};
            const LAS unsigned char* ap = L + GA_KS + (32 * ta + r32) * GP + hh * 16;
            const LAS unsigned char* bp = L + (wave < 4 ? GA_KS : GA_QS) + (32 * tb + r32) * GP + hh * 16;
#pragma unroll
            for (int s = 0; s < 8; ++s) acc = MFMA32(*(const LAS bf16x8v*)(ap + s * 32), *(const LAS bf16x8v*)(bp + s * 32), acc);
            const int cidx = 32 * tb + r32; const float gcc = SM[cidx];
            if (wave < 4) {
#pragma unroll
                for (int r = 0; r < 16; ++r) { const int i = 32 * ta + crow16(r, hh); const float val = (cidx < i) ? SM[64 + i] * acc[r] * __expf(SM[i] - gcc) : 0.f; AM[i * 64 + cidx] = val; }
            } else {
#pragma unroll
                for (int r = 0; r < 16; ++r) { const int j = 32 * ta + crow16(r, hh); acc[r] = (j <= cidx) ? acc[r] * __expf(gcc - SM[j]) : 0.f; }
                bf16* ip = INp + (size_t)item * 4096 + cidx * 64 + 32 * ta + 8 * hh;
                *(bf16x8v*)ip = pack_half(acc, 0); *(bf16x8v*)(ip + 16) = pack_half(acc, 1);
            }
        }
        __syncthreads();
        {
            const int part = lane & 7, col = 8 * wave + (lane >> 3);
            float tj[8];
#pragma unroll
            for (int m = 0; m < 8; ++m) tj[m] = 0.f;
#pragma unroll
            for (int m = 0; m < 8; ++m)
#pragma unroll
                for (int p = 0; p < 8; ++p) {
                    const int i = 8 * m + p; const LAS float* ar = AM + i * 64 + part;
                    float s0 = 0.f, s1 = 0.f;
#pragma unroll
                    for (int mm = 0; mm <= m; ++mm) { if (mm & 1) s1 += ar[8 * mm] * tj[mm]; else s0 += ar[8 * mm] * tj[mm]; }
                    float sum = s0 + s1;
                    sum += __builtin_bit_cast(float, __builtin_amdgcn_update_dpp(0, __builtin_bit_cast(int, sum), 0xB1, 0xF, 0xF, true));
                    sum += __builtin_bit_cast(float, __builtin_amdgcn_update_dpp(0, __builtin_bit_cast(int, sum), 0x4E, 0xF, 0xF, true));
                    sum += __builtin_bit_cast(float, __builtin_amdgcn_update_dpp(0, __builtin_bit_cast(int, sum), 0x141, 0xF, 0xF, true));
                    const float val = ((i == col) ? 1.f : 0.f) - sum;
                    tj[m] = (part == p) ? val : tj[m];
                }
#pragma unroll
            for (int m = 0; m < 8; ++m) *(LAS unsigned short*)(L + GA_TB + (part + 8 * m) * TPB + col * 2) = (unsigned short)f2bf(tj[m]);
        }
        { const int kk = tid >> 2, cg = tid & 3; unsigned w[8];
#pragma unroll
          for (int e = 0; e < 8; ++e) { const int c0 = 16 * cg + perm16c(2 * e), c1 = 16 * cg + perm16c(2 * e + 1);
              const float v0 = bflo((unsigned)*(const LAS unsigned short*)(L + GA_KS + c0 * GP + kk * 2)) * SM[192 + c0], v1 = bflo((unsigned)*(const LAS unsigned short*)(L + GA_KS + c1 * GP + kk * 2)) * SM[192 + c1];
              w[e] = pk2(v0, v1); }
          bf16* kp = KDT + (size_t)item * 8192 + kk * 64 + cg * 16; *(v4u*)kp = (v4u){w[0], w[1], w[2], w[3]}; *(v4u*)(kp + 8) = (v4u){w[4], w[5], w[6], w[7]}; }
        __syncthreads();
#pragma unroll
        for (int rep = 0; rep < 2; ++rep) {
            const int t = wave + 8 * rep;
            if (rep == 0) {
                const int ct = t >> 2, vs = t & 3; f32x16 acc = {};
                const LAS unsigned char* ap = L + GA_TB + (32 * ct + r32) * TPB + hh * 16; const LAS unsigned char* bp = L + GA_VBT + (32 * vs + r32) * TPB + hh * 16;
#pragma unroll
                for (int s = 0; s < 4; ++s) acc = MFMA32(*(const LAS bf16x8v*)(ap + s * 32), *(const LAS bf16x8v*)(bp + s * 32), acc);
                bf16* up = UF + (size_t)item * 8192 + ((ct * 4 + vs) * 64 + lane) * 16;
                *(bf16x8v*)up = pack_half(acc, 0); *(bf16x8v*)(up + 8) = pack_half(acc, 1);
            } else {
                const int kt = (t - 8) >> 1, ct = (t - 8) & 1; f32x16 acc = {};
                const LAS unsigned char* ap = L + GA_KBT + (32 * kt + r32) * TPB + hh * 16; const LAS unsigned char* bp = L + GA_TB + (32 * ct + r32) * TPB + hh * 16;
#pragma unroll
                for (int s = 0; s < 4; ++s) acc = MFMA32(*(const LAS bf16x8v*)(ap + s * 32), *(const LAS bf16x8v*)(bp + s * 32), acc);
#pragma unroll
                for (int r = 0; r < 16; ++r) acc[r] = -acc[r];
                bf16* wp = WN + (size_t)item * 8192 + (32 * ct + r32) * 128 + 32 * kt + 8 * hh;
                *(bf16x8v*)wp = pack_half(acc, 0); *(bf16x8v*)(wp + 16) = pack_half(acc, 1);
            }
        }
        __syncthreads();
    }
}

constexpr int GB_WN = 0, GB_KD = 17408, GB_U = 35840, GB_BUF = 52224;
static_assert(2 * GB_BUF <= RING_BYTES, "GDN-B LDS");
__device__ __forceinline__ void gdn_b_phase(Frame& F) {
    if (blockIdx.x >= 8) return;
    const int tid = F.tid, lane = F.lane, wave = F.wave, r32 = lane & 31, hh = lane >> 5;
    LAS unsigned char* L = F.lds + RING_OFF;
    const bf16* WN = (const bf16*)(F.ws + WS_WN); const bf16* KDT = (const bf16*)(F.ws + WS_KDT); const bf16* UF = (const bf16*)(F.ws + WS_U); const float* GL = (const float*)(F.ws + WS_GL);
    bf16* SB = (bf16*)(F.ws + WS_SB); bf16* VB = (bf16*)(F.ws + WS_VB);
    const int item0 = blockIdx.x * 128;
    f32x16 S[4];
#pragma unroll
    for (int k = 0; k < 4; ++k) S[k] = (f32x16){};
    v4u st[12]; const int lt = tid - 256;
#define GB_LOAD(it) do { const v4u* a_ = (const v4u*)(WN + (size_t)(it) * 8192); const v4u* b_ = (const v4u*)(KDT + (size_t)(it) * 8192); const v4u* c_ = (const v4u*)(UF + (size_t)(it) * 8192); \
        _Pragma("unroll") for (int q_ = 0; q_ < 4; ++q_) { st[q_] = a_[lt + 256 * q_]; st[4 + q_] = b_[lt + 256 * q_]; st[8 + q_] = c_[lt + 256 * q_]; } } while (0)
#define GB_WRITE(buf) do { LAS unsigned char* B_ = L + (buf) * GB_BUF; \
        _Pragma("unroll") for (int q_ = 0; q_ < 4; ++q_) { const int x_ = lt + 256 * q_; \
            *(LAS v4u*)(B_ + GB_WN + (x_ >> 4) * GP + (x_ & 15) * 16) = st[q_]; *(LAS v4u*)(B_ + GB_KD + (x_ >> 3) * TPB + (x_ & 7) * 16) = st[4 + q_]; *(LAS v4u*)(B_ + GB_U + x_ * 16) = st[8 + q_]; } } while (0)
    LAS float* GLs = (LAS float*)(F.lds + GA_SM);
    if (tid < 128) GLs[tid] = GL[item0 + tid];
    if (wave >= 4) {
        GB_LOAD(item0); GB_WRITE(0); GB_LOAD(item0 + 1);
        __syncthreads();
        for (int n = 0; n < 128; ++n) {
            if (n + 1 < 128) { GB_WRITE((n & 1) ^ 1); if (n + 2 < 128) GB_LOAD(item0 + n + 2); }
            __syncthreads();
        }
        return;
    }
    __syncthreads();
    for (int n = 0; n < 128; ++n) {
        const int item = item0 + n; const int buf = n & 1;
        {
            const int vs = wave; const LAS unsigned char* B_ = L + buf * GB_BUF;
            const float gl = GLs[n];
            bf16x8v vb[2][2]; bf16x8v af[16], ak[16];
            { const LAS unsigned char* ap = B_ + GB_WN + r32 * GP + hh * 16;
#pragma unroll
              for (int ct = 0; ct < 2; ++ct)
#pragma unroll
                  for (int k = 0; k < 8; ++k) af[ct * 8 + k] = *(const LAS bf16x8v*)(ap + ct * 32 * GP + k * 32); }
            v4u ur[2][2];
#pragma unroll
            for (int ct = 0; ct < 2; ++ct) { const LAS unsigned char* up = B_ + GB_U + ((ct * 4 + vs) * 64 + lane) * 32; ur[ct][0] = *(const LAS v4u*)up; ur[ct][1] = *(const LAS v4u*)(up + 16); }
            bf16x8v sb[4][2];
#pragma unroll
            for (int kt = 0; kt < 4; ++kt)
#pragma unroll
                for (int s = 0; s < 2; ++s) { sb[kt][s] = pack_half(S[kt], s); *(bf16x8v*)(SB + ((((size_t)item * 4 + vs) * 4 + kt) * 2 + s) * 512 + lane * 8) = sb[kt][s]; }
#pragma unroll
            for (int kt = 0; kt < 4; ++kt) S[kt] = S[kt] * gl;
            f32x16 vn[2];
#pragma unroll
            for (int ct = 0; ct < 2; ++ct) { const v4u u0 = ur[ct][0], u1 = ur[ct][1];
                f32x16 acc; acc[0] = bflo(u0.x); acc[1] = bfhi(u0.x); acc[2] = bflo(u0.y); acc[3] = bfhi(u0.y); acc[4] = bflo(u0.z); acc[5] = bfhi(u0.z); acc[6] = bflo(u0.w); acc[7] = bfhi(u0.w);
                acc[8] = bflo(u1.x); acc[9] = bfhi(u1.x); acc[10] = bflo(u1.y); acc[11] = bfhi(u1.y); acc[12] = bflo(u1.z); acc[13] = bfhi(u1.z); acc[14] = bflo(u1.w); acc[15] = bfhi(u1.w);
                vn[ct] = acc; }
            const LAS unsigned char* kp = B_ + GB_KD + r32 * TPB + hh * 16;
            __builtin_amdgcn_sched_barrier(0);
#pragma unroll
            for (int k = 0; k < 8; ++k) vn[0] = MFMA32(af[k], sb[k >> 1][k & 1], vn[0]);
#pragma unroll
            for (int q = 0; q < 8; ++q) ak[q] = *(const LAS bf16x8v*)(kp + (q >> 2) * 32 * TPB + (q & 3) * 32);
            __builtin_amdgcn_sched_barrier(0);
#pragma unroll
            for (int k = 0; k < 8; ++k) vn[1] = MFMA32(af[8 + k], sb[k >> 1][k & 1], vn[1]);
#pragma unroll
            for (int q = 8; q < 16; ++q) ak[q] = *(const LAS bf16x8v*)(kp + (q >> 2) * 32 * TPB + (q & 3) * 32);
#pragma unroll
            for (int s2 = 0; s2 < 2; ++s2) { vb[0][s2] = pack_half(vn[0], s2); *(bf16x8v*)(VB + ((((size_t)item * 4 + vs) * 2 + 0) * 2 + s2) * 512 + lane * 8) = vb[0][s2]; }
            __builtin_amdgcn_sched_barrier(0);
#pragma unroll
            for (int s2 = 0; s2 < 2; ++s2) { vb[1][s2] = pack_half(vn[1], s2); *(bf16x8v*)(VB + ((((size_t)item * 4 + vs) * 2 + 1) * 2 + s2) * 512 + lane * 8) = vb[1][s2]; }
#pragma unroll
            for (int kt = 0; kt < 4; ++kt)
#pragma unroll
                for (int k = 0; k < 4; ++k) S[kt] = MFMA32(ak[kt * 4 + k], vb[k >> 1][k & 1], S[kt]);
        }
        __syncthreads();
    }
#undef GB_LOAD
#undef GB_WRITE
}

constexpr int GC_OS = 0;
__device__ __forceinline__ void gdn_c_phase(Frame& F) {
    const int tid = F.tid, lane = F.lane, wave = F.wave, r32 = lane & 31, hh = lane >> 5;
    LAS float* OS = (LAS float*)(F.lds + RING_OFF + GC_OS);
    const bf16* QD = (const bf16*)(F.ws + WS_QD); const bf16* INp = (const bf16*)(F.ws + WS_IN); const bf16* SB = (const bf16*)(F.ws + WS_SB); const bf16* VB = (const bf16*)(F.ws + WS_VB);
    const bf16* GATE = (const bf16*)(F.ws + WS_GATE); bf16* YB = (bf16*)(F.ws + WS_K);
    const int ct = wave >> 2, vs = wave & 3, c = tid >> 3, seg = tid & 7;
    for (int item = F.vcu; item < 1024; item += F.G) {
        const int b = item >> 9, h = (item >> 7) & 3, n = item & 127, t0 = b * T + n * 64;
        f32x16 acc = {};
        const bf16* qa = QD + (size_t)item * 8192 + (32 * ct + r32) * 128 + 8 * hh;
        const bf16* sbp = SB + ((size_t)item * 4 + vs) * 4096 + lane * 8;
#pragma unroll
        for (int ks = 0; ks < 8; ++ks) acc = MFMA32(*(const bf16x8v*)(qa + ks * 16), *(const bf16x8v*)(sbp + ks * 512), acc);
        const bf16* ia = INp + (size_t)item * 4096 + (32 * ct + r32) * 64 + 8 * hh;
        const bf16* vbp = VB + ((size_t)item * 4 + vs) * 2048 + lane * 8;
#pragma unroll
        for (int ks = 0; ks < 4; ++ks) acc = MFMA32(*(const bf16x8v*)(ia + ks * 16), *(const bf16x8v*)(vbp + ks * 512), acc);
#pragma unroll
        for (int r = 0; r < 16; ++r) OS[(32 * ct + crow16(r, hh)) * 132 + 32 * vs + r32] = acc[r];
        __syncthreads();
        { const int tp = t0 + c; float o[16]; float ss = 0.f;
#pragma unroll
          for (int i = 0; i < 16; ++i) { o[i] = OS[c * 132 + seg * 16 + i]; ss += o[i] * o[i]; }
          ss += __shfl_xor(ss, 1); ss += __shfl_xor(ss, 2); ss += __shfl_xor(ss, 4);
          const float rr = 1.f / sqrtf(ss * (1.f / 128.f) + EPS);
          const v4u g0 = *(const v4u*)(GATE + (size_t)tp * 512 + h * 128 + seg * 16), g1 = *(const v4u*)(GATE + (size_t)tp * 512 + h * 128 + seg * 16 + 8);
          const unsigned gw[8] = {g0.x, g0.y, g0.z, g0.w, g1.x, g1.y, g1.z, g1.w}; unsigned ow[8];
#pragma unroll
          for (int i = 0; i < 8; ++i) { const float ga = bflo(gw[i]), gb = bfhi(gw[i]);
              const float y0 = o[2 * i] * rr * FIN(11)[seg * 16 + 2 * i] * (ga * sigm(ga)), y1 = o[2 * i + 1] * rr * FIN(11)[seg * 16 + 2 * i + 1] * (gb * sigm(gb)); ow[i] = pk2(y0, y1); }
          *(v4u*)(YB + (size_t)tp * 512 + h * 128 + seg * 16) = (v4u){ow[0], ow[1], ow[2], ow[3]}; *(v4u*)(YB + (size_t)tp * 512 + h * 128 + seg * 16 + 8) = (v4u){ow[4], ow[5], ow[6], ow[7]}; }
        __syncthreads();
    }
}

__device__ __forceinline__ void ya_phase(Frame& F) {
    const int gw = F.vcu * NWAVES + F.wave, NGW = F.G * NWAVES, l = F.lane;
    const float lam = __expf(wave_sum(FIN(3)[l] * FIN(4)[l])) - __expf(wave_sum(FIN(5)[l] * FIN(6)[l])) + 0.2f;
    const bf16* OP = (const bf16*)(F.ws + WS_H); bf16* YA = (bf16*)(F.ws + WS_Q);
    const int vh = l >> 5, d = 2 * (l & 31);
    const float g0 = FIN(7)[2 * l] * 0.8f, g1 = FIN(7)[2 * l + 1] * 0.8f;
    for (int m = gw; m < M; m += NGW) {
        const bf16* row = OP + (size_t)m * 1024; unsigned ow[4];
#pragma unroll
        for (int hh = 0; hh < 4; ++hh) {
            const unsigned p0 = *(const unsigned*)(row + ((hh * 2 + 0) * 2 + vh) * 64 + d), p1 = *(const unsigned*)(row + ((hh * 2 + 1) * 2 + vh) * 64 + d);
            const float a0 = bflo(p0) - lam * bflo(p1), a1 = bfhi(p0) - lam * bfhi(p1);
            const float ss = wave_sum(a0 * a0 + a1 * a1);
            const float r = 1.f / sqrtf(ss * (1.f / 128.f) + EPS);
            ow[hh] = pk2(a0 * r * g0, a1 * r * g1);
        }
#pragma unroll
        for (int hh = 0; hh < 4; ++hh) *(unsigned*)(YA + (size_t)m * 512 + hh * 128 + 2 * l) = ow[hh];
    }
}

typedef float f32x4r __attribute__((ext_vector_type(4)));
__device__ __forceinline__ void router_phase(Frame& F, bool count) {
    const int l = F.lane, r = l & 15, g = l >> 4;
    const bf16* WRS = (const bf16*)(F.ws + WS_WR); float* ROUTE = (float*)(F.ws + WS_ROUTE);
    LAS float* LG = (LAS float*)(F.lds + RING_OFF) + (F.wave & 3) * (16 * 49);
    LAS float* PX = (LAS float*)(F.lds + RING_OFF + 16384) + (F.wave & 3) * (64 * 13);
    const int kh = F.wave >> 2;
    {
        for (int rt = F.vcu * 4 + (F.wave & 3); rt < M / 16; rt += F.G * 4) {
            const int m0 = rt * 16;
            const float* xp = F.out + (size_t)(m0 + r) * D + 8 * g + 512 * kh;
            const bf16* wp = WRS + (size_t)r * 1024 + 8 * g + 512 * kh;
            f32x4r acc[3]; float ssq = 0.f;
#pragma unroll
            for (int ct = 0; ct < 3; ++ct) acc[ct] = (f32x4r){0.f, 0.f, 0.f, 0.f};
#pragma unroll 8
            for (int sidx = 0; sidx < 16; ++sidx) {
                const f32x4 x0 = *(const GAS f32x4*)(xp + 32 * sidx), x1v = *(const GAS f32x4*)(xp + 32 * sidx + 4);
                ssq += (x0.x * x0.x + x0.y * x0.y) + (x0.z * x0.z + x0.w * x0.w) + (x1v.x * x1v.x + x1v.y * x1v.y) + (x1v.z * x1v.z + x1v.w * x1v.w);
                v4u ah, al;
                ah.x = cvtpk(x0.x, x0.y); ah.y = cvtpk(x0.z, x0.w); ah.z = cvtpk(x1v.x, x1v.y); ah.w = cvtpk(x1v.z, x1v.w);
                al.x = cvtpk(x0.x - bflo(ah.x), x0.y - bfhi(ah.x)); al.y = cvtpk(x0.z - bflo(ah.y), x0.w - bfhi(ah.y)); al.z = cvtpk(x1v.x - bflo(ah.z), x1v.y - bfhi(ah.z)); al.w = cvtpk(x1v.z - bflo(ah.w), x1v.w - bfhi(ah.w));
                const bf16x8v Ah = __builtin_bit_cast(bf16x8v, ah), Al = __builtin_bit_cast(bf16x8v, al);
#pragma unroll
                for (int ct = 0; ct < 3; ++ct) {
                    const bf16x8v bh = *(const bf16x8v*)(wp + (size_t)ct * 16 * 1024 + 32 * sidx), bl = *(const bf16x8v*)(wp + (size_t)(48 + ct * 16) * 1024 + 32 * sidx);
                    acc[ct] = __builtin_amdgcn_mfma_f32_16x16x32_bf16(Ah, bh, acc[ct], 0, 0, 0);
                    acc[ct] = __builtin_amdgcn_mfma_f32_16x16x32_bf16(Ah, bl, acc[ct], 0, 0, 0);
                    acc[ct] = __builtin_amdgcn_mfma_f32_16x16x32_bf16(Al, bh, acc[ct], 0, 0, 0);
                }
            }
            if (kh) { LAS float* px = PX + l * 13;
#pragma unroll
                for (int ct = 0; ct < 3; ++ct)
#pragma unroll
                    for (int e = 0; e < 4; ++e) px[ct * 4 + e] = acc[ct][e];
                px[12] = ssq; }
            __syncthreads();
            if (!kh) {
            { const LAS float* px = PX + l * 13;
#pragma unroll
                for (int ct = 0; ct < 3; ++ct)
#pragma unroll
                    for (int e = 0; e < 4; ++e) acc[ct][e] += px[ct * 4 + e];
                ssq += px[12]; }
            ssq += __shfl_xor(ssq, 16); ssq += __shfl_xor(ssq, 32);
            const float rstd = 1.f / sqrtf(ssq * (1.f / D) + EPS);
#pragma unroll
            for (int e = 0; e < 4; ++e) { const float rs = __shfl(rstd, 4 * g + e);
#pragma unroll
                for (int ct = 0; ct < 3; ++ct) LG[(4 * g + e) * 49 + 16 * ct + r] = acc[ct][e] * rs; }
            LDS_WAIT(); asm volatile("" ::: "memory");
            if (l < 16) {
                const LAS float* lr = LG + l * 49; const int m = m0 + l;
                float gl[4];
#pragma unroll
                for (int c = 0; c < 4; ++c) gl[c] = lr[c] + FIN(17)[c];
                int gi = 0; float gm = gl[0];
#pragma unroll
                for (int c = 1; c < 4; ++c) if (gl[c] > gm) { gm = gl[c]; gi = c; }
                float den = 0.f;
#pragma unroll
                for (int c = 0; c < 4; ++c) den += __expf(gl[c] - gm);
                const float gwt = 1.f / den;
                float el[8];
#pragma unroll
                for (int j = 0; j < 8; ++j) el[j] = lr[4 + 8 * gi + j] + FIN(19)[8 * gi + j];
                int i0 = 0; float v0 = el[0];
#pragma unroll
                for (int j = 1; j < 8; ++j) if (el[j] > v0) { v0 = el[j]; i0 = j; }
                int i1 = -1; float v1 = -INFINITY;
#pragma unroll
                for (int j = 0; j < 8; ++j) if (j != i0 && el[j] > v1) { v1 = el[j]; i1 = j; }
                const float e1 = __expf(v1 - v0), w0 = gwt / (1.f + e1), w1 = gwt * e1 / (1.f + e1);
                const int ex0 = gi * 8 + i0, ex1 = gi * 8 + i1;
                *(GAS f32x4*)(ROUTE + (size_t)m * 4) = (f32x4){__int_as_float(ex0), __int_as_float(ex1), w0, w1};
                if (count) { atomicAdd((unsigned*)(F.ctl + CW_CNT + 64 * ex0), 1u); atomicAdd((unsigned*)(F.ctl + CW_CNT + 64 * ex1), 1u); }
            }
            }
            __syncthreads();
        }
    }
}
__device__ __forceinline__ void moe_build_ts(Frame& F) {
    LAS int* ts = (LAS int*)(F.lds + TS_OFF);
    if (F.tid == 0) { int acc = 0;
        for (int e = 0; e < 32; ++e) { ts[e] = acc; const unsigned n = __hip_atomic_load(F.ctl + CW_CNT + 64 * e, RLX_AGENT); acc += (int)((n + 255u) >> 8); }
        ts[32] = acc; }
    __syncthreads();
}
__device__ __forceinline__ void gather_phase(Frame& F) {
    moe_build_ts(F);
    const LAS int* ts = (const LAS int*)(F.lds + TS_OFF);
    const int gw = F.vcu * NWAVES + F.wave, NGW = F.G * NWAVES, l = F.lane;
    const float* ROUTE = (const float*)(F.ws + WS_ROUTE); bf16* XG = (bf16*)(F.ws + WS_XG); float* ROWW = (float*)(F.ws + WS_ROWW); int* POS = (int*)(F.ws + WS_POS);
    f32x4 gn[4];
#pragma unroll
    for (int j = 0; j < 4; ++j) gn[j] = *((const GAS f32x4*)FIN(15) + l + 64 * j);
    for (int m = gw; m < M; m += NGW) {
        const f32x4 rt = *(const GAS f32x4*)(ROUTE + (size_t)m * 4);
        const int e0 = __float_as_int(rt.x), e1 = __float_as_int(rt.y);
        int p0 = 0, p1 = 0;
        if (l == 0) { p0 = ts[e0] * 256 + (int)atomicAdd((unsigned*)(F.ctl + CW_CUR + 64 * e0), 1u); p1 = ts[e1] * 256 + (int)atomicAdd((unsigned*)(F.ctl + CW_CUR + 64 * e1), 1u);
            ROWW[p0] = rt.z; ROWW[p1] = rt.w; POS[2 * m] = p0; POS[2 * m + 1] = p1; }
        p0 = __builtin_amdgcn_readfirstlane(p0); p1 = __builtin_amdgcn_readfirstlane(p1);
        const GAS f32x4* xr = (const GAS f32x4*)(F.out + (size_t)m * D) + l;
        f32x4 v[4]; float s2 = 0.f;
#pragma unroll
        for (int j = 0; j < 4; ++j) { v[j] = xr[64 * j]; s2 += (v[j].x * v[j].x + v[j].y * v[j].y) + (v[j].z * v[j].z + v[j].w * v[j].w); }
        const float rstd = 1.f / sqrtf(wave_sum(s2) * (1.f / D) + EPS);
        GAS unsigned long long* o0 = (GAS unsigned long long*)(XG + (size_t)p0 * D) + l; GAS unsigned long long* o1 = (GAS unsigned long long*)(XG + (size_t)p1 * D) + l;
#pragma unroll
        for (int j = 0; j < 4; ++j) { v[j] = v[j] * rstd * gn[j]; const unsigned long long w = (unsigned long long)pk2(v[j].x, v[j].y) | ((unsigned long long)pk2(v[j].z, v[j].w) << 32); o0[64 * j] = w; o1[64 * j] = w; }
    }
}
__device__ __forceinline__ void final_phase(Frame& F) {
    const int gw = F.vcu * NWAVES + F.wave, NGW = F.G * NWAVES, l = F.lane;
    const bf16* YG = (const bf16*)(F.ws + WS_YG); const int* POS = (const int*)(F.ws + WS_POS);
    f32x4 gn[4];
#pragma unroll
    for (int j = 0; j < 4; ++j) gn[j] = *((const GAS f32x4*)FIN(23) + l + 64 * j);
    for (int m = gw; m < M; m += NGW) {
        const int p0 = POS[2 * m], p1 = POS[2 * m + 1];
        GAS f32x4* xr = (GAS f32x4*)(F.out + (size_t)m * D) + l;
        const GAS v2u* y0 = (const GAS v2u*)(YG + (size_t)p0 * D) + l; const GAS v2u* y1 = (const GAS v2u*)(YG + (size_t)p1 * D) + l;
        f32x4 v[4]; float s2 = 0.f;
#pragma unroll
        for (int j = 0; j < 4; ++j) { const v2u a = y0[64 * j], bq = y1[64 * j]; v[j] = xr[64 * j];
            v[j].x += bflo(a.x) + bflo(bq.x); v[j].y += bfhi(a.x) + bfhi(bq.x); v[j].z += bflo(a.y) + bflo(bq.y); v[j].w += bfhi(a.y) + bfhi(bq.y);
            s2 += (v[j].x * v[j].x + v[j].y * v[j].y) + (v[j].z * v[j].z + v[j].w * v[j].w); }
        const float rstd = 1.f / sqrtf(wave_sum(s2) * (1.f / D) + EPS);
#pragma unroll
        for (int j = 0; j < 4; ++j) xr[64 * j] = v[j] * rstd * gn[j];
    }
}

__global__ void __launch_bounds__(NWAVES * 64, 2) mk_fwd(Args args) {
    extern __shared__ __attribute__((aligned(16))) unsigned char lds[];
    Frame F;
    F.lds = (LAS unsigned char*)lds;
    F.MISC = (volatile LAS unsigned*)(F.lds + MISC_OFF);
    F.tid = threadIdx.x; F.lane = F.tid & 63; F.wave = __builtin_amdgcn_readfirstlane(F.tid >> 6);
    F.G = gridDim.x; { const int bx = blockIdx.x; F.vcu = (F.G % 8 == 0) ? (bx % 8) * (F.G / 8) + bx / 8 : bx; }
    F.ws = args.ws; F.out = args.out; F.ctl = (gu32*)(args.ws + WS_CTL);
    F.ka = (const CAS Args*)__builtin_amdgcn_kernarg_segment_ptr();
    for (int u = F.tid; u < (LDS_BYTES - LDSCTL_OFF) / 4; u += NWAVES * 64) ((LAS unsigned*)(F.lds + LDSCTL_OFF))[u] = 0u;
    __syncthreads();
    XcdBarrier bar = xcd_barrier_post((unsigned*)(F.ctl + CW_BAR), F.MISC + 8);
    const int lo = args.ph_lo, hi = args.ph_hi;
#ifndef PHMASK
#define PHMASK 0x1fff
#endif
#define IN(k) (((PHMASK >> (k)) & 1) && lo <= (k) && (k) < hi)
#ifndef REPMASK
#define REPMASK 0
#endif
#define NREP(k) ((((REPMASK) >> (k)) & 1) ? 2 : 1)
#define REFRESH() do { int t_ = threadIdx.x; asm volatile("" : "+v"(t_)); F.tid = t_; F.lane = t_ & 63; } while (0)
#define SEAM(k) do { if (IN(k) && IN((k) + 1)) xcd_barrier(bar); } while (0)
    bf16* const WIN = (bf16*)(F.ws + WS_WIN); bf16* const Hb = (bf16*)(F.ws + WS_H);
    bf16* const Qb = (bf16*)(F.ws + WS_Q); bf16* const Kb = (bf16*)(F.ws + WS_K); bf16* const Vb = (bf16*)(F.ws + WS_V);
    bf16* const MA = (bf16*)F.out; bf16* const MB = MA + (size_t)M * 1024;

    if (IN(0)) for (int rep_ = 0; rep_ < NREP(0); ++rep_) { REFRESH(); p0_prologue(F); } SEAM(0);
    if (IN(1)) for (int rep_ = 0; rep_ < NREP(1); ++rep_) { REFRESH();
        pg8::Gemm g{Hb, WIN, M, NPROJ, D}; pg8::StaticOrder S; S.init(M, NPROJ, F.G, (int)blockIdx.x);
        pg8::EpiProj E{Qb, Kb, Vb, (bf16*)(F.ws + WS_G), (bf16*)(F.ws + WS_GATE), MA, MB, attn_body::C2};
        pg8::gemm_phase<pg8::EpiProj, pg8::StaticOrder, PG8_ALIGN, PG8_SP2>(F.lds + RING_OFF, g, S, E);
    } SEAM(1);
    if (IN(2)) for (int rep_ = 0; rep_ < NREP(2); ++rep_) { REFRESH(); gdn_a_phase(F); } SEAM(2);
    if (IN(4)) for (int rep_ = 0; rep_ < NREP(4); ++rep_) { REFRESH();
        gdn_b_phase(F);
        __syncthreads();
#if ATTN_DV128
        static_assert(attn128::ATTN_LDS_BYTES <= RING_BYTES, "attention LDS");
        const attn128::AttnTensors AT{(const attn128::bf16*)Qb, (const attn128::bf16*)Kb, (const attn128::bf16*)Vb, (attn128::bf16*)Hb};
        const attn128::DynOrder S{(unsigned*)(F.ctl + CW_AQ), (int)(blockIdx.x & 7), (volatile LAS int*)(F.lds + MISC_OFF + 64)};
        attn128::attn_phase<attn128::DynOrder>((char*)lds + RING_OFF, AT, S);
        __syncthreads();
        moe_weights_phase(F, 0);
#else
        const attn_body::AttnTensors AT{(const attn_body::bf16*)Qb, (const attn_body::bf16*)Kb, (const attn_body::bf16*)Vb, (attn_body::bf16*)Hb};
        const attn_body::DynOrder S{(unsigned*)(F.ctl + CW_AQ), (int)(blockIdx.x & 7), (volatile LAS int*)(F.lds + MISC_OFF + 64)};
        attn_body::attn_phase<attn_body::DynOrder>((char*)lds + RING_OFF, AT, S);
#endif
    } SEAM(4);
    if (IN(5)) for (int rep_ = 0; rep_ < NREP(5); ++rep_) { REFRESH(); gdn_c_phase(F); ya_phase(F); __syncthreads(); moe_weights_phase(F, 1); } SEAM(5);
    if (IN(6)) for (int rep_ = 0; rep_ < NREP(6); ++rep_) { REFRESH();
        { pg8::Gemm g{Qb, (bf16*)(F.ws + WS_WA), M, D, 512}; pg8::StaticOrder S; S.init(M, D, F.G, (int)blockIdx.x);
          pg8::EpiMerge<0> E{MA, Hb}; pg8::gemm_phase<pg8::EpiMerge<0>, pg8::StaticOrder, PG8_ALIGN, PG8_SP2>(F.lds + RING_OFF, g, S, E); }
        __syncthreads();
        { pg8::Gemm g{Kb, (bf16*)(F.ws + WS_WB), M, D, 512}; pg8::StaticOrder S; S.init(M, D, F.G, (int)blockIdx.x);
          pg8::EpiMerge<1> E{MB, Hb}; pg8::gemm_phase<pg8::EpiMerge<1>, pg8::StaticOrder, PG8_ALIGN, PG8_SP2>(F.lds + RING_OFF, g, S, E); }
    } SEAM(6);
    if (IN(7)) for (int rep_ = 0; rep_ < NREP(7); ++rep_) { REFRESH();
        pg8::Gemm g{Hb, (bf16*)(F.ws + WS_WOUT), M, D, D}; pg8::StaticOrder S; S.init(M, D, F.G, (int)blockIdx.x);
        pg8::EpiRes E{FIN(0), F.out}; pg8::gemm_phase<pg8::EpiRes, pg8::StaticOrder, PG8_ALIGN, PG8_SP2>(F.lds + RING_OFF, g, S, E);
    } SEAM(7);
    if (IN(8)) for (int rep_ = 0; rep_ < NREP(8); ++rep_) { REFRESH(); router_phase(F, rep_ == 0); } SEAM(8);
    if (IN(9)) for (int rep_ = 0; rep_ < NREP(9); ++rep_) { REFRESH(); gather_phase(F); } SEAM(9);
    if (IN(10)) for (int rep_ = 0; rep_ < NREP(10); ++rep_) { REFRESH();
        moe_build_ts(F);
        pg8::Gemm g{(bf16*)(F.ws + WS_XG), (bf16*)(F.ws + WS_GU), XG_ROWS, NE * 512, D};
        pg8::MoeOrder S{(const LAS int*)(F.lds + TS_OFF), 2, F.G, (int)blockIdx.x, GU_SPLIT, GU_SHIFT};
        pg8::EpiAct E{(bf16*)(F.ws + WS_ACT), (const float*)(F.ws + WS_ROWW)};
        pg8::gemm_phase<pg8::EpiAct, pg8::MoeOrder, PG8_ALIGN, PG8_SP2>(F.lds + RING_OFF, g, S, E);
    } SEAM(10);
    if (IN(11)) for (int rep_ = 0; rep_ < NREP(11); ++rep_) { REFRESH();
        moe_build_ts(F);
        int Kd = FH; asm volatile("" : "+s"(Kd));
        pg8::Gemm g{(bf16*)(F.ws + WS_ACT), (bf16*)(F.ws + WS_DN), XG_ROWS, NE * 1024, Kd};
        pg8::MoeOrder S{(const LAS int*)(F.lds + TS_OFF), 4, F.G, (int)blockIdx.x, 64, 0};
        pg8::EpiStore E{(bf16*)(F.ws + WS_YG), 1024, 3};
        pg8::gemm_phase<pg8::EpiStore, pg8::MoeOrder, PG8_ALIGN, PG8_SP2>(F.lds + RING_OFF, g, S, E);
    } SEAM(11);
    if (IN(12)) for (int rep_ = 0; rep_ < NREP(12); ++rep_) { REFRESH(); final_phase(F); }
#undef IN
#undef SEAM
}

#ifndef MK_N_LAUNCHES
#define MK_N_LAUNCHES 1
#endif
extern "C" void kernel_launch(void* const* d_in, const int* in_sizes, int n_in, void* d_out, int out_size, void* d_ws, size_t ws_size, hipStream_t stream) {
    static int grid = 0;
    if (grid == 0) {
        if (n_in != 24 || in_sizes[0] != M * D || out_size != M * D || ws_size < WS_END) { fprintf(stderr, "kernel_launch: unexpected shapes (n_in %d, in0 %d, out %d, ws %zu)\n", n_in, n_in > 0 ? in_sizes[0] : -1, out_size, ws_size); grid = -1; return; }
        int dev = 0, cus = 0, per_cu = 0;
        if (hipGetDevice(&dev) != hipSuccess || hipDeviceGetAttribute(&cus, hipDeviceAttributeMultiprocessorCount, dev) != hipSuccess) { grid = -1; return; }
        if (hipFuncSetAttribute((const void*)mk_fwd, hipFuncAttributeMaxDynamicSharedMemorySize, LDS_BYTES) != hipSuccess) { fprintf(stderr, "kernel_launch: hipFuncSetAttribute failed\n"); grid = -1; return; }
        if (hipOccupancyMaxActiveBlocksPerMultiprocessor(&per_cu, (const void*)mk_fwd, NWAVES * 64, LDS_BYTES) != hipSuccess || per_cu < 1) { fprintf(stderr, "kernel_launch: occupancy query says %d blocks per CU\n", per_cu); per_cu = 1; }
        (void)hipGetLastError();
        grid = cus;
        if (grid != 256) fprintf(stderr, "kernel_launch: %d CUs (built for 256)\n", grid);
    }
    if (grid < 0) return;
    if (hipMemsetAsync((char*)d_ws + WS_CTL, 0, CTL_ZERO_BYTES, stream) != hipSuccess) return;
    Args a{};
    for (int i = 0; i < 24; ++i) a.in[i] = (const float*)d_in[i];
    a.out = (float*)d_out; a.ws = (unsigned char*)d_ws;
#if MK_N_LAUNCHES == 1
    a.ph_lo = 0; a.ph_hi = N_PHASES;
    hipLaunchKernelGGL(mk_fwd, dim3(grid), dim3(NWAVES * 64), LDS_BYTES, stream, a);
#else
    for (int p = 0; p < N_PHASES; ++p) { a.ph_lo = p; a.ph_hi = p + 1; hipLaunchKernelGGL(mk_fwd, dim3(grid), dim3(NWAVES * 64), LDS_BYTES, stream, a); }
#endif
}
```
